# Optimizing an MI355X kernel written in HIP

```python
import math
import jax, jax.numpy as jnp
from jax import lax
import numpy as np

D_MODEL = 1024
BATCH = 8
SEQ = 2048
DEPTH = 2

MIX_WIDTH = D_MODEL
HEAD_DIM = 64
ATTN_WIDTH = D_MODEL // 2
N_Q_HEADS = ATTN_WIDTH // HEAD_DIM
N_KV_HEADS = N_Q_HEADS // 4
KV_WIDTH = N_KV_HEADS * HEAD_DIM
WINDOW = 128
BLOCK = 128
ROPE_THETA = 500000.0
ROPE_DIM = HEAD_DIM // 4
CONV_WIDTH = D_MODEL // 4
CONV_K = 3
POOL_WIDTH = D_MODEL // 4
POOL_WINDOWS = (2, 4, 8, 16)
POOL_GROUP = POOL_WIDTH // len(POOL_WINDOWS)
IN_WIDTH = ATTN_WIDTH + 2 * KV_WIDTH + 3 * CONV_WIDTH + POOL_WIDTH
IN_SPLITS = (ATTN_WIDTH,
             ATTN_WIDTH + KV_WIDTH,
             ATTN_WIDTH + 2 * KV_WIDTH,
             ATTN_WIDTH + 2 * KV_WIDTH + CONV_WIDTH,
             ATTN_WIDTH + 2 * KV_WIDTH + 2 * CONV_WIDTH,
             ATTN_WIDTH + 2 * KV_WIDTH + 3 * CONV_WIDTH)
PEER_HEADS = 8
PEER_NKEYS = 128
PEER_EXPERTS = PEER_NKEYS * PEER_NKEYS
PEER_QDIM = 256
PEER_TOPK = 16
PEER_CHUNK = 128
EPS = 1e-6
MASK_VALUE = -1e30

kernel_name = "hybrid_conv_swa_pool_peer_encoder"


def rms_norm(t, g):
    tf = t.astype(jnp.float32)
    y = tf * lax.rsqrt(jnp.mean(tf * tf, axis=-1, keepdims=True) + EPS)
    return (y * g.astype(jnp.float32)).astype(t.dtype)


def rope_tables(positions):
    inv = ROPE_THETA ** (-jnp.arange(0, ROPE_DIM, 2, dtype=jnp.float32) / ROPE_DIM)
    ang = positions.astype(jnp.float32)[..., None] * inv
    return jnp.cos(ang)[:, :, None, :], jnp.sin(ang)[:, :, None, :]


def partial_rope(t, cos, sin):
    half = ROPE_DIM // 2
    t1 = t[..., :half].astype(jnp.float32)
    t2 = t[..., half:ROPE_DIM].astype(jnp.float32)
    rot = jnp.concatenate([t1 * cos - t2 * sin, t2 * cos + t1 * sin], axis=-1).astype(t.dtype)
    return jnp.concatenate([rot, t[..., ROPE_DIM:]], axis=-1)


def windowed_gqa(q, k, v, sink):
    b, s = q.shape[0], q.shape[1]
    nb = s // BLOCK
    grp = N_Q_HEADS // N_KV_HEADS
    qb = q.reshape(b, nb, BLOCK, N_KV_HEADS, grp, HEAD_DIM)

    def bands(t):
        tp = jnp.pad(t, ((0, 0), (BLOCK, BLOCK), (0, 0), (0, 0)))
        tp = tp.reshape(b, nb + 2, BLOCK, N_KV_HEADS, HEAD_DIM)
        return jnp.concatenate([tp[:, :-2], tp[:, 1:-1], tp[:, 2:]], axis=2)

    kb, vb = bands(k), bands(v)
    scores = jnp.einsum('bnqhgd,bnkhd->bnhgqk', qb, kb).astype(jnp.float32) * (HEAD_DIM ** -0.5)
    qpos = jnp.arange(s).reshape(nb, BLOCK, 1)
    kpos = (jnp.arange(nb)[:, None, None] - 1) * BLOCK + jnp.arange(3 * BLOCK)[None, None, :]
    valid = (jnp.abs(qpos - kpos) <= WINDOW) & (kpos >= 0) & (kpos < s)
    scores = jnp.where(valid[None, :, None, None], scores, MASK_VALUE)
    sink_col = jnp.broadcast_to(
        sink.astype(jnp.float32).reshape(1, 1, N_KV_HEADS, grp, 1, 1), scores.shape[:-1] + (1,))
    probs = jax.nn.softmax(jnp.concatenate([scores, sink_col], axis=-1), axis=-1)[..., :-1]
    out = jnp.einsum('bnhgqk,bnkhd->bnqhgd', probs.astype(v.dtype), vb)
    return out.reshape(b, s, N_Q_HEADS * HEAD_DIM)


def short_conv(u, w):
    up = jnp.pad(u, ((0, 0), (1, 1), (0, 0)))
    return w[0] * up[:, :-2] + w[1] * up[:, 1:-1] + w[2] * up[:, 2:]


def multiscale_pool(u):
    s = u.shape[1]
    t = jnp.arange(s)
    uf = u.astype(jnp.float32)
    cs = jnp.pad(jnp.cumsum(uf, axis=1), ((0, 0), (1, 0), (0, 0)))
    outs = []
    for gi, w in enumerate(POOL_WINDOWS):
        lo = jnp.clip(t - w // 2, 0, s)
        hi = jnp.clip(t + w // 2, 0, s)
        csg = cs[..., gi * POOL_GROUP:(gi + 1) * POOL_GROUP]
        cnt = (hi - lo).astype(jnp.float32)[None, :, None]
        mean = (jnp.take(csg, hi, axis=1) - jnp.take(csg, lo, axis=1)) / cnt
        outs.append(mean - uf[..., gi * POOL_GROUP:(gi + 1) * POOL_GROUP])
    return jnp.stack(outs, axis=2).astype(u.dtype)


def peer_ffn(h, w_q, sub_keys, expert_u, expert_v):
    b, s, d = h.shape
    n_tok = b * s
    ht = h.reshape(n_tok, d)
    q = (ht @ w_q).reshape(n_tok, PEER_HEADS, PEER_QDIM)
    half = PEER_QDIM // 2
    s1 = jnp.einsum('thd,kd->thk', q[..., :half], sub_keys[0]).astype(jnp.float32)
    s2 = jnp.einsum('thd,kd->thk', q[..., half:], sub_keys[1]).astype(jnp.float32)
    v1, i1 = lax.top_k(s1, PEER_TOPK)
    v2, i2 = lax.top_k(s2, PEER_TOPK)
    cand = (v1[..., :, None] + v2[..., None, :]).reshape(n_tok, PEER_HEADS, PEER_TOPK * PEER_TOPK)
    cidx = (i1[..., :, None] * PEER_NKEYS + i2[..., None, :]).reshape(n_tok, PEER_HEADS, PEER_TOPK * PEER_TOPK)
    top, pos = lax.top_k(cand, PEER_TOPK)
    eidx = jnp.take_along_axis(cidx, pos, axis=-1)
    gate = jax.nn.softmax(top, axis=-1).astype(h.dtype)
    n_chunks = n_tok // PEER_CHUNK

    def chunk(args):
        hc, ec, gc = args
        u = expert_u[ec]
        act = jax.nn.gelu(jnp.einsum('td,thkd->thk', hc, u), approximate=False)
        return jnp.einsum('thk,thkd->td', gc * act, expert_v[ec])

    y = lax.map(chunk, (ht.reshape(n_chunks, PEER_CHUNK, d),
                        eidx.reshape(n_chunks, PEER_CHUNK, PEER_HEADS, PEER_TOPK),
                        gate.reshape(n_chunks, PEER_CHUNK, PEER_HEADS, PEER_TOPK)))
    return y.reshape(b, s, d)


def setup_inputs(seed: int = 0) -> dict:
    key = jax.random.key(seed)
    ks = jax.random.split(key, 20)
    L, D = DEPTH, D_MODEL

    def nrm(k, shape, scale):
        return jax.random.normal(k, shape, jnp.float32) * scale

    return {
        "x": nrm(ks[0], (BATCH, SEQ, D), 1.0),
        "c": nrm(ks[1], (BATCH, D), 1.0),
        "positions": jnp.arange(SEQ, dtype=jnp.int32)[None, :]
                     + jax.random.randint(ks[2], (BATCH, 1), 0, 1024, dtype=jnp.int32),
        "norm1_g": 1.0 + nrm(ks[3], (L, D), 0.02),
        "norm2_g": 1.0 + nrm(ks[4], (L, D), 0.02),
        "w_ada": nrm(ks[5], (L, D, 6 * D), 0.5 * D ** -0.5),
        "b_ada": nrm(ks[6], (L, 6 * D), 0.02),
        "w_in": nrm(ks[7], (L, D, IN_WIDTH), D ** -0.5),
        "q_norm_g": 1.0 + nrm(ks[8], (L, HEAD_DIM), 0.02),
        "k_norm_g": 1.0 + nrm(ks[9], (L, HEAD_DIM), 0.02),
        "attn_sink": nrm(ks[10], (L, N_Q_HEADS), 0.5),
        "conv_w": nrm(ks[11], (L, CONV_K, CONV_WIDTH), CONV_K ** -0.5),
        "pool_w": nrm(ks[12], (L, len(POOL_WINDOWS), POOL_GROUP, POOL_GROUP), POOL_GROUP ** -0.5),
        "pool_scale": 1.0 + nrm(ks[13], (L, POOL_WIDTH), 0.1),
        "w_out": nrm(ks[14], (L, MIX_WIDTH, D), MIX_WIDTH ** -0.5),
        "peer_wq": nrm(ks[15], (L, D, PEER_HEADS * PEER_QDIM), D ** -0.5),
        "peer_keys": nrm(ks[16], (L, 2, PEER_NKEYS, PEER_QDIM // 2), (PEER_QDIM // 2) ** -0.5),
        "peer_u": nrm(ks[17], (L, PEER_EXPERTS, D), D ** -0.5),
        "peer_v": nrm(ks[18], (L, PEER_EXPERTS, D), PEER_HEADS ** -0.5),
    }


def reference(x, c, positions, norm1_g, norm2_g, w_ada, b_ada, w_in, q_norm_g, k_norm_g,
              attn_sink, conv_w, pool_w, pool_scale, w_out, peer_wq, peer_keys, peer_u, peer_v):
    b, s, d = x.shape
    cos, sin = rope_tables(positions)
    c_act = jax.nn.silu(c)
    for l in range(DEPTH):
        mod = (c_act @ w_ada[l] + b_ada[l])[:, None, :]
        shift1, scale1, gate1, shift2, scale2, gate2 = jnp.split(mod, 6, axis=-1)

        h = rms_norm(x, norm1_g[l]) * (1.0 + scale1) + shift1
        z = h @ w_in[l]
        q, k, v, conv_x, conv_b, conv_c, pool_x = jnp.split(z, IN_SPLITS, axis=-1)

        q = q.reshape(b, s, N_Q_HEADS, HEAD_DIM)
        k = k.reshape(b, s, N_KV_HEADS, HEAD_DIM)
        v = v.reshape(b, s, N_KV_HEADS, HEAD_DIM)
        q = partial_rope(rms_norm(q, q_norm_g[l]), cos, sin)
        k = partial_rope(rms_norm(k, k_norm_g[l]), cos, sin)
        attn_o = windowed_gqa(q, k, v, attn_sink[l])

        conv_o = conv_b * short_conv(conv_c * conv_x, conv_w[l])

        pooled = multiscale_pool(pool_x)
        pool_o = jnp.einsum('bsgc,gce->bsge', pooled, pool_w[l]).reshape(b, s, POOL_WIDTH) * pool_scale[l]

        mix = jnp.concatenate([attn_o, conv_o, pool_o], axis=-1) @ w_out[l]
        x = x + gate1 * mix

        h2 = rms_norm(x, norm2_g[l]) * (1.0 + scale2) + shift2
        x = x + gate2 * peer_ffn(h2, peer_wq[l], peer_keys[l], peer_u[l], peer_v[l])
    return x
```

```cpp
#include <hip/hip_runtime.h>
#include <stdint.h>
#include <math.h>

#ifndef BATCH
#define BATCH 8
#endif
#ifndef SEQ
#define SEQ 2048
#endif
#define HD __host__ __device__ __forceinline__

namespace cfg {
constexpr int B = BATCH, S = SEQ, T = B * S, D = 1024, DEPTH = 2;
constexpr int HDIM = 64, NQH = 8, NKVH = 2, GRP = 4, WIN = 128;
constexpr int INW = 1792, OQ = 0, OK_ = 512, OV = 640, OCX = 768, OCB = 1024, OCC = 1280, OPX = 1536;
constexpr int PH = 8, NK = 128, NE = 16384, QD = 256, TOPK = 16, PW = 2048;
constexpr float EPS = 1e-6f;
}
using namespace cfg;

HD float silu_f(float x) { return x / (1.0f + expf(-x)); }
HD float gelu_f(float x) { return 0.5f * x * (1.0f + erff(x * 0.70710678118654752f)); }

HD float mod_elem(const float* c, const float* w_ada_l, const float* b_ada_l, int b, int n) {
    float acc = 0.f;
    for (int k = 0; k < D; ++k) acc += silu_f(c[b * D + k]) * w_ada_l[(size_t)k * (6 * D) + n];
    return acc + b_ada_l[n];
}
HD float row_rstd(const float* xr) {
    float s = 0.f;
    for (int k = 0; k < D; ++k) s += xr[k] * xr[k];
    return 1.0f / sqrtf(s / D + EPS);
}
HD float hmod_elem(float xv, float rstd, float g, const float* mod_b, int which, int k) {
    const float shift = mod_b[(which * 3 + 0) * D + k], scale = mod_b[(which * 3 + 1) * D + k];
    return xv * rstd * g * (1.0f + scale) + shift;
}
HD void qk_prep(const float* src, const float* g, int pos, float* dst) {
    float s = 0.f;
    for (int d = 0; d < HDIM; ++d) s += src[d] * src[d];
    const float r = 1.0f / sqrtf(s / HDIM + EPS);
    for (int d = 16; d < HDIM; ++d) dst[d] = src[d] * r * g[d];
    for (int i = 0; i < 8; ++i) {
        const float inv = powf(500000.0f, -(float)(2 * i) / 16.0f);
        const float ang = (float)pos * inv;
        const float cs = cosf(ang), sn = sinf(ang);
        const float t1 = src[i] * r * g[i], t2 = src[i + 8] * r * g[i + 8];
        dst[i] = t1 * cs - t2 * sn; dst[i + 8] = t2 * cs + t1 * sn;
    }
}
HD float conv_elem(const float* z, const float* conv_w_l, int t, int c) {
    const int s = t % S;
    float acc = 0.f;
    for (int j = 0; j < 3; ++j) {
        const int ss = s + j - 1;
        if (ss < 0 || ss >= S) continue;
        const float* zr = z + (size_t)(t + j - 1) * INW;
        acc += conv_w_l[j * 256 + c] * zr[OCC + c] * zr[OCX + c];
    }
    return z[(size_t)t * INW + OCB + c] * acc;
}
HD float pooled_elem(const float* z, int t, int ch) {
    const int s = t % S, g = ch >> 6, half = 1 << g;
    int lo = s - half, hi = s + half;
    lo = lo < 0 ? 0 : lo; hi = hi > S ? S : hi;
    float acc = 0.f;
    for (int ss = lo; ss < hi; ++ss) acc += z[(size_t)(t - s + ss) * INW + OPX + ch];
    return acc / (float)(hi - lo) - z[(size_t)t * INW + OPX + ch];
}
HD float poolo_elem(const float* pooled, const float* pool_w_l, const float* pool_scale_l, int t, int ch) {
    const int g = ch >> 6, e = ch & 63;
    float acc = 0.f;
    for (int c = 0; c < 64; ++c) acc += pooled[(size_t)t * 256 + g * 64 + c] * pool_w_l[(g * 64 + c) * 64 + e];
    return acc * pool_scale_l[ch];
}
HD float score_elem(const float* qp, const float* keys_l, int row, int col) {
    const int half = col >> 7, n = col & 127;
    const float* q = qp + (size_t)row * QD + half * 128;
    const float* kk = keys_l + ((size_t)half * NK + n) * 128;
    float acc = 0.f;
    for (int d = 0; d < 128; ++d) acc += q[d] * kk[d];
    return acc;
}

HD void attn_row(const float* qn, const float* kn, const float* z, const float* sink_l, int t, int hq, float* mixin) {
    const int s = t % S, b0 = t - s, kvh = hq / GRP;
    float q[64], o[64];
#pragma unroll
    for (int d = 0; d < 64; ++d) { q[d] = qn[(size_t)t * 512 + hq * 64 + d]; o[d] = 0.f; }
    float m = sink_l[hq], l = 1.0f;
    int lo = s - WIN, hi = s + WIN; lo = lo < 0 ? 0 : lo; hi = hi > S - 1 ? S - 1 : hi;
    for (int j = lo; j <= hi; ++j) {
        const float* kr = kn + (size_t)(b0 + j) * 128 + kvh * 64;
        float sc = 0.f;
#pragma unroll
        for (int d = 0; d < 64; ++d) sc += q[d] * kr[d];
        sc *= 0.125f;
        const float mn = fmaxf(m, sc), al = expf(m - mn), p = expf(sc - mn);
        l = l * al + p; m = mn;
        const float* vr = z + (size_t)(b0 + j) * INW + OV + kvh * 64;
#pragma unroll
        for (int d = 0; d < 64; ++d) o[d] = o[d] * al + p * vr[d];
    }
    const float inv = 1.0f / l;
#pragma unroll
    for (int d = 0; d < 64; ++d) mixin[(size_t)t * D + hq * 64 + d] = o[d] * inv;
}
HD void top1_row(const float* sc, float* selv, int* seli, int i) {
    const float* p = sc + (size_t)i * 128;
    float lastv = INFINITY; int lasti = -1;
    for (int r = 0; r < TOPK; ++r) {
        float bv = -INFINITY; int bi = -1;
        for (int n = 0; n < 128; ++n) {
            const float v = p[n];
            const bool elig = (v < lastv) || (v == lastv && n > lasti);
            if (elig && (v > bv)) { bv = v; bi = n; }
        }
        selv[(size_t)i * 16 + r] = bv; seli[(size_t)i * 16 + r] = bi;
        lastv = bv; lasti = bi;
    }
}
HD void top2_row(const float* selv, const int* seli, int* eidx, float* gate, int row) {
    const float* v1 = selv + (size_t)(row * 2) * 16; const float* v2 = v1 + 16;
    const int* i1 = seli + (size_t)(row * 2) * 16; const int* i2 = i1 + 16;
    float lastv = INFINITY; int lasti = -1;
    float top0 = 0.f, den = 0.f;
    for (int r = 0; r < TOPK; ++r) {
        float bv = -INFINITY; int bi = -1;
        for (int n = 0; n < 256; ++n) {
            const float v = v1[n >> 4] + v2[n & 15];
            const bool elig = (v < lastv) || (v == lastv && n > lasti);
            if (elig && (v > bv)) { bv = v; bi = n; }
        }
        if (r == 0) top0 = bv;
        const float e = expf(bv - top0);
        den += e;
        gate[(size_t)row * 16 + r] = e;
        eidx[(size_t)row * 16 + r] = i1[bi >> 4] * NK + i2[bi & 15];
        lastv = bv; lasti = bi;
    }
    const float inv = 1.0f / den;
    for (int r = 0; r < TOPK; ++r) gate[(size_t)row * 16 + r] *= inv;
}

#ifndef HOST_TEST
__global__ void k_mod(const float* c, const float* w_ada, const float* b_ada, float* mod) {
    const int i = blockIdx.x * 256 + threadIdx.x;
    if (i >= DEPTH * B * 6 * D) return;
    const int n = i % (6 * D), b = (i / (6 * D)) % B, l = i / (6 * D * B);
    mod[i] = mod_elem(c, w_ada + (size_t)l * D * 6 * D, b_ada + (size_t)l * 6 * D, b, n);
}
__global__ void k_hmod(const float* x, const float* g, const float* mod_l, int which, float* h) {
    const int row = blockIdx.x * 4 + (threadIdx.x >> 6), lane = threadIdx.x & 63;
    if (row >= T) return;
    const float* xr = x + (size_t)row * D;
    float s = 0.f;
    for (int k = lane; k < D; k += 64) s += xr[k] * xr[k];
    for (int o = 32; o; o >>= 1) s += __shfl_xor(s, o);
    const float rstd = 1.0f / sqrtf(s / D + EPS);
    const float* mod_b = mod_l + (size_t)(row / S) * 6 * D;
    for (int k = lane; k < D; k += 64) h[(size_t)row * D + k] = hmod_elem(xr[k], rstd, g[k], mod_b, which, k);
}
__global__ void k_gemm(const float* __restrict__ A, const float* __restrict__ Bm, float* __restrict__ C, int M, int N, int K) {
    __shared__ float As[16][64 + 1], Bs[16][64 + 1];
    const int tx = threadIdx.x & 15, ty = threadIdx.x >> 4, m0 = blockIdx.y * 64, n0 = blockIdx.x * 64;
    float acc[4][4];
#pragma unroll
    for (int i = 0; i < 4; ++i)
#pragma unroll
        for (int j = 0; j < 4; ++j) acc[i][j] = 0.f;
    for (int k0 = 0; k0 < K; k0 += 16) {
        for (int e = threadIdx.x; e < 64 * 16; e += 256) {
            const int r = e >> 4, kk = e & 15;
            As[kk][r] = A[(size_t)(m0 + r) * K + k0 + kk];
            const int kb = e >> 6, cb = e & 63;
            Bs[kb][cb] = Bm[(size_t)(k0 + kb) * N + n0 + cb];
        }
        __syncthreads();
#pragma unroll
        for (int kk = 0; kk < 16; ++kk) {
            float a[4], b[4];
#pragma unroll
            for (int i = 0; i < 4; ++i) { a[i] = As[kk][ty * 4 + i]; b[i] = Bs[kk][tx * 4 + i]; }
#pragma unroll
            for (int i = 0; i < 4; ++i)
#pragma unroll
                for (int j = 0; j < 4; ++j) acc[i][j] += a[i] * b[j];
        }
        __syncthreads();
    }
#pragma unroll
    for (int i = 0; i < 4; ++i)
#pragma unroll
        for (int j = 0; j < 4; ++j) C[(size_t)(m0 + ty * 4 + i) * N + n0 + tx * 4 + j] = acc[i][j];
}
__global__ void k_qkprep(const float* z, const float* qg, const float* kg, const int* positions, float* qn, float* kn) {
    const int i = blockIdx.x * 256 + threadIdx.x;
    if (i >= T * 10) return;
    const int t = i / 10, hh = i % 10;
    const int pos = positions[t];
    if (hh < 8) qk_prep(z + (size_t)t * INW + OQ + hh * 64, qg, pos, qn + (size_t)t * 512 + hh * 64);
    else        qk_prep(z + (size_t)t * INW + OK_ + (hh - 8) * 64, kg, pos, kn + (size_t)t * 128 + (hh - 8) * 64);
}
__global__ void __launch_bounds__(64) k_attn(const float* qn, const float* kn, const float* z, const float* sink_l, float* mixin) {
    const int i = blockIdx.x * 64 + threadIdx.x;
    if (i >= T * NQH) return;
    attn_row(qn, kn, z, sink_l, i / NQH, i % NQH, mixin);
}
__global__ void k_conv_pooled(const float* z, const float* conv_w_l, float* mixin, float* pooled) {
    const int i = blockIdx.x * 256 + threadIdx.x;
    if (i >= T * 256) return;
    const int t = i >> 8, c = i & 255;
    mixin[(size_t)t * D + 512 + c] = conv_elem(z, conv_w_l, t, c);
    pooled[i] = pooled_elem(z, t, c);
}
__global__ void k_poolo(const float* pooled, const float* pool_w_l, const float* pool_scale_l, float* mixin) {
    const int i = blockIdx.x * 256 + threadIdx.x;
    if (i >= T * 256) return;
    const int t = i >> 8, c = i & 255;
    mixin[(size_t)t * D + 768 + c] = poolo_elem(pooled, pool_w_l, pool_scale_l, t, c);
}
__global__ void k_resid(const float* xi, const float* y, const float* mod_l, int which, float* xo) {
    const size_t i = (size_t)blockIdx.x * 256 + threadIdx.x;
    if (i >= (size_t)T * D) return;
    const int n = (int)(i % D), t = (int)(i / D);
    xo[i] = xi[i] + mod_l[(size_t)(t / S) * 6 * D + (which * 3 + 2) * D + n] * y[i];
}
__global__ void k_score(const float* qp, const float* keys_l, float* sc) {
    const size_t i = (size_t)blockIdx.x * 256 + threadIdx.x;
    if (i >= (size_t)T * PH * 256) return;
    sc[i] = score_elem(qp, keys_l, (int)(i >> 8), (int)(i & 255));
}
__global__ void k_top1(const float* sc, float* selv, int* seli) {
    const int i = blockIdx.x * 256 + threadIdx.x;
    if (i >= T * PH * 2) return;
    top1_row(sc, selv, seli, i);
}
__global__ void k_top2(const float* selv, const int* seli, int* eidx, float* gate) {
    const int row = blockIdx.x * 256 + threadIdx.x;
    if (row >= T * PH) return;
    top2_row(selv, seli, eidx, gate, row);
}
__global__ void k_peer_u(const float* h2, const float* u_l, const int* eidx, const float* gate, float* wact) {
    const int i = blockIdx.x * 4 + (threadIdx.x >> 6), lane = threadIdx.x & 63;
    if (i >= T * 128) return;
    const int t = i >> 7;
    const float* ur = u_l + (size_t)eidx[i] * D; const float* hr = h2 + (size_t)t * D;
    float s = 0.f;
    for (int k = lane; k < D; k += 64) s += hr[k] * ur[k];
    for (int o = 32; o; o >>= 1) s += __shfl_xor(s, o);
    if (lane == 0) wact[i] = gate[i] * gelu_f(s);
}
__global__ void k_peer_v(const float* x1, const float* v_l, const int* eidx, const float* wact, const float* mod_l, float* x2) {
    const int t = blockIdx.x;
    float acc[4] = {0.f, 0.f, 0.f, 0.f};
    for (int k = 0; k < 128; ++k) {
        const float w = wact[(size_t)t * 128 + k]; const float* vr = v_l + (size_t)eidx[(size_t)t * 128 + k] * D;
#pragma unroll
        for (int j = 0; j < 4; ++j) acc[j] += w * vr[threadIdx.x + 256 * j];
    }
    const float* g2 = mod_l + (size_t)(t / S) * 6 * D + 5 * D;
#pragma unroll
    for (int j = 0; j < 4; ++j) { const int n = threadIdx.x + 256 * j; x2[(size_t)t * D + n] = x1[(size_t)t * D + n] + g2[n] * acc[j]; }
}

extern "C" void kernel_launch(void* const* d_in, const int* in_sizes, int n_in, void* d_out, int out_size, void* d_ws, size_t ws_size, hipStream_t stream) {
    const float* x = (const float*)d_in[0]; const float* c = (const float*)d_in[1]; const int* positions = (const int*)d_in[2];
    const float* norm1_g = (const float*)d_in[3]; const float* norm2_g = (const float*)d_in[4];
    const float* w_ada = (const float*)d_in[5]; const float* b_ada = (const float*)d_in[6]; const float* w_in = (const float*)d_in[7];
    const float* q_norm_g = (const float*)d_in[8]; const float* k_norm_g = (const float*)d_in[9]; const float* attn_sink = (const float*)d_in[10];
    const float* conv_w = (const float*)d_in[11]; const float* pool_w = (const float*)d_in[12]; const float* pool_scale = (const float*)d_in[13];
    const float* w_out = (const float*)d_in[14]; const float* peer_wq = (const float*)d_in[15]; const float* peer_keys = (const float*)d_in[16];
    const float* peer_u = (const float*)d_in[17]; const float* peer_v = (const float*)d_in[18];
    float* out = (float*)d_out;
    char* ws = (char*)d_ws; size_t off = 0;
    auto carve = [&](size_t bytes) { char* p = ws + off; off += (bytes + 255) & ~(size_t)255; return p; };
    float* mod = (float*)carve((size_t)DEPTH * B * 6 * D * 4);
    float* h = (float*)carve((size_t)T * D * 4);
    float* R1 = (float*)carve((size_t)T * PW * 4);
    char* R2 = carve((size_t)T * (512 + 128 + 256 + 1024 + 1024) * 4);
    float* x1 = (float*)carve((size_t)T * D * 4);
    float* selv = (float*)carve((size_t)T * PH * 2 * 16 * 4); int* seli = (int*)carve((size_t)T * PH * 2 * 16 * 4);
    int* eidx = (int*)carve((size_t)T * 128 * 4); float* gate = (float*)carve((size_t)T * 128 * 4); float* wact = (float*)carve((size_t)T * 128 * 4);
    if (off > ws_size) return;
    float* z = R1; float* qp = R1;
    float* qn = (float*)R2; float* kn = qn + (size_t)T * 512; float* pooled = kn + (size_t)T * 128; float* mixin = pooled + (size_t)T * 256; float* mix = mixin + (size_t)T * D;
    float* sc = (float*)R2;
    k_mod<<<(DEPTH * B * 6 * D + 255) / 256, 256, 0, stream>>>(c, w_ada, b_ada, mod);
    const float* xin = x;
    for (int l = 0; l < DEPTH; ++l) {
        const float* mod_l = mod + (size_t)l * B * 6 * D;
        k_hmod<<<T / 4, 256, 0, stream>>>(xin, norm1_g + l * D, mod_l, 0, h);
        k_gemm<<<dim3(INW / 64, T / 64), 256, 0, stream>>>(h, w_in + (size_t)l * D * INW, z, T, INW, D);
        k_qkprep<<<(T * 10 + 255) / 256, 256, 0, stream>>>(z, q_norm_g + l * 64, k_norm_g + l * 64, positions, qn, kn);
        k_attn<<<(T * NQH + 63) / 64, 64, 0, stream>>>(qn, kn, z, attn_sink + l * NQH, mixin);
        k_conv_pooled<<<T, 256, 0, stream>>>(z, conv_w + l * 3 * 256, mixin, pooled);
        k_poolo<<<T, 256, 0, stream>>>(pooled, pool_w + (size_t)l * 4 * 64 * 64, pool_scale + l * 256, mixin);
        k_gemm<<<dim3(D / 64, T / 64), 256, 0, stream>>>(mixin, w_out + (size_t)l * D * D, mix, T, D, D);
        k_resid<<<T * D / 256, 256, 0, stream>>>(xin, mix, mod_l, 0, x1);
        k_hmod<<<T / 4, 256, 0, stream>>>(x1, norm2_g + l * D, mod_l, 1, h);
        k_gemm<<<dim3(PW / 64, T / 64), 256, 0, stream>>>(h, peer_wq + (size_t)l * D * PW, qp, T, PW, D);
        k_score<<<T * PH, 256, 0, stream>>>(qp, peer_keys + (size_t)l * 2 * NK * 128, sc);
        k_top1<<<(T * PH * 2 + 255) / 256, 256, 0, stream>>>(sc, selv, seli);
        k_top2<<<(T * PH + 255) / 256, 256, 0, stream>>>(selv, seli, eidx, gate);
        k_peer_u<<<T * 128 / 4, 256, 0, stream>>>(h, peer_u + (size_t)l * NE * D, eidx, gate, wact);
        k_peer_v<<<T, 256, 0, stream>>>(x1, peer_v + (size_t)l * NE * D, eidx, wact, mod_l, out);
        xin = out;
    }
}
#endif
```

```cpp
#include <hip/hip_runtime.h>
#include <stdint.h>
#include <math.h>
#include <cstdio>
#ifndef Z_F32
#define Z_F32 1
#endif
#ifndef QP_F32
#define QP_F32 1
#endif
#ifndef DO_UV
#define DO_UV 0
#endif

#ifndef BATCH
#define BATCH 8
#endif
#ifndef SEQ
#define SEQ 2048
#endif
#define HD __host__ __device__ __forceinline__

namespace cfg {
constexpr int B = BATCH, S = SEQ, T = B * S, D = 1024, DEPTH = 2;
constexpr int HDIM = 64, NQH = 8, NKVH = 2, GRP = 4, WIN = 128;
constexpr int INW = 1792, OQ = 0, OK_ = 512, OV = 640, OCX = 768, OCB = 1024, OCC = 1280, OPX = 1536;
constexpr int PH = 8, NK = 128, NE = 16384, QD = 256, TOPK = 16, PW = 2048;
constexpr float EPS = 1e-6f;
}
using namespace cfg;

HD float silu_f(float x) { return x / (1.0f + expf(-x)); }
HD float gelu_f(float x) { return 0.5f * x * (1.0f + erff(x * 0.70710678118654752f)); }

HD float mod_elem(const float* c, const float* w_ada_l, const float* b_ada_l, int b, int n) {
    float acc = 0.f;
    for (int k = 0; k < D; ++k) acc += silu_f(c[b * D + k]) * w_ada_l[(size_t)k * (6 * D) + n];
    return acc + b_ada_l[n];
}
HD float row_rstd(const float* xr) {
    float s = 0.f;
    for (int k = 0; k < D; ++k) s += xr[k] * xr[k];
    return 1.0f / sqrtf(s / D + EPS);
}
HD float hmod_elem(float xv, float rstd, float g, const float* mod_b, int which, int k) {
    const float shift = mod_b[(which * 3 + 0) * D + k], scale = mod_b[(which * 3 + 1) * D + k];
    return xv * rstd * g * (1.0f + scale) + shift;
}
HD void qk_prep(const float* src, const float* g, int pos, float* dst) {
    float s = 0.f;
    for (int d = 0; d < HDIM; ++d) s += src[d] * src[d];
    const float r = 1.0f / sqrtf(s / HDIM + EPS);
    for (int d = 16; d < HDIM; ++d) dst[d] = src[d] * r * g[d];
    for (int i = 0; i < 8; ++i) {
        const float inv = powf(500000.0f, -(float)(2 * i) / 16.0f);
        const float ang = (float)pos * inv;
        const float cs = cosf(ang), sn = sinf(ang);
        const float t1 = src[i] * r * g[i], t2 = src[i + 8] * r * g[i + 8];
        dst[i] = t1 * cs - t2 * sn; dst[i + 8] = t2 * cs + t1 * sn;
    }
}
HD float conv_elem(const float* z, const float* conv_w_l, int t, int c) {
    const int s = t % S;
    float acc = 0.f;
    for (int j = 0; j < 3; ++j) {
        const int ss = s + j - 1;
        if (ss < 0 || ss >= S) continue;
        const float* zr = z + (size_t)(t + j - 1) * INW;
        acc += conv_w_l[j * 256 + c] * zr[OCC + c] * zr[OCX + c];
    }
    return z[(size_t)t * INW + OCB + c] * acc;
}
HD float pooled_elem(const float* z, int t, int ch) {
    const int s = t % S, g = ch >> 6, half = 1 << g;
    int lo = s - half, hi = s + half;
    lo = lo < 0 ? 0 : lo; hi = hi > S ? S : hi;
    float acc = 0.f;
    for (int ss = lo; ss < hi; ++ss) acc += z[(size_t)(t - s + ss) * INW + OPX + ch];
    return acc / (float)(hi - lo) - z[(size_t)t * INW + OPX + ch];
}
HD float poolo_elem(const float* pooled, const float* pool_w_l, const float* pool_scale_l, int t, int ch) {
    const int g = ch >> 6, e = ch & 63;
    float acc = 0.f;
    for (int c = 0; c < 64; ++c) acc += pooled[(size_t)t * 256 + g * 64 + c] * pool_w_l[(g * 64 + c) * 64 + e];
    return acc * pool_scale_l[ch];
}
HD float score_elem(const float* qp, const float* keys_l, int row, int col) {
    const int half = col >> 7, n = col & 127;
    const float* q = qp + (size_t)row * QD + half * 128;
    const float* kk = keys_l + ((size_t)half * NK + n) * 128;
    float acc = 0.f;
    for (int d = 0; d < 128; ++d) acc += q[d] * kk[d];
    return acc;
}

HD void attn_row(const float* qn, const float* kn, const float* z, const float* sink_l, int t, int hq, float* mixin) {
    const int s = t % S, b0 = t - s, kvh = hq / GRP;
    float q[64], o[64];
#pragma unroll
    for (int d = 0; d < 64; ++d) { q[d] = qn[(size_t)t * 512 + hq * 64 + d]; o[d] = 0.f; }
    float m = sink_l[hq], l = 1.0f;
    int lo = s - WIN, hi = s + WIN; lo = lo < 0 ? 0 : lo; hi = hi > S - 1 ? S - 1 : hi;
    for (int j = lo; j <= hi; ++j) {
        const float* kr = kn + (size_t)(b0 + j) * 128 + kvh * 64;
        float sc = 0.f;
#pragma unroll
        for (int d = 0; d < 64; ++d) sc += q[d] * kr[d];
        sc *= 0.125f;
        const float mn = fmaxf(m, sc), al = expf(m - mn), p = expf(sc - mn);
        l = l * al + p; m = mn;
        const float* vr = z + (size_t)(b0 + j) * INW + OV + kvh * 64;
#pragma unroll
        for (int d = 0; d < 64; ++d) o[d] = o[d] * al + p * vr[d];
    }
    const float inv = 1.0f / l;
#pragma unroll
    for (int d = 0; d < 64; ++d) mixin[(size_t)t * D + hq * 64 + d] = o[d] * inv;
}
HD void top1_row(const float* sc, float* selv, int* seli, int i) {
    const float* p = sc + (size_t)i * 128;
    float lastv = INFINITY; int lasti = -1;
    for (int r = 0; r < TOPK; ++r) {
        float bv = -INFINITY; int bi = -1;
        for (int n = 0; n < 128; ++n) {
            const float v = p[n];
            const bool elig = (v < lastv) || (v == lastv && n > lasti);
            if (elig && (v > bv)) { bv = v; bi = n; }
        }
        selv[(size_t)i * 16 + r] = bv; seli[(size_t)i * 16 + r] = bi;
        lastv = bv; lasti = bi;
    }
}
HD void top2_row(const float* selv, const int* seli, int* eidx, float* gate, int row) {
    const float* v1 = selv + (size_t)(row * 2) * 16; const float* v2 = v1 + 16;
    const int* i1 = seli + (size_t)(row * 2) * 16; const int* i2 = i1 + 16;
    float lastv = INFINITY; int lasti = -1;
    float top0 = 0.f, den = 0.f;
    for (int r = 0; r < TOPK; ++r) {
        float bv = -INFINITY; int bi = -1;
        for (int n = 0; n < 256; ++n) {
            const float v = v1[n >> 4] + v2[n & 15];
            const bool elig = (v < lastv) || (v == lastv && n > lasti);
            if (elig && (v > bv)) { bv = v; bi = n; }
        }
        if (r == 0) top0 = bv;
        const float e = expf(bv - top0);
        den += e;
        gate[(size_t)row * 16 + r] = e;
        eidx[(size_t)row * 16 + r] = i1[bi >> 4] * NK + i2[bi & 15];
        lastv = bv; lasti = bi;
    }
    const float inv = 1.0f / den;
    for (int r = 0; r < TOPK; ++r) gate[(size_t)row * 16 + r] *= inv;
}

#ifndef HOST_TEST
__global__ void k_mod(const float* c, const float* w_ada, const float* b_ada, float* mod) {
    const int i = blockIdx.x * 256 + threadIdx.x;
    if (i >= DEPTH * B * 6 * D) return;
    const int n = i % (6 * D), b = (i / (6 * D)) % B, l = i / (6 * D * B);
    mod[i] = mod_elem(c, w_ada + (size_t)l * D * 6 * D, b_ada + (size_t)l * 6 * D, b, n);
}
__global__ void k_hmod(const float* x, const float* g, const float* mod_l, int which, float* h) {
    const int row = blockIdx.x * 4 + (threadIdx.x >> 6), lane = threadIdx.x & 63;
    if (row >= T) return;
    const float* xr = x + (size_t)row * D;
    float s = 0.f;
    for (int k = lane; k < D; k += 64) s += xr[k] * xr[k];
    for (int o = 32; o; o >>= 1) s += __shfl_xor(s, o);
    const float rstd = 1.0f / sqrtf(s / D + EPS);
    const float* mod_b = mod_l + (size_t)(row / S) * 6 * D;
    for (int k = lane; k < D; k += 64) h[(size_t)row * D + k] = hmod_elem(xr[k], rstd, g[k], mod_b, which, k);
}
__global__ void k_gemm(const float* __restrict__ A, const float* __restrict__ Bm, float* __restrict__ C, int M, int N, int K) {
    __shared__ float As[16][64 + 1], Bs[16][64 + 1];
    const int tx = threadIdx.x & 15, ty = threadIdx.x >> 4, m0 = blockIdx.y * 64, n0 = blockIdx.x * 64;
    float acc[4][4];
#pragma unroll
    for (int i = 0; i < 4; ++i)
#pragma unroll
        for (int j = 0; j < 4; ++j) acc[i][j] = 0.f;
    for (int k0 = 0; k0 < K; k0 += 16) {
        for (int e = threadIdx.x; e < 64 * 16; e += 256) {
            const int r = e >> 4, kk = e & 15;
            As[kk][r] = A[(size_t)(m0 + r) * K + k0 + kk];
            const int kb = e >> 6, cb = e & 63;
            Bs[kb][cb] = Bm[(size_t)(k0 + kb) * N + n0 + cb];
        }
        __syncthreads();
#pragma unroll
        for (int kk = 0; kk < 16; ++kk) {
            float a[4], b[4];
#pragma unroll
            for (int i = 0; i < 4; ++i) { a[i] = As[kk][ty * 4 + i]; b[i] = Bs[kk][tx * 4 + i]; }
#pragma unroll
            for (int i = 0; i < 4; ++i)
#pragma unroll
                for (int j = 0; j < 4; ++j) acc[i][j] += a[i] * b[j];
        }
        __syncthreads();
    }
#pragma unroll
    for (int i = 0; i < 4; ++i)
#pragma unroll
        for (int j = 0; j < 4; ++j) C[(size_t)(m0 + ty * 4 + i) * N + n0 + tx * 4 + j] = acc[i][j];
}
__global__ void k_qkprep(const float* z, const float* qg, const float* kg, const int* positions, float* qn, float* kn) {
    const int i = blockIdx.x * 256 + threadIdx.x;
    if (i >= T * 10) return;
    const int t = i / 10, hh = i % 10;
    const int pos = positions[t];
    if (hh < 8) qk_prep(z + (size_t)t * INW + OQ + hh * 64, qg, pos, qn + (size_t)t * 512 + hh * 64);
    else        qk_prep(z + (size_t)t * INW + OK_ + (hh - 8) * 64, kg, pos, kn + (size_t)t * 128 + (hh - 8) * 64);
}
__global__ void __launch_bounds__(64) k_attn(const float* qn, const float* kn, const float* z, const float* sink_l, float* mixin) {
    const int i = blockIdx.x * 64 + threadIdx.x;
    if (i >= T * NQH) return;
    attn_row(qn, kn, z, sink_l, i / NQH, i % NQH, mixin);
}
__global__ void k_conv_pooled(const float* z, const float* conv_w_l, float* mixin, float* pooled) {
    const int i = blockIdx.x * 256 + threadIdx.x;
    if (i >= T * 256) return;
    const int t = i >> 8, c = i & 255;
    mixin[(size_t)t * D + 512 + c] = conv_elem(z, conv_w_l, t, c);
    pooled[i] = pooled_elem(z, t, c);
}
__global__ void k_poolo(const float* pooled, const float* pool_w_l, const float* pool_scale_l, float* mixin) {
    const int i = blockIdx.x * 256 + threadIdx.x;
    if (i >= T * 256) return;
    const int t = i >> 8, c = i & 255;
    mixin[(size_t)t * D + 768 + c] = poolo_elem(pooled, pool_w_l, pool_scale_l, t, c);
}
__global__ void k_resid(const float* xi, const float* y, const float* mod_l, int which, float* xo) {
    const size_t i = (size_t)blockIdx.x * 256 + threadIdx.x;
    if (i >= (size_t)T * D) return;
    const int n = (int)(i % D), t = (int)(i / D);
    xo[i] = xi[i] + mod_l[(size_t)(t / S) * 6 * D + (which * 3 + 2) * D + n] * y[i];
}
__global__ void k_score(const float* qp, const float* keys_l, float* sc) {
    const size_t i = (size_t)blockIdx.x * 256 + threadIdx.x;
    if (i >= (size_t)T * PH * 256) return;
    sc[i] = score_elem(qp, keys_l, (int)(i >> 8), (int)(i & 255));
}
__global__ void k_top1(const float* sc, float* selv, int* seli) {
    const int i = blockIdx.x * 256 + threadIdx.x;
    if (i >= T * PH * 2) return;
    top1_row(sc, selv, seli, i);
}
__global__ void k_top2(const float* selv, const int* seli, int* eidx, float* gate) {
    const int row = blockIdx.x * 256 + threadIdx.x;
    if (row >= T * PH) return;
    top2_row(selv, seli, eidx, gate, row);
}
__global__ void k_peer_u(const float* h2, const float* u_l, const int* eidx, const float* gate, float* wact) {
    const int i = blockIdx.x * 4 + (threadIdx.x >> 6), lane = threadIdx.x & 63;
    if (i >= T * 128) return;
    const int t = i >> 7;
    const float* ur = u_l + (size_t)eidx[i] * D; const float* hr = h2 + (size_t)t * D;
    float s = 0.f;
    for (int k = lane; k < D; k += 64) s += hr[k] * ur[k];
    for (int o = 32; o; o >>= 1) s += __shfl_xor(s, o);
    if (lane == 0) wact[i] = gate[i] * gelu_f(s);
}
__global__ void k_peer_v(const float* x1, const float* v_l, const int* eidx, const float* wact, const float* mod_l, float* x2) {
    const int t = blockIdx.x;
    float acc[4] = {0.f, 0.f, 0.f, 0.f};
    for (int k = 0; k < 128; ++k) {
        const float w = wact[(size_t)t * 128 + k]; const float* vr = v_l + (size_t)eidx[(size_t)t * 128 + k] * D;
#pragma unroll
        for (int j = 0; j < 4; ++j) acc[j] += w * vr[threadIdx.x + 256 * j];
    }
    const float* g2 = mod_l + (size_t)(t / S) * 6 * D + 5 * D;
#pragma unroll
    for (int j = 0; j < 4; ++j) { const int n = threadIdx.x + 256 * j; x2[(size_t)t * D + n] = x1[(size_t)t * D + n] + g2[n] * acc[j]; }
}


namespace pg8 {
#define PG8_LAS __attribute__((address_space(3)))
typedef unsigned short bf16_t;
typedef short bf16x8 __attribute__((ext_vector_type(8)));
typedef float f32x4 __attribute__((ext_vector_type(4)));
typedef unsigned u32x4 __attribute__((ext_vector_type(4)));
constexpr int BM = 256, BK = 64, HALF = 128, HTB = HALF * BK * 2  , STAGE_BYTES = 8 * HTB, NXCD = 8, WGM = 8;

__host__ __device__ __forceinline__ int lds_byte(int r, int c) { const int st = (r >> 4) * 2 + (c >> 5), rr = r & 15, cc = c & 31, ob = rr * 64 + cc * 2; return st * 1024 + (ob ^ (((ob >> 9) & 1) << 5)); }
__host__ __device__ __forceinline__ void stage_rc(int b, int& R, int& C) { const int st = b / 1024, sb = b % 1024, swz = sb ^ (((sb >> 9) & 1) << 5); R = (st >> 1) * 16 + swz / 64; C = (st & 1) * 32 + (swz % 64) / 2; }
__host__ __device__ __forceinline__ int perm32(int rho) { const int n = rho >> 4, i = rho & 15; return 8 * (i >> 2) + 4 * n + (i & 3); }

struct Unit { int pm, pn; };
struct Gemm { const bf16_t* A; const bf16_t* Bt; int M, N, K; };

struct StaticOrder {
    int nM, nN, nwg, G, c;
    __host__ __device__ void init(int M, int N, int G_, int c_) { nM = M / BM; nN = N / BM; nwg = nM * nN; G = G_; c = c_; }
    __host__ __device__ bool next(int i, Unit& u) const {
        const long L = (long)i * G + c; if (L >= nwg) return false;
        int wgid = (int)L; { const int q = nwg / NXCD, r = nwg % NXCD, xcd = wgid % NXCD, off = wgid / NXCD; wgid = (xcd < r ? xcd * (q + 1) : r * (q + 1) + (xcd - r) * q) + off; }
        const int nig = WGM * nN, gid = wgid / nig, fm = gid * WGM, gsz = (nM - fm) < WGM ? (nM - fm) : WGM;
        u.pm = fm + ((wgid % nig) % gsz); u.pn = (wgid % nig) / gsz; return true;
    }
    __device__ __forceinline__ void a_ready(const Unit&) const {}
    __device__ __forceinline__ void done(const Unit&) const {}
};

__device__ __forceinline__ unsigned cvt_pk_bf16(float lo, float hi) { unsigned r; asm volatile("v_cvt_pk_bf16_f32 %0, %1, %2" : "=v"(r) : "v"(lo), "v"(hi)); return r; }
typedef float f32x2 __attribute__((ext_vector_type(2)));
__device__ __forceinline__ f32x2 gelu_pk(f32x2 v) {
    const f32x2 av = __builtin_elementwise_abs(v), d = av * 0.2316418882f + 1.0f;
    f32x2 t; t.x = __builtin_amdgcn_rcpf(d.x); t.y = __builtin_amdgcn_rcpf(d.y);
    f32x2 q = t * 0.5307027145f + (-0.7265760135f); q = q * t + 0.7107068705f; q = q * t + (-0.142248368f); q = q * t + 0.127414796f; q = q * t;
    const f32x2 s = (v * v) * (-0.72134752044f);
    f32x2 e; e.x = __builtin_amdgcn_exp2f(s.x); e.y = __builtin_amdgcn_exp2f(s.y);
    const f32x2 m = v * (q * e), r = v - m;
    f32x2 o; o.x = v.x < 0.f ? m.x : r.x; o.y = v.y < 0.f ? m.y : r.y; return o;
}

template <int ACT  > struct EpiBf16 {
    static constexpr bool PERM = true, AFTER_DRAIN = false; static_assert(ACT == 0 || ACT == 1, "EpiBf16: ACT is 0 (none) or 1 (gelu_pk)");
    bf16_t* O; int ldc; const float* bias; int split_cols; size_t split_stride; float scale0;
    __device__ __forceinline__ void operator()(const f32x4 (&acc)[2][2][4][2], const Unit& u, int wr, int wc, int fr, int fq) const {
        const int row0 = u.pm * BM + wr * 64 + fr; int colt = u.pn * BM; bf16_t* base = O;
        float sc = 1.f; if (split_cols) { const int t = colt / split_cols; base += (size_t)t * split_stride; colt -= t * split_cols; if (t == 0) sc = scale0; }
        const int col0 = colt + wc * 32 + 8 * fq, bcol0 = u.pn * BM + wc * 32 + 8 * fq;
        f32x4 bv[2][2];
#pragma unroll
        for (int bj = 0; bj < 2; ++bj)
#pragma unroll
            for (int n = 0; n < 2; ++n) bv[bj][n] = bias ? *(const f32x4*)(bias + bcol0 + bj * HALF + 4 * n) : (f32x4){0.f, 0.f, 0.f, 0.f};
#pragma unroll
        for (int ai = 0; ai < 2; ++ai)
#pragma unroll
            for (int m = 0; m < 4; ++m) { bf16_t* rowp = base + (size_t)(row0 + ai * HALF + m * 16) * ldc + col0;
#pragma unroll
                for (int bj = 0; bj < 2; ++bj) { f32x4 v0 = acc[ai][bj][m][0] + bv[bj][0], v1 = acc[ai][bj][m][1] + bv[bj][1];
                    if (ACT == 1) { f32x2 a = gelu_pk((f32x2){v0[0], v0[1]}), b = gelu_pk((f32x2){v0[2], v0[3]}), c = gelu_pk((f32x2){v1[0], v1[1]}), d = gelu_pk((f32x2){v1[2], v1[3]});
                        v0 = (f32x4){a.x, a.y, b.x, b.y}; v1 = (f32x4){c.x, c.y, d.x, d.y}; }
                    v0 = v0 * sc; v1 = v1 * sc; u32x4 w; w.x = cvt_pk_bf16(v0[0], v0[1]); w.y = cvt_pk_bf16(v0[2], v0[3]); w.z = cvt_pk_bf16(v1[0], v1[1]); w.w = cvt_pk_bf16(v1[2], v1[3]);
                    *(u32x4*)(rowp + bj * HALF) = w; } }
    }
};

template <class Epi, class Sched, bool ALIGN_EPI = false, bool SP2 = false>
__device__ __forceinline__ void gemm_phase(PG8_LAS unsigned char* lds, const Gemm g, const Sched& S, const Epi& E) {
    const int tid = threadIdx.x, wid = __builtin_amdgcn_readfirstlane(tid >> 6), lane = tid & 63, wr = wid >> 2, wc = wid & 3, fr = lane & 15, fq = lane >> 4;
    const int K = g.K, nt = K / BK;
    unsigned voffA[2], voffB[2];
#pragma unroll
    for (int i = 0; i < 2; ++i) { int R, C; stage_rc(tid * 16 + i * 8192, R, C); const int Rb = Epi::PERM ? ((R & ~31) + perm32(R & 31)) : R;
        voffA[i] = (unsigned)(R * K + C) * 2u; voffB[i] = (unsigned)(Rb * K + C) * 2u; }
    const size_t kstep = (size_t)(BK * 2);
    const size_t hstep = (size_t)HALF * K * 2;
    const size_t tstep = 2 * hstep;
    const unsigned ldsw = (unsigned)wid * 1024u;
    const int aoff = lds_byte(wr * 64 + fr, fq * 8), boff = lds_byte(wc * 32 + fr, fq * 8);
#define PG8_SA(b, h) (((b) * 2 + (h)) * HTB)
#define PG8_SB(b, h) ((4 + (b) * 2 + (h)) * HTB)
#define PG8_STAGE(bufoff, gbase, voff) do { _Pragma("unroll") for (int _i = 0; _i < 2; ++_i) \
        __builtin_amdgcn_global_load_lds((const unsigned*)((const char*)(gbase) + (voff)[_i]), (PG8_LAS unsigned*)(lds + (bufoff) + ldsw + _i * 8192), 16, 0, 0); } while (0)
#define PG8_LDA(dst, b, h) do { _Pragma("unroll") for (int m = 0; m < 4; ++m) _Pragma("unroll") for (int k = 0; k < 2; ++k) dst[m][k] = *(const PG8_LAS bf16x8*)(lds + PG8_SA(b, h) + aoff + m * 2048 + k * 1024); } while (0)
#define PG8_LDB(dst, b, h) do { _Pragma("unroll") for (int n = 0; n < 2; ++n) _Pragma("unroll") for (int k = 0; k < 2; ++k) dst[n][k] = *(const PG8_LAS bf16x8*)(lds + PG8_SB(b, h) + boff + n * 2048 + k * 1024); } while (0)
#define PG8_MMA(ai, bj, At, Bt) do { __builtin_amdgcn_s_setprio(1); _Pragma("unroll") for (int m = 0; m < 4; ++m) _Pragma("unroll") for (int n = 0; n < 2; ++n) _Pragma("unroll") for (int k = 0; k < 2; ++k) \
        acc[ai][bj][m][n] = __builtin_amdgcn_mfma_f32_16x16x32_bf16(Bt[n][k], At[m][k], acc[ai][bj][m][n], 0, 0, 0); __builtin_amdgcn_s_setprio(0); } while (0)
#define PG8_WAIT_V(n) asm volatile("s_waitcnt vmcnt(" #n ")" ::: "memory")
#define PG8_WAIT_L(n) asm volatile("s_waitcnt lgkmcnt(" #n ")" ::: "memory")
#define PG8_BAR __builtin_amdgcn_s_barrier()
#define PG8_SCHED __builtin_amdgcn_sched_barrier(0)
    Unit cur, nxt; int ui = 0;
    if (!S.next(0, cur)) return;
    f32x4 acc[2][2][4][2];
#pragma unroll
    for (int a = 0; a < 2; ++a)
#pragma unroll
        for (int b = 0; b < 2; ++b)
#pragma unroll
            for (int m = 0; m < 4; ++m)
#pragma unroll
                for (int n = 0; n < 2; ++n) acc[a][b][m][n] = (f32x4){0.f, 0.f, 0.f, 0.f};
    bf16x8 At[4][2], B0[2][2], B1[2][2];
    const char* cA = (const char*)g.A + (size_t)cur.pm * tstep; const char* cB = (const char*)g.Bt + (size_t)cur.pn * tstep;
    S.a_ready(cur);
    if constexpr (SP2) {
        PG8_STAGE(PG8_SB(0, 0), cB, voffB); PG8_STAGE(PG8_SB(0, 1), cB + hstep, voffB); PG8_STAGE(PG8_SA(0, 0), cA, voffA); PG8_STAGE(PG8_SA(0, 1), cA + hstep, voffA);
        if (wr == 1) PG8_BAR;
        PG8_WAIT_V(2); PG8_BAR;
        PG8_STAGE(PG8_SB(1, 0), cB + kstep, voffB); PG8_STAGE(PG8_SA(1, 0), cA + kstep, voffA); PG8_STAGE(PG8_SB(1, 1), cB + hstep + kstep, voffB);
        PG8_WAIT_V(6); PG8_BAR;
    } else {
        PG8_STAGE(PG8_SB(0, 0), cB, voffB); PG8_STAGE(PG8_SA(0, 0), cA, voffA); PG8_STAGE(PG8_SB(0, 1), cB + hstep, voffB); PG8_STAGE(PG8_SA(0, 1), cA + hstep, voffA);
        if (wr == 1) PG8_BAR;
        PG8_WAIT_V(4); PG8_BAR;
        PG8_STAGE(PG8_SB(1, 0), cB + kstep, voffB); PG8_STAGE(PG8_SA(1, 0), cA + kstep, voffA); PG8_STAGE(PG8_SB(1, 1), cB + hstep + kstep, voffB);
        PG8_WAIT_V(6); PG8_BAR;
    }
    for (;;) {
        const bool has_next = S.next(ui + 1, nxt);
        const char* nA = has_next ? (const char*)g.A + (size_t)nxt.pm * tstep : cA; const char* nB = has_next ? (const char*)g.Bt + (size_t)nxt.pn * tstep : cB;
        for (int t = 0; t < nt; t += 2) {
            const bool last = (t == nt - 2);
            const char* a1 = cA + (size_t)(t + 1) * kstep;
            const char* a2 = last ? nA : cA + (size_t)(t + 2) * kstep; const char* b2 = last ? nB : cB + (size_t)(t + 2) * kstep;
            const char* a3 = a2 + kstep; const char* b3 = b2 + kstep;
            if (last && has_next) S.a_ready(nxt);
            if constexpr (SP2) {
            PG8_LDB(B0, 0, 0); PG8_LDB(B1, 0, 1); PG8_SCHED; PG8_LDA(At, 0, 0); PG8_STAGE(PG8_SA(1, 1), a1 + hstep, voffA);
            PG8_WAIT_V(8); PG8_WAIT_L(0); PG8_BAR; PG8_MMA(0, 0, At, B0); PG8_MMA(0, 1, At, B1); PG8_BAR; PG8_SCHED;
            PG8_LDA(At, 0, 1); PG8_STAGE(PG8_SB(0, 0), b2, voffB); PG8_STAGE(PG8_SB(0, 1), b2 + hstep, voffB); PG8_STAGE(PG8_SA(0, 0), a2, voffA);
            PG8_WAIT_V(8); PG8_WAIT_L(0); PG8_BAR; PG8_MMA(1, 0, At, B0); PG8_MMA(1, 1, At, B1); PG8_BAR; PG8_SCHED;
            PG8_LDB(B0, 1, 0); PG8_LDB(B1, 1, 1); PG8_SCHED; PG8_LDA(At, 1, 0); PG8_STAGE(PG8_SA(0, 1), a2 + hstep, voffA);
            PG8_WAIT_V(8); PG8_WAIT_L(0); PG8_BAR; PG8_MMA(0, 0, At, B0); PG8_MMA(0, 1, At, B1); PG8_BAR; PG8_SCHED;
            PG8_LDA(At, 1, 1); PG8_STAGE(PG8_SB(1, 0), b3, voffB); PG8_STAGE(PG8_SB(1, 1), b3 + hstep, voffB); PG8_STAGE(PG8_SA(1, 0), a3, voffA);
            PG8_WAIT_V(8); PG8_WAIT_L(0); PG8_BAR; PG8_MMA(1, 0, At, B0); PG8_MMA(1, 1, At, B1); PG8_BAR; PG8_SCHED;
            } else {
            PG8_LDB(B0, 0, 0); PG8_SCHED; PG8_LDA(At, 0, 0); PG8_STAGE(PG8_SA(1, 1), a1 + hstep, voffA);
            PG8_WAIT_L(8); PG8_BAR; PG8_WAIT_L(0); PG8_MMA(0, 0, At, B0); PG8_BAR; PG8_SCHED;
            PG8_LDB(B1, 0, 1); PG8_STAGE(PG8_SB(0, 0), b2, voffB);
            PG8_BAR; PG8_WAIT_L(0); PG8_MMA(0, 1, At, B1); PG8_BAR;
            PG8_LDA(At, 0, 1); PG8_STAGE(PG8_SA(0, 0), a2, voffA);
            PG8_BAR; PG8_WAIT_L(0); PG8_MMA(1, 0, At, B0); PG8_BAR; PG8_SCHED;
            PG8_STAGE(PG8_SB(0, 1), b2 + hstep, voffB);
            PG8_WAIT_V(6); PG8_BAR; PG8_MMA(1, 1, At, B1); PG8_BAR;
            PG8_LDB(B0, 1, 0); PG8_SCHED; PG8_LDA(At, 1, 0); PG8_STAGE(PG8_SA(0, 1), a2 + hstep, voffA);
            PG8_WAIT_L(8); PG8_BAR; PG8_WAIT_L(0); PG8_MMA(0, 0, At, B0); PG8_BAR; PG8_SCHED;
            PG8_LDB(B1, 1, 1); PG8_STAGE(PG8_SB(1, 0), b3, voffB);
            PG8_BAR; PG8_WAIT_L(0); PG8_MMA(0, 1, At, B1); PG8_BAR;
            PG8_LDA(At, 1, 1); PG8_STAGE(PG8_SA(1, 0), a3, voffA);
            PG8_BAR; PG8_WAIT_L(0); PG8_MMA(1, 0, At, B0); PG8_BAR; PG8_SCHED;
            PG8_STAGE(PG8_SB(1, 1), b3 + hstep, voffB);
            PG8_WAIT_V(6); PG8_BAR; PG8_MMA(1, 1, At, B1); PG8_BAR;
            }
        }
        if constexpr (ALIGN_EPI) { if (wr == 0) PG8_BAR; }
        if constexpr (!Epi::AFTER_DRAIN) { E(acc, cur, wr, wc, fr, fq); S.done(cur); }
        if (!has_next) break;
#pragma unroll
        for (int a = 0; a < 2; ++a)
#pragma unroll
            for (int b = 0; b < 2; ++b)
#pragma unroll
                for (int m = 0; m < 4; ++m)
#pragma unroll
                    for (int n = 0; n < 2; ++n) acc[a][b][m][n] = (f32x4){0.f, 0.f, 0.f, 0.f};
        cur = nxt; cA = nA; cB = nB; ++ui;
        if constexpr (ALIGN_EPI) { if (wr == 1) PG8_BAR; }
    }
    PG8_WAIT_V(0);
    if constexpr (!ALIGN_EPI) { if (wr == 0) PG8_BAR; }
    PG8_BAR;
    if constexpr (Epi::AFTER_DRAIN) { E.fused(acc, cur, wr, wc, fr, fq, lds, wid, lane); S.done(cur); }
#undef PG8_SA
#undef PG8_SB
#undef PG8_STAGE
#undef PG8_LDA
#undef PG8_LDB
#undef PG8_MMA
#undef PG8_WAIT_V
#undef PG8_WAIT_L
#undef PG8_BAR
#undef PG8_SCHED
}
}

namespace pg8 {
struct EpiF32 {
    static constexpr bool PERM = false, AFTER_DRAIN = false;
    float* C; int ldc;
    __device__ __forceinline__ void operator()(const f32x4 (&acc)[2][2][4][2], const Unit& u, int wr, int wc, int fr, int fq) const {
        const int row0 = u.pm * BM + wr * 64 + fr, col0 = u.pn * BM + wc * 32 + 4 * fq;
#pragma unroll
        for (int ai = 0; ai < 2; ++ai)
#pragma unroll
            for (int m = 0; m < 4; ++m) { float* rowp = C + (size_t)(row0 + ai * HALF + m * 16) * ldc + col0;
#pragma unroll
                for (int bj = 0; bj < 2; ++bj)
#pragma unroll
                    for (int n = 0; n < 2; ++n) *(f32x4*)(rowp + bj * HALF + n * 16) = acc[ai][bj][m][n]; }
    }
};
struct EpiResid {
    static constexpr bool PERM = false, AFTER_DRAIN = false;
    const float* base; float* out; int ldc; const float* gate0; int rows_per_b; int gstride;
    __device__ __forceinline__ void operator()(const f32x4 (&acc)[2][2][4][2], const Unit& u, int wr, int wc, int fr, int fq) const {
        const int row0 = u.pm * BM + wr * 64 + fr, col0 = u.pn * BM + wc * 32 + 4 * fq;
        const float* gp = gate0 + (size_t)((u.pm * BM) / rows_per_b) * gstride + col0;
        f32x4 gv[2][2];
#pragma unroll
        for (int bj = 0; bj < 2; ++bj)
#pragma unroll
            for (int n = 0; n < 2; ++n) gv[bj][n] = *(const f32x4*)(gp + bj * HALF + n * 16);
#pragma unroll
        for (int ai = 0; ai < 2; ++ai)
#pragma unroll
            for (int m = 0; m < 4; ++m) { const size_t off = (size_t)(row0 + ai * HALF + m * 16) * ldc + col0;
#pragma unroll
                for (int bj = 0; bj < 2; ++bj)
#pragma unroll
                    for (int n = 0; n < 2; ++n) { const f32x4 bs = *(const f32x4*)(base + off + bj * HALF + n * 16);
                        *(f32x4*)(out + off + bj * HALF + n * 16) = bs + gv[bj][n] * acc[ai][bj][m][n]; }
                if (m & 1) asm volatile("" ::: "memory"); }
    }
};
}

namespace mk {
#define GAS __attribute__((address_space(1)))
#define LAS __attribute__((address_space(3)))
typedef unsigned short bf16;
typedef unsigned v4u __attribute__((ext_vector_type(4)));
typedef unsigned v2u __attribute__((ext_vector_type(2)));
typedef float f32x4 __attribute__((ext_vector_type(4)));
#define LDS_WAIT() asm volatile("s_waitcnt lgkmcnt(0)" ::: "memory")
#define VM_WAIT() asm volatile("s_waitcnt vmcnt(0)" ::: "memory")
__device__ __forceinline__ unsigned f2bf(float f) { unsigned u = __builtin_bit_cast(unsigned, f); return (u + 0x7fffu + ((u >> 16) & 1u)) >> 16; }
__device__ __forceinline__ unsigned pk2(float lo, float hi) { return f2bf(lo) | (f2bf(hi) << 16); }
__device__ __forceinline__ float bf2f(unsigned short h) { return __builtin_bit_cast(float, (unsigned)h << 16); }

constexpr int NWAVES = 8, NT = 512;
constexpr int RING_BYTES = 131072, LDSCTL_OFF = RING_BYTES, LDS_BYTES = 147456;
constexpr size_t MiB = 1u << 20;
constexpr size_t WS_CTL = 0, CTL_ZERO_BYTES = 1 * MiB;
constexpr size_t WS_MOD = 1 * MiB, WS_KEYS = 2 * MiB, WS_WIN = 4 * MiB, WS_WOUT = 12 * MiB, WS_WQ = 16 * MiB, WS_H = 24 * MiB, WS_X1 = 56 * MiB;
constexpr size_t WS_EIDX = 120 * MiB, WS_GATE = 128 * MiB, WS_A = 136 * MiB, WS_MIX = 200 * MiB, WS_U = 232 * MiB, WS_V = 296 * MiB, WS_END = 360 * MiB;
constexpr size_t WS_T1 = 232 * MiB, WS_T2 = 360 * MiB, WS_TEND = 488 * MiB;
constexpr int CW_BAR = 4096;

enum { PH_PRO = 0, PH_H0 = 1, PH_L0 = 2, PH_PER_LAYER = 7, PH_G1 = 0, PH_AT = 1, PH_G2 = 2, PH_N2 = 3, PH_G3 = 4, PH_TK = 5, PH_PE = 6, PH_END = PH_L0 + 2 * PH_PER_LAYER, PH_H1 = 100 };

struct Args { const float* in[19]; float* out; unsigned char* ws; int ph_lo, ph_hi; };

__device__ __forceinline__ void p0_transpose_item(const float* W, int K, int N, bf16* WT, LAS float* scr, int item, int lane) {
    const int nblk = N / 32, kb = item / nblk, nb = item % nblk, k0 = 64 * kb, n0 = 32 * nb;
#pragma unroll 8
    for (int i = 0; i < 32; ++i) { const int kk = 2 * i + (lane >> 5); scr[kk * 33 + (lane & 31)] = W[(size_t)(k0 + kk) * N + n0 + (lane & 31)]; }
    LDS_WAIT(); asm volatile("" ::: "memory");
    const int c = lane & 7;
#pragma unroll
    for (int j = 0; j < 4; ++j) { const int n = (lane >> 3) + 8 * j; const LAS float* s = scr + (8 * c) * 33 + n;
        v4u o; o.x = pk2(s[0 * 33], s[1 * 33]); o.y = pk2(s[2 * 33], s[3 * 33]); o.z = pk2(s[4 * 33], s[5 * 33]); o.w = pk2(s[6 * 33], s[7 * 33]);
        *(GAS v4u*)(WT + (size_t)(n0 + n) * K + k0 + 8 * c) = o; }
    LDS_WAIT(); asm volatile("" ::: "memory");
}
__device__ __forceinline__ float wave_sum(float v) {
#pragma unroll
    for (int o = 1; o < 64; o <<= 1) v += __shfl_xor(v, o);
    return v;
}
__device__ __forceinline__ void hmod_row(const float* xrow, const float* g, const float* mod_b, int which, bf16* orow, int lane) {
    const GAS f32x4* xr = (const GAS f32x4*)xrow + lane;
    f32x4 v[4]; float s = 0.f;
#pragma unroll
    for (int j = 0; j < 4; ++j) { v[j] = xr[64 * j]; s += (v[j].x * v[j].x + v[j].y * v[j].y) + (v[j].z * v[j].z + v[j].w * v[j].w); }
    const float rstd = 1.0f / sqrtf(wave_sum(s) * (1.f / D) + EPS);
    const float* shp = mod_b + (which * 3 + 0) * D; const float* scp = mod_b + (which * 3 + 1) * D;
    GAS unsigned long long* o8 = (GAS unsigned long long*)orow + lane;
#pragma unroll
    for (int j = 0; j < 4; ++j) { const int k = 4 * lane + 256 * j;
        const f32x4 gg = *(const f32x4*)(g + k), sh = *(const f32x4*)(shp + k), sc = *(const f32x4*)(scp + k);
        const f32x4 hv = v[j] * rstd * gg * (sc + 1.0f) + sh;
        o8[64 * j] = (unsigned long long)pk2(hv.x, hv.y) | ((unsigned long long)pk2(hv.z, hv.w) << 32); }
}


#define MK_GW(wave) (((gridDim.x % 8 == 0) ? (blockIdx.x % 8) * (gridDim.x / 8) + blockIdx.x / 8 : blockIdx.x) * NWAVES + (wave))
#define MK_NGW (gridDim.x * NWAVES)

__device__ __forceinline__ void ph_prologue(const Args& args, LAS unsigned char* lds) {
    const int tid = threadIdx.x, lane = tid & 63, wave = __builtin_amdgcn_readfirstlane(tid >> 6);
    const int G = gridDim.x, bx = blockIdx.x;
    unsigned char* ws = args.ws;
    {
        const float* c = args.in[1]; const float* w_ada = args.in[5]; const float* b_ada = args.in[6]; float* mod = (float*)(ws + WS_MOD);
        LAS float* sact = (LAS float*)lds; LAS float* red = (LAS float*)(lds + 32768);
        for (int i = tid; i < B * D; i += NT) { const float cv = c[i]; sact[i] = cv / (1.0f + __expf(-cv)); }
        __syncthreads();
        for (int item = bx; item < DEPTH * (6 * D / 32); item += G) {
            const int l = item / (6 * D / 32), n0 = (item % (6 * D / 32)) * 32, cc = tid & 31, kg = tid >> 5;
            float acc[B];
#pragma unroll
            for (int b = 0; b < B; ++b) acc[b] = 0.f;
            const float* w = w_ada + (size_t)l * D * 6 * D + n0 + cc;
            for (int kk = 0; kk < 64; ++kk) { const int k = kg * 64 + kk; const float wv = w[(size_t)k * 6 * D];
#pragma unroll
                for (int b = 0; b < B; ++b) acc[b] += sact[b * D + k] * wv; }
#pragma unroll
            for (int b = 0; b < B; ++b) red[(kg * 32 + cc) * B + b] = acc[b];
            __syncthreads();
            if (tid < 32 * B) { const int c2 = tid & 31, b = tid >> 5; float s = 0.f;
                for (int k2 = 0; k2 < 16; ++k2) s += red[(k2 * 32 + c2) * B + b];
                mod[((size_t)l * B + b) * 6 * D + n0 + c2] = s + b_ada[(size_t)l * 6 * D + n0 + c2]; }
            __syncthreads();
        }
    }
    const int gw = MK_GW(wave), NGW = MK_NGW;
    {
        const float* w_in = args.in[7]; const float* w_out = args.in[14]; const float* peer_wq = args.in[15];
        bf16* WinT = (bf16*)(ws + WS_WIN); bf16* WoutT = (bf16*)(ws + WS_WOUT); bf16* WqT = (bf16*)(ws + WS_WQ);
        LAS float* scr = (LAS float*)(lds + wave * 16384);
        constexpr int I_IN = (D / 64) * (INW / 32), I_OUT = (D / 64) * (D / 32), I_Q = (D / 64) * (PW / 32), I_L = I_IN + I_OUT + I_Q;
        for (int it = gw; it < DEPTH * I_L; it += NGW) {
            const int l = it / I_L; int r = it % I_L;
            if (r < I_IN) { p0_transpose_item(w_in + (size_t)l * D * INW, D, INW, WinT + (size_t)l * INW * D, scr, r, lane); continue; } r -= I_IN;
            if (r < I_OUT) { p0_transpose_item(w_out + (size_t)l * D * D, D, D, WoutT + (size_t)l * D * D, scr, r, lane); continue; } r -= I_OUT;
            p0_transpose_item(peer_wq + (size_t)l * D * PW, D, PW, WqT + (size_t)l * PW * D, scr, r, lane);
        }
    }
    {
        const float* peer_keys = args.in[16]; bf16* keysb = (bf16*)(ws + WS_KEYS);
        for (int i = gw * 64 + lane; i < DEPTH * 2 * NK * 128 / 2; i += NGW * 64) ((GAS unsigned*)keysb)[i] = pk2(peer_keys[2 * i], peer_keys[2 * i + 1]);
    }
#if DO_UV
    {
        const float* peer_u = args.in[17]; const float* peer_v = args.in[18]; bf16* Ub = (bf16*)(ws + WS_U); bf16* Vb = (bf16*)(ws + WS_V);
        for (size_t i = (size_t)gw * 64 + lane; i < (size_t)DEPTH * NE * D / 8; i += (size_t)NGW * 64) {
            { const f32x4 a = ((const GAS f32x4*)peer_u)[2 * i], b = ((const GAS f32x4*)peer_u)[2 * i + 1];
              v4u o; o.x = pk2(a.x, a.y); o.y = pk2(a.z, a.w); o.z = pk2(b.x, b.y); o.w = pk2(b.z, b.w); ((GAS v4u*)Ub)[i] = o; }
            { const f32x4 a = ((const GAS f32x4*)peer_v)[2 * i], b = ((const GAS f32x4*)peer_v)[2 * i + 1];
              v4u o; o.x = pk2(a.x, a.y); o.y = pk2(a.z, a.w); o.z = pk2(b.x, b.y); o.w = pk2(b.z, b.w); ((GAS v4u*)Vb)[i] = o; }
        }
    }
#endif
}
template <int L, int WHICH> __device__ __forceinline__ void ph_hmod(const Args& args) {
    const int lane = threadIdx.x & 63, wave = __builtin_amdgcn_readfirstlane(threadIdx.x >> 6);
    unsigned char* ws = args.ws;
    const float* src = WHICH ? (const float*)(ws + WS_X1) : (L == 0 ? args.in[0] : args.out);
    const float* g = args.in[WHICH ? 4 : 3] + L * D; const float* mod_l = (const float*)(ws + WS_MOD) + (size_t)L * B * 6 * D; bf16* Hb = (bf16*)(ws + WS_H);
    const int gw = MK_GW(wave), NGW = MK_NGW;
    for (int m = gw; m < T; m += NGW) hmod_row(src + (size_t)m * D, g, mod_l + (size_t)(m / S) * 6 * D, WHICH, Hb + (size_t)m * D, lane);
}
template <int L> __device__ __forceinline__ void ph_g1(const Args& args, LAS unsigned char* lds) {
    unsigned char* ws = args.ws;
    pg8::Gemm g{(const bf16*)(ws + WS_H), (const bf16*)(ws + WS_WIN) + (size_t)L * INW * D, T, INW, D}; pg8::StaticOrder SO; SO.init(T, INW, gridDim.x, blockIdx.x);
#if Z_F32
    pg8::EpiF32 E{(float*)(ws + WS_T1), INW};
    pg8::gemm_phase<pg8::EpiF32, pg8::StaticOrder, true, true>(lds, g, SO, E);
#else
    pg8::EpiBf16<0> E{(bf16*)(ws + WS_A), INW, nullptr, 0, 0, 1.f};
    pg8::gemm_phase<pg8::EpiBf16<0>, pg8::StaticOrder, true, true>(lds, g, SO, E);
#endif
}
template <int L> __device__ __forceinline__ void ph_g2(const Args& args, LAS unsigned char* lds) {
    unsigned char* ws = args.ws;
    pg8::Gemm g{(const bf16*)(ws + WS_MIX), (const bf16*)(ws + WS_WOUT) + (size_t)L * D * D, T, D, D}; pg8::StaticOrder SO; SO.init(T, D, gridDim.x, blockIdx.x);
    pg8::EpiResid E{L == 0 ? args.in[0] : args.out, (float*)(ws + WS_X1), D, (const float*)(ws + WS_MOD) + (size_t)L * B * 6 * D + 2 * D, S, 6 * D};
    pg8::gemm_phase<pg8::EpiResid, pg8::StaticOrder, true, true>(lds, g, SO, E);
}
template <int L> __device__ __forceinline__ void ph_g3(const Args& args, LAS unsigned char* lds) {
    unsigned char* ws = args.ws;
    pg8::Gemm g{(const bf16*)(ws + WS_H), (const bf16*)(ws + WS_WQ) + (size_t)L * PW * D, T, PW, D}; pg8::StaticOrder SO; SO.init(T, PW, gridDim.x, blockIdx.x);
#if QP_F32
    pg8::EpiF32 E{(float*)(ws + WS_T1), PW};
    pg8::gemm_phase<pg8::EpiF32, pg8::StaticOrder, true, true>(lds, g, SO, E);
#else
    pg8::EpiBf16<0> E{(bf16*)(ws + WS_A), PW, nullptr, 0, 0, 1.f};
    pg8::gemm_phase<pg8::EpiBf16<0>, pg8::StaticOrder, true, true>(lds, g, SO, E);
#endif
}
template <int L> __device__ __forceinline__ void layer_phases(const Args& args, LAS unsigned char* lds) {
    const int lo = args.ph_lo, hi = args.ph_hi;
#define IN(k) (lo <= (k) && (k) < hi)
    constexpr int pb = PH_L0 + L * PH_PER_LAYER;
    if (IN(pb + PH_G1)) ph_g1<L>(args, lds);
    if (IN(pb + PH_G2)) ph_g2<L>(args, lds);
    if (IN(pb + PH_N2)) ph_hmod<L, 1>(args);
    if (IN(pb + PH_G3)) ph_g3<L>(args, lds);
#undef IN
}

__global__ void __launch_bounds__(NT, 2) mk_fwd(Args args) {
    extern __shared__ __attribute__((aligned(16))) unsigned char lds_raw[];
    LAS unsigned char* lds = (LAS unsigned char*)lds_raw;
    const int lo = args.ph_lo, hi = args.ph_hi;
#define IN(k) (lo <= (k) && (k) < hi)
    if (IN(PH_PRO)) ph_prologue(args, lds);
    if (IN(PH_H0)) ph_hmod<0, 0>(args);
    layer_phases<0>(args, lds);
    if (IN(PH_H1)) ph_hmod<1, 0>(args);
    layer_phases<1>(args, lds);
#undef IN
}
}


__global__ void k_cvt_bf16(const float* src, unsigned short* dst, size_t n) {
    const size_t i = (size_t)blockIdx.x * 256 + threadIdx.x;
    if (i < n) dst[i] = (unsigned short)mk::f2bf(src[i]);
}
__global__ void k_peer_u_b16(const unsigned short* h2, const float* u_l, const int* eidx, const float* gate, float* wact) {
    const int i = blockIdx.x * 4 + (threadIdx.x >> 6), lane = threadIdx.x & 63;
    if (i >= T * 128) return;
    const int t = i >> 7;
    const float* ur = u_l + (size_t)eidx[i] * D; const unsigned short* hr = h2 + (size_t)t * D;
    float s = 0.f;
    for (int k = lane; k < D; k += 64) s += mk::bf2f(hr[k]) * ur[k];
    for (int o = 32; o; o >>= 1) s += __shfl_xor(s, o);
    if (lane == 0) wact[i] = gate[i] * gelu_f(s);
}

extern "C" void kernel_launch(void* const* d_in, const int* in_sizes, int n_in, void* d_out, int out_size, void* d_ws, size_t ws_size, hipStream_t stream) {
    using namespace mk;
    static int grid = 0;
    if (grid == 0) {
        if (n_in != 19 || ws_size < WS_TEND) { fprintf(stderr, "kernel_launch: bad n_in %d or ws_size %zu\n", n_in, ws_size); grid = -1; return; }
        int dev = 0, cus = 0, per_cu = 0;
        hipGetDevice(&dev); hipDeviceGetAttribute(&cus, hipDeviceAttributeMultiprocessorCount, dev);
        if (hipFuncSetAttribute((const void*)mk_fwd, hipFuncAttributeMaxDynamicSharedMemorySize, LDS_BYTES) != hipSuccess) { fprintf(stderr, "hipFuncSetAttribute failed\n"); grid = -1; return; }
        hipOccupancyMaxActiveBlocksPerMultiprocessor(&per_cu, (const void*)mk_fwd, NT, LDS_BYTES);
        (void)hipGetLastError();
        grid = (per_cu >= 1) ? cus : -1;
        if (grid != 256) fprintf(stderr, "kernel_launch: grid %d (per_cu %d)\n", grid, per_cu);
    }
    if (grid < 0) return;
    const float* positions_f = (const float*)d_in[2]; const int* positions = (const int*)positions_f;
    const float* q_norm_g = (const float*)d_in[8]; const float* k_norm_g = (const float*)d_in[9]; const float* attn_sink = (const float*)d_in[10];
    const float* conv_w = (const float*)d_in[11]; const float* pool_w = (const float*)d_in[12]; const float* pool_scale = (const float*)d_in[13];
    const float* peer_keys = (const float*)d_in[16]; const float* peer_u = (const float*)d_in[17]; const float* peer_v = (const float*)d_in[18];
    float* out = (float*)d_out; unsigned char* ws = (unsigned char*)d_ws;
    hipMemsetAsync(ws + WS_CTL, 0, CTL_ZERO_BYTES, stream);
    Args a{};
    for (int i = 0; i < 19; ++i) a.in[i] = (const float*)d_in[i];
    a.out = out; a.ws = ws;
    auto run = [&](int lo, int hi) { a.ph_lo = lo; a.ph_hi = hi; hipLaunchKernelGGL(mk_fwd, dim3(grid), dim3(NT), LDS_BYTES, stream, a); };
    float* mod = (float*)(ws + WS_MOD); unsigned short* Hb = (unsigned short*)(ws + WS_H); float* X1 = (float*)(ws + WS_X1);
    int* eidx = (int*)(ws + WS_EIDX); float* gate = (float*)(ws + WS_GATE); unsigned short* MIXb = (unsigned short*)(ws + WS_MIX);
    float* z = (float*)(ws + WS_T1); float* qp = (float*)(ws + WS_T1);
    float* selv = (float*)(ws + WS_T1); int* seli = (int*)(ws + WS_T1 + 16 * MiB); float* wact = (float*)(ws + WS_T1 + 32 * MiB);
    float* qn = (float*)(ws + WS_T2); float* kn = qn + (size_t)T * 512; float* pooled = kn + (size_t)T * 128; float* mixin = pooled + (size_t)T * 256;
    float* sc = (float*)(ws + WS_T2);
    run(PH_PRO, PH_PRO + 1);
    run(PH_H0, PH_H0 + 1);
    for (int l = 0; l < DEPTH; ++l) {
        const float* mod_l = mod + (size_t)l * B * 6 * D; const int pb = PH_L0 + l * PH_PER_LAYER;
        run(pb + PH_G1, pb + PH_G1 + 1);
        k_qkprep<<<(T * 10 + 255) / 256, 256, 0, stream>>>(z, q_norm_g + l * 64, k_norm_g + l * 64, positions, qn, kn);
        k_attn<<<(T * NQH + 63) / 64, 64, 0, stream>>>(qn, kn, z, attn_sink + l * NQH, mixin);
        k_conv_pooled<<<T, 256, 0, stream>>>(z, conv_w + l * 3 * 256, mixin, pooled);
        k_poolo<<<T, 256, 0, stream>>>(pooled, pool_w + (size_t)l * 4 * 64 * 64, pool_scale + l * 256, mixin);
        k_cvt_bf16<<<(unsigned)(((size_t)T * D + 255) / 256), 256, 0, stream>>>(mixin, MIXb, (size_t)T * D);
        run(pb + PH_G2, pb + PH_G2 + 1);
        run(pb + PH_N2, pb + PH_N2 + 1);
        run(pb + PH_G3, pb + PH_G3 + 1);
        k_score<<<T * PH, 256, 0, stream>>>(qp, peer_keys + (size_t)l * 2 * NK * 128, sc);
        k_top1<<<(T * PH * 2 + 255) / 256, 256, 0, stream>>>(sc, selv, seli);
        k_top2<<<(T * PH + 255) / 256, 256, 0, stream>>>(selv, seli, eidx, gate);
        k_peer_u_b16<<<T * 128 / 4, 256, 0, stream>>>(Hb, peer_u + (size_t)l * NE * D, eidx, gate, wact);
        k_peer_v<<<T, 256, 0, stream>>>(X1, peer_v + (size_t)l * NE * D, eidx, wact, mod_l, out);
        if (l == 0) run(PH_H1, PH_H1 + 1);
    }
}
#endif
```

```cpp
#include <hip/hip_runtime.h>
#include <stdint.h>
#include <math.h>
#include <cstdio>
#ifndef Z_F32
#define Z_F32 0
#endif
#ifndef QP_F32
#define QP_F32 0
#endif
#ifndef DO_UV
#define DO_UV 1
#endif

#ifndef BATCH
#define BATCH 8
#endif
#ifndef SEQ
#define SEQ 2048
#endif
#define HD __host__ __device__ __forceinline__

namespace cfg {
constexpr int B = BATCH, S = SEQ, T = B * S, D = 1024, DEPTH = 2;
constexpr int HDIM = 64, NQH = 8, NKVH = 2, GRP = 4, WIN = 128;
constexpr int INW = 1792, OQ = 0, OK_ = 512, OV = 640, OCX = 768, OCB = 1024, OCC = 1280, OPX = 1536;
constexpr int PH = 8, NK = 128, NE = 16384, QD = 256, TOPK = 16, PW = 2048;
constexpr float EPS = 1e-6f;
}
using namespace cfg;

HD float silu_f(float x) { return x / (1.0f + expf(-x)); }
HD float gelu_f(float x) { return 0.5f * x * (1.0f + erff(x * 0.70710678118654752f)); }

HD float mod_elem(const float* c, const float* w_ada_l, const float* b_ada_l, int b, int n) {
    float acc = 0.f;
    for (int k = 0; k < D; ++k) acc += silu_f(c[b * D + k]) * w_ada_l[(size_t)k * (6 * D) + n];
    return acc + b_ada_l[n];
}
HD float row_rstd(const float* xr) {
    float s = 0.f;
    for (int k = 0; k < D; ++k) s += xr[k] * xr[k];
    return 1.0f / sqrtf(s / D + EPS);
}
HD float hmod_elem(float xv, float rstd, float g, const float* mod_b, int which, int k) {
    const float shift = mod_b[(which * 3 + 0) * D + k], scale = mod_b[(which * 3 + 1) * D + k];
    return xv * rstd * g * (1.0f + scale) + shift;
}
HD void qk_prep(const float* src, const float* g, int pos, float* dst) {
    float s = 0.f;
    for (int d = 0; d < HDIM; ++d) s += src[d] * src[d];
    const float r = 1.0f / sqrtf(s / HDIM + EPS);
    for (int d = 16; d < HDIM; ++d) dst[d] = src[d] * r * g[d];
    for (int i = 0; i < 8; ++i) {
        const float inv = powf(500000.0f, -(float)(2 * i) / 16.0f);
        const float ang = (float)pos * inv;
        const float cs = cosf(ang), sn = sinf(ang);
        const float t1 = src[i] * r * g[i], t2 = src[i + 8] * r * g[i + 8];
        dst[i] = t1 * cs - t2 * sn; dst[i + 8] = t2 * cs + t1 * sn;
    }
}
HD float conv_elem(const float* z, const float* conv_w_l, int t, int c) {
    const int s = t % S;
    float acc = 0.f;
    for (int j = 0; j < 3; ++j) {
        const int ss = s + j - 1;
        if (ss < 0 || ss >= S) continue;
        const float* zr = z + (size_t)(t + j - 1) * INW;
        acc += conv_w_l[j * 256 + c] * zr[OCC + c] * zr[OCX + c];
    }
    return z[(size_t)t * INW + OCB + c] * acc;
}
HD float pooled_elem(const float* z, int t, int ch) {
    const int s = t % S, g = ch >> 6, half = 1 << g;
    int lo = s - half, hi = s + half;
    lo = lo < 0 ? 0 : lo; hi = hi > S ? S : hi;
    float acc = 0.f;
    for (int ss = lo; ss < hi; ++ss) acc += z[(size_t)(t - s + ss) * INW + OPX + ch];
    return acc / (float)(hi - lo) - z[(size_t)t * INW + OPX + ch];
}
HD float poolo_elem(const float* pooled, const float* pool_w_l, const float* pool_scale_l, int t, int ch) {
    const int g = ch >> 6, e = ch & 63;
    float acc = 0.f;
    for (int c = 0; c < 64; ++c) acc += pooled[(size_t)t * 256 + g * 64 + c] * pool_w_l[(g * 64 + c) * 64 + e];
    return acc * pool_scale_l[ch];
}
HD float score_elem(const float* qp, const float* keys_l, int row, int col) {
    const int half = col >> 7, n = col & 127;
    const float* q = qp + (size_t)row * QD + half * 128;
    const float* kk = keys_l + ((size_t)half * NK + n) * 128;
    float acc = 0.f;
    for (int d = 0; d < 128; ++d) acc += q[d] * kk[d];
    return acc;
}

HD void attn_row(const float* qn, const float* kn, const float* z, const float* sink_l, int t, int hq, float* mixin) {
    const int s = t % S, b0 = t - s, kvh = hq / GRP;
    float q[64], o[64];
#pragma unroll
    for (int d = 0; d < 64; ++d) { q[d] = qn[(size_t)t * 512 + hq * 64 + d]; o[d] = 0.f; }
    float m = sink_l[hq], l = 1.0f;
    int lo = s - WIN, hi = s + WIN; lo = lo < 0 ? 0 : lo; hi = hi > S - 1 ? S - 1 : hi;
    for (int j = lo; j <= hi; ++j) {
        const float* kr = kn + (size_t)(b0 + j) * 128 + kvh * 64;
        float sc = 0.f;
#pragma unroll
        for (int d = 0; d < 64; ++d) sc += q[d] * kr[d];
        sc *= 0.125f;
        const float mn = fmaxf(m, sc), al = expf(m - mn), p = expf(sc - mn);
        l = l * al + p; m = mn;
        const float* vr = z + (size_t)(b0 + j) * INW + OV + kvh * 64;
#pragma unroll
        for (int d = 0; d < 64; ++d) o[d] = o[d] * al + p * vr[d];
    }
    const float inv = 1.0f / l;
#pragma unroll
    for (int d = 0; d < 64; ++d) mixin[(size_t)t * D + hq * 64 + d] = o[d] * inv;
}
HD void top1_row(const float* sc, float* selv, int* seli, int i) {
    const float* p = sc + (size_t)i * 128;
    float lastv = INFINITY; int lasti = -1;
    for (int r = 0; r < TOPK; ++r) {
        float bv = -INFINITY; int bi = -1;
        for (int n = 0; n < 128; ++n) {
            const float v = p[n];
            const bool elig = (v < lastv) || (v == lastv && n > lasti);
            if (elig && (v > bv)) { bv = v; bi = n; }
        }
        selv[(size_t)i * 16 + r] = bv; seli[(size_t)i * 16 + r] = bi;
        lastv = bv; lasti = bi;
    }
}
HD void top2_row(const float* selv, const int* seli, int* eidx, float* gate, int row) {
    const float* v1 = selv + (size_t)(row * 2) * 16; const float* v2 = v1 + 16;
    const int* i1 = seli + (size_t)(row * 2) * 16; const int* i2 = i1 + 16;
    float lastv = INFINITY; int lasti = -1;
    float top0 = 0.f, den = 0.f;
    for (int r = 0; r < TOPK; ++r) {
        float bv = -INFINITY; int bi = -1;
        for (int n = 0; n < 256; ++n) {
            const float v = v1[n >> 4] + v2[n & 15];
            const bool elig = (v < lastv) || (v == lastv && n > lasti);
            if (elig && (v > bv)) { bv = v; bi = n; }
        }
        if (r == 0) top0 = bv;
        const float e = expf(bv - top0);
        den += e;
        gate[(size_t)row * 16 + r] = e;
        eidx[(size_t)row * 16 + r] = i1[bi >> 4] * NK + i2[bi & 15];
        lastv = bv; lasti = bi;
    }
    const float inv = 1.0f / den;
    for (int r = 0; r < TOPK; ++r) gate[(size_t)row * 16 + r] *= inv;
}

#ifndef HOST_TEST
__global__ void k_mod(const float* c, const float* w_ada, const float* b_ada, float* mod) {
    const int i = blockIdx.x * 256 + threadIdx.x;
    if (i >= DEPTH * B * 6 * D) return;
    const int n = i % (6 * D), b = (i / (6 * D)) % B, l = i / (6 * D * B);
    mod[i] = mod_elem(c, w_ada + (size_t)l * D * 6 * D, b_ada + (size_t)l * 6 * D, b, n);
}
__global__ void k_hmod(const float* x, const float* g, const float* mod_l, int which, float* h) {
    const int row = blockIdx.x * 4 + (threadIdx.x >> 6), lane = threadIdx.x & 63;
    if (row >= T) return;
    const float* xr = x + (size_t)row * D;
    float s = 0.f;
    for (int k = lane; k < D; k += 64) s += xr[k] * xr[k];
    for (int o = 32; o; o >>= 1) s += __shfl_xor(s, o);
    const float rstd = 1.0f / sqrtf(s / D + EPS);
    const float* mod_b = mod_l + (size_t)(row / S) * 6 * D;
    for (int k = lane; k < D; k += 64) h[(size_t)row * D + k] = hmod_elem(xr[k], rstd, g[k], mod_b, which, k);
}
__global__ void k_gemm(const float* __restrict__ A, const float* __restrict__ Bm, float* __restrict__ C, int M, int N, int K) {
    __shared__ float As[16][64 + 1], Bs[16][64 + 1];
    const int tx = threadIdx.x & 15, ty = threadIdx.x >> 4, m0 = blockIdx.y * 64, n0 = blockIdx.x * 64;
    float acc[4][4];
#pragma unroll
    for (int i = 0; i < 4; ++i)
#pragma unroll
        for (int j = 0; j < 4; ++j) acc[i][j] = 0.f;
    for (int k0 = 0; k0 < K; k0 += 16) {
        for (int e = threadIdx.x; e < 64 * 16; e += 256) {
            const int r = e >> 4, kk = e & 15;
            As[kk][r] = A[(size_t)(m0 + r) * K + k0 + kk];
            const int kb = e >> 6, cb = e & 63;
            Bs[kb][cb] = Bm[(size_t)(k0 + kb) * N + n0 + cb];
        }
        __syncthreads();
#pragma unroll
        for (int kk = 0; kk < 16; ++kk) {
            float a[4], b[4];
#pragma unroll
            for (int i = 0; i < 4; ++i) { a[i] = As[kk][ty * 4 + i]; b[i] = Bs[kk][tx * 4 + i]; }
#pragma unroll
            for (int i = 0; i < 4; ++i)
#pragma unroll
                for (int j = 0; j < 4; ++j) acc[i][j] += a[i] * b[j];
        }
        __syncthreads();
    }
#pragma unroll
    for (int i = 0; i < 4; ++i)
#pragma unroll
        for (int j = 0; j < 4; ++j) C[(size_t)(m0 + ty * 4 + i) * N + n0 + tx * 4 + j] = acc[i][j];
}
__global__ void k_qkprep(const float* z, const float* qg, const float* kg, const int* positions, float* qn, float* kn) {
    const int i = blockIdx.x * 256 + threadIdx.x;
    if (i >= T * 10) return;
    const int t = i / 10, hh = i % 10;
    const int pos = positions[t];
    if (hh < 8) qk_prep(z + (size_t)t * INW + OQ + hh * 64, qg, pos, qn + (size_t)t * 512 + hh * 64);
    else        qk_prep(z + (size_t)t * INW + OK_ + (hh - 8) * 64, kg, pos, kn + (size_t)t * 128 + (hh - 8) * 64);
}
__global__ void __launch_bounds__(64) k_attn(const float* qn, const float* kn, const float* z, const float* sink_l, float* mixin) {
    const int i = blockIdx.x * 64 + threadIdx.x;
    if (i >= T * NQH) return;
    attn_row(qn, kn, z, sink_l, i / NQH, i % NQH, mixin);
}
__global__ void k_conv_pooled(const float* z, const float* conv_w_l, float* mixin, float* pooled) {
    const int i = blockIdx.x * 256 + threadIdx.x;
    if (i >= T * 256) return;
    const int t = i >> 8, c = i & 255;
    mixin[(size_t)t * D + 512 + c] = conv_elem(z, conv_w_l, t, c);
    pooled[i] = pooled_elem(z, t, c);
}
__global__ void k_poolo(const float* pooled, const float* pool_w_l, const float* pool_scale_l, float* mixin) {
    const int i = blockIdx.x * 256 + threadIdx.x;
    if (i >= T * 256) return;
    const int t = i >> 8, c = i & 255;
    mixin[(size_t)t * D + 768 + c] = poolo_elem(pooled, pool_w_l, pool_scale_l, t, c);
}
__global__ void k_resid(const float* xi, const float* y, const float* mod_l, int which, float* xo) {
    const size_t i = (size_t)blockIdx.x * 256 + threadIdx.x;
    if (i >= (size_t)T * D) return;
    const int n = (int)(i % D), t = (int)(i / D);
    xo[i] = xi[i] + mod_l[(size_t)(t / S) * 6 * D + (which * 3 + 2) * D + n] * y[i];
}
__global__ void k_score(const float* qp, const float* keys_l, float* sc) {
    const size_t i = (size_t)blockIdx.x * 256 + threadIdx.x;
    if (i >= (size_t)T * PH * 256) return;
    sc[i] = score_elem(qp, keys_l, (int)(i >> 8), (int)(i & 255));
}
__global__ void k_top1(const float* sc, float* selv, int* seli) {
    const int i = blockIdx.x * 256 + threadIdx.x;
    if (i >= T * PH * 2) return;
    top1_row(sc, selv, seli, i);
}
__global__ void k_top2(const float* selv, const int* seli, int* eidx, float* gate) {
    const int row = blockIdx.x * 256 + threadIdx.x;
    if (row >= T * PH) return;
    top2_row(selv, seli, eidx, gate, row);
}
__global__ void k_peer_u(const float* h2, const float* u_l, const int* eidx, const float* gate, float* wact) {
    const int i = blockIdx.x * 4 + (threadIdx.x >> 6), lane = threadIdx.x & 63;
    if (i >= T * 128) return;
    const int t = i >> 7;
    const float* ur = u_l + (size_t)eidx[i] * D; const float* hr = h2 + (size_t)t * D;
    float s = 0.f;
    for (int k = lane; k < D; k += 64) s += hr[k] * ur[k];
    for (int o = 32; o; o >>= 1) s += __shfl_xor(s, o);
    if (lane == 0) wact[i] = gate[i] * gelu_f(s);
}
__global__ void k_peer_v(const float* x1, const float* v_l, const int* eidx, const float* wact, const float* mod_l, float* x2) {
    const int t = blockIdx.x;
    float acc[4] = {0.f, 0.f, 0.f, 0.f};
    for (int k = 0; k < 128; ++k) {
        const float w = wact[(size_t)t * 128 + k]; const float* vr = v_l + (size_t)eidx[(size_t)t * 128 + k] * D;
#pragma unroll
        for (int j = 0; j < 4; ++j) acc[j] += w * vr[threadIdx.x + 256 * j];
    }
    const float* g2 = mod_l + (size_t)(t / S) * 6 * D + 5 * D;
#pragma unroll
    for (int j = 0; j < 4; ++j) { const int n = threadIdx.x + 256 * j; x2[(size_t)t * D + n] = x1[(size_t)t * D + n] + g2[n] * acc[j]; }
}


namespace pg8 {
#define PG8_LAS __attribute__((address_space(3)))
typedef unsigned short bf16_t;
typedef short bf16x8 __attribute__((ext_vector_type(8)));
typedef float f32x4 __attribute__((ext_vector_type(4)));
typedef unsigned u32x4 __attribute__((ext_vector_type(4)));
constexpr int BM = 256, BK = 64, HALF = 128, HTB = HALF * BK * 2  , STAGE_BYTES = 8 * HTB, NXCD = 8, WGM = 8;

__host__ __device__ __forceinline__ int lds_byte(int r, int c) { const int st = (r >> 4) * 2 + (c >> 5), rr = r & 15, cc = c & 31, ob = rr * 64 + cc * 2; return st * 1024 + (ob ^ (((ob >> 9) & 1) << 5)); }
__host__ __device__ __forceinline__ void stage_rc(int b, int& R, int& C) { const int st = b / 1024, sb = b % 1024, swz = sb ^ (((sb >> 9) & 1) << 5); R = (st >> 1) * 16 + swz / 64; C = (st & 1) * 32 + (swz % 64) / 2; }
__host__ __device__ __forceinline__ int perm32(int rho) { const int n = rho >> 4, i = rho & 15; return 8 * (i >> 2) + 4 * n + (i & 3); }

struct Unit { int pm, pn; };
struct Gemm { const bf16_t* A; const bf16_t* Bt; int M, N, K; };

struct StaticOrder {
    int nM, nN, nwg, G, c;
    __host__ __device__ void init(int M, int N, int G_, int c_) { nM = M / BM; nN = N / BM; nwg = nM * nN; G = G_; c = c_; }
    __host__ __device__ bool next(int i, Unit& u) const {
        const long L = (long)i * G + c; if (L >= nwg) return false;
        int wgid = (int)L; { const int q = nwg / NXCD, r = nwg % NXCD, xcd = wgid % NXCD, off = wgid / NXCD; wgid = (xcd < r ? xcd * (q + 1) : r * (q + 1) + (xcd - r) * q) + off; }
        const int nig = WGM * nN, gid = wgid / nig, fm = gid * WGM, gsz = (nM - fm) < WGM ? (nM - fm) : WGM;
        u.pm = fm + ((wgid % nig) % gsz); u.pn = (wgid % nig) / gsz; return true;
    }
    __device__ __forceinline__ void a_ready(const Unit&) const {}
    __device__ __forceinline__ void done(const Unit&) const {}
};

__device__ __forceinline__ unsigned cvt_pk_bf16(float lo, float hi) { unsigned r; asm volatile("v_cvt_pk_bf16_f32 %0, %1, %2" : "=v"(r) : "v"(lo), "v"(hi)); return r; }
typedef float f32x2 __attribute__((ext_vector_type(2)));
__device__ __forceinline__ f32x2 gelu_pk(f32x2 v) {
    const f32x2 av = __builtin_elementwise_abs(v), d = av * 0.2316418882f + 1.0f;
    f32x2 t; t.x = __builtin_amdgcn_rcpf(d.x); t.y = __builtin_amdgcn_rcpf(d.y);
    f32x2 q = t * 0.5307027145f + (-0.7265760135f); q = q * t + 0.7107068705f; q = q * t + (-0.142248368f); q = q * t + 0.127414796f; q = q * t;
    const f32x2 s = (v * v) * (-0.72134752044f);
    f32x2 e; e.x = __builtin_amdgcn_exp2f(s.x); e.y = __builtin_amdgcn_exp2f(s.y);
    const f32x2 m = v * (q * e), r = v - m;
    f32x2 o; o.x = v.x < 0.f ? m.x : r.x; o.y = v.y < 0.f ? m.y : r.y; return o;
}

template <int ACT  > struct EpiBf16 {
    static constexpr bool PERM = true, AFTER_DRAIN = false; static_assert(ACT == 0 || ACT == 1, "EpiBf16: ACT is 0 (none) or 1 (gelu_pk)");
    bf16_t* O; int ldc; const float* bias; int split_cols; size_t split_stride; float scale0;
    __device__ __forceinline__ void operator()(const f32x4 (&acc)[2][2][4][2], const Unit& u, int wr, int wc, int fr, int fq) const {
        const int row0 = u.pm * BM + wr * 64 + fr; int colt = u.pn * BM; bf16_t* base = O;
        float sc = 1.f; if (split_cols) { const int t = colt / split_cols; base += (size_t)t * split_stride; colt -= t * split_cols; if (t == 0) sc = scale0; }
        const int col0 = colt + wc * 32 + 8 * fq, bcol0 = u.pn * BM + wc * 32 + 8 * fq;
        f32x4 bv[2][2];
#pragma unroll
        for (int bj = 0; bj < 2; ++bj)
#pragma unroll
            for (int n = 0; n < 2; ++n) bv[bj][n] = bias ? *(const f32x4*)(bias + bcol0 + bj * HALF + 4 * n) : (f32x4){0.f, 0.f, 0.f, 0.f};
#pragma unroll
        for (int ai = 0; ai < 2; ++ai)
#pragma unroll
            for (int m = 0; m < 4; ++m) { bf16_t* rowp = base + (size_t)(row0 + ai * HALF + m * 16) * ldc + col0;
#pragma unroll
                for (int bj = 0; bj < 2; ++bj) { f32x4 v0 = acc[ai][bj][m][0] + bv[bj][0], v1 = acc[ai][bj][m][1] + bv[bj][1];
                    if (ACT == 1) { f32x2 a = gelu_pk((f32x2){v0[0], v0[1]}), b = gelu_pk((f32x2){v0[2], v0[3]}), c = gelu_pk((f32x2){v1[0], v1[1]}), d = gelu_pk((f32x2){v1[2], v1[3]});
                        v0 = (f32x4){a.x, a.y, b.x, b.y}; v1 = (f32x4){c.x, c.y, d.x, d.y}; }
                    v0 = v0 * sc; v1 = v1 * sc; u32x4 w; w.x = cvt_pk_bf16(v0[0], v0[1]); w.y = cvt_pk_bf16(v0[2], v0[3]); w.z = cvt_pk_bf16(v1[0], v1[1]); w.w = cvt_pk_bf16(v1[2], v1[3]);
                    *(u32x4*)(rowp + bj * HALF) = w; } }
    }
};

template <class Epi, class Sched, bool ALIGN_EPI = false, bool SP2 = false>
__device__ __forceinline__ void gemm_phase(PG8_LAS unsigned char* lds, const Gemm g, const Sched& S, const Epi& E) {
    const int tid = threadIdx.x, wid = __builtin_amdgcn_readfirstlane(tid >> 6), lane = tid & 63, wr = wid >> 2, wc = wid & 3, fr = lane & 15, fq = lane >> 4;
    const int K = g.K, nt = K / BK;
    unsigned voffA[2], voffB[2];
#pragma unroll
    for (int i = 0; i < 2; ++i) { int R, C; stage_rc(tid * 16 + i * 8192, R, C); const int Rb = Epi::PERM ? ((R & ~31) + perm32(R & 31)) : R;
        voffA[i] = (unsigned)(R * K + C) * 2u; voffB[i] = (unsigned)(Rb * K + C) * 2u; }
    const size_t kstep = (size_t)(BK * 2);
    const size_t hstep = (size_t)HALF * K * 2;
    const size_t tstep = 2 * hstep;
    const unsigned ldsw = (unsigned)wid * 1024u;
    const int aoff = lds_byte(wr * 64 + fr, fq * 8), boff = lds_byte(wc * 32 + fr, fq * 8);
#define PG8_SA(b, h) (((b) * 2 + (h)) * HTB)
#define PG8_SB(b, h) ((4 + (b) * 2 + (h)) * HTB)
#define PG8_STAGE(bufoff, gbase, voff) do { _Pragma("unroll") for (int _i = 0; _i < 2; ++_i) \
        __builtin_amdgcn_global_load_lds((const unsigned*)((const char*)(gbase) + (voff)[_i]), (PG8_LAS unsigned*)(lds + (bufoff) + ldsw + _i * 8192), 16, 0, 0); } while (0)
#define PG8_LDA(dst, b, h) do { _Pragma("unroll") for (int m = 0; m < 4; ++m) _Pragma("unroll") for (int k = 0; k < 2; ++k) dst[m][k] = *(const PG8_LAS bf16x8*)(lds + PG8_SA(b, h) + aoff + m * 2048 + k * 1024); } while (0)
#define PG8_LDB(dst, b, h) do { _Pragma("unroll") for (int n = 0; n < 2; ++n) _Pragma("unroll") for (int k = 0; k < 2; ++k) dst[n][k] = *(const PG8_LAS bf16x8*)(lds + PG8_SB(b, h) + boff + n * 2048 + k * 1024); } while (0)
#define PG8_MMA(ai, bj, At, Bt) do { __builtin_amdgcn_s_setprio(1); _Pragma("unroll") for (int m = 0; m < 4; ++m) _Pragma("unroll") for (int n = 0; n < 2; ++n) _Pragma("unroll") for (int k = 0; k < 2; ++k) \
        acc[ai][bj][m][n] = __builtin_amdgcn_mfma_f32_16x16x32_bf16(Bt[n][k], At[m][k], acc[ai][bj][m][n], 0, 0, 0); __builtin_amdgcn_s_setprio(0); } while (0)
#define PG8_WAIT_V(n) asm volatile("s_waitcnt vmcnt(" #n ")" ::: "memory")
#define PG8_WAIT_L(n) asm volatile("s_waitcnt lgkmcnt(" #n ")" ::: "memory")
#define PG8_BAR __builtin_amdgcn_s_barrier()
#define PG8_SCHED __builtin_amdgcn_sched_barrier(0)
    Unit cur, nxt; int ui = 0;
    if (!S.next(0, cur)) return;
    f32x4 acc[2][2][4][2];
#pragma unroll
    for (int a = 0; a < 2; ++a)
#pragma unroll
        for (int b = 0; b < 2; ++b)
#pragma unroll
            for (int m = 0; m < 4; ++m)
#pragma unroll
                for (int n = 0; n < 2; ++n) acc[a][b][m][n] = (f32x4){0.f, 0.f, 0.f, 0.f};
    bf16x8 At[4][2], B0[2][2], B1[2][2];
    const char* cA = (const char*)g.A + (size_t)cur.pm * tstep; const char* cB = (const char*)g.Bt + (size_t)cur.pn * tstep;
    S.a_ready(cur);
    if constexpr (SP2) {
        PG8_STAGE(PG8_SB(0, 0), cB, voffB); PG8_STAGE(PG8_SB(0, 1), cB + hstep, voffB); PG8_STAGE(PG8_SA(0, 0), cA, voffA); PG8_STAGE(PG8_SA(0, 1), cA + hstep, voffA);
        if (wr == 1) PG8_BAR;
        PG8_WAIT_V(2); PG8_BAR;
        PG8_STAGE(PG8_SB(1, 0), cB + kstep, voffB); PG8_STAGE(PG8_SA(1, 0), cA + kstep, voffA); PG8_STAGE(PG8_SB(1, 1), cB + hstep + kstep, voffB);
        PG8_WAIT_V(6); PG8_BAR;
    } else {
        PG8_STAGE(PG8_SB(0, 0), cB, voffB); PG8_STAGE(PG8_SA(0, 0), cA, voffA); PG8_STAGE(PG8_SB(0, 1), cB + hstep, voffB); PG8_STAGE(PG8_SA(0, 1), cA + hstep, voffA);
        if (wr == 1) PG8_BAR;
        PG8_WAIT_V(4); PG8_BAR;
        PG8_STAGE(PG8_SB(1, 0), cB + kstep, voffB); PG8_STAGE(PG8_SA(1, 0), cA + kstep, voffA); PG8_STAGE(PG8_SB(1, 1), cB + hstep + kstep, voffB);
        PG8_WAIT_V(6); PG8_BAR;
    }
    for (;;) {
        const bool has_next = S.next(ui + 1, nxt);
        const char* nA = has_next ? (const char*)g.A + (size_t)nxt.pm * tstep : cA; const char* nB = has_next ? (const char*)g.Bt + (size_t)nxt.pn * tstep : cB;
        for (int t = 0; t < nt; t += 2) {
            const bool last = (t == nt - 2);
            const char* a1 = cA + (size_t)(t + 1) * kstep;
            const char* a2 = last ? nA : cA + (size_t)(t + 2) * kstep; const char* b2 = last ? nB : cB + (size_t)(t + 2) * kstep;
            const char* a3 = a2 + kstep; const char* b3 = b2 + kstep;
            if (last && has_next) S.a_ready(nxt);
            if constexpr (SP2) {
            PG8_LDB(B0, 0, 0); PG8_LDB(B1, 0, 1); PG8_SCHED; PG8_LDA(At, 0, 0); PG8_STAGE(PG8_SA(1, 1), a1 + hstep, voffA);
            PG8_WAIT_V(8); PG8_WAIT_L(0); PG8_BAR; PG8_MMA(0, 0, At, B0); PG8_MMA(0, 1, At, B1); PG8_BAR; PG8_SCHED;
            PG8_LDA(At, 0, 1); PG8_STAGE(PG8_SB(0, 0), b2, voffB); PG8_STAGE(PG8_SB(0, 1), b2 + hstep, voffB); PG8_STAGE(PG8_SA(0, 0), a2, voffA);
            PG8_WAIT_V(8); PG8_WAIT_L(0); PG8_BAR; PG8_MMA(1, 0, At, B0); PG8_MMA(1, 1, At, B1); PG8_BAR; PG8_SCHED;
            PG8_LDB(B0, 1, 0); PG8_LDB(B1, 1, 1); PG8_SCHED; PG8_LDA(At, 1, 0); PG8_STAGE(PG8_SA(0, 1), a2 + hstep, voffA);
            PG8_WAIT_V(8); PG8_WAIT_L(0); PG8_BAR; PG8_MMA(0, 0, At, B0); PG8_MMA(0, 1, At, B1); PG8_BAR; PG8_SCHED;
            PG8_LDA(At, 1, 1); PG8_STAGE(PG8_SB(1, 0), b3, voffB); PG8_STAGE(PG8_SB(1, 1), b3 + hstep, voffB); PG8_STAGE(PG8_SA(1, 0), a3, voffA);
            PG8_WAIT_V(8); PG8_WAIT_L(0); PG8_BAR; PG8_MMA(1, 0, At, B0); PG8_MMA(1, 1, At, B1); PG8_BAR; PG8_SCHED;
            } else {
            PG8_LDB(B0, 0, 0); PG8_SCHED; PG8_LDA(At, 0, 0); PG8_STAGE(PG8_SA(1, 1), a1 + hstep, voffA);
            PG8_WAIT_L(8); PG8_BAR; PG8_WAIT_L(0); PG8_MMA(0, 0, At, B0); PG8_BAR; PG8_SCHED;
            PG8_LDB(B1, 0, 1); PG8_STAGE(PG8_SB(0, 0), b2, voffB);
            PG8_BAR; PG8_WAIT_L(0); PG8_MMA(0, 1, At, B1); PG8_BAR;
            PG8_LDA(At, 0, 1); PG8_STAGE(PG8_SA(0, 0), a2, voffA);
            PG8_BAR; PG8_WAIT_L(0); PG8_MMA(1, 0, At, B0); PG8_BAR; PG8_SCHED;
            PG8_STAGE(PG8_SB(0, 1), b2 + hstep, voffB);
            PG8_WAIT_V(6); PG8_BAR; PG8_MMA(1, 1, At, B1); PG8_BAR;
            PG8_LDB(B0, 1, 0); PG8_SCHED; PG8_LDA(At, 1, 0); PG8_STAGE(PG8_SA(0, 1), a2 + hstep, voffA);
            PG8_WAIT_L(8); PG8_BAR; PG8_WAIT_L(0); PG8_MMA(0, 0, At, B0); PG8_BAR; PG8_SCHED;
            PG8_LDB(B1, 1, 1); PG8_STAGE(PG8_SB(1, 0), b3, voffB);
            PG8_BAR; PG8_WAIT_L(0); PG8_MMA(0, 1, At, B1); PG8_BAR;
            PG8_LDA(At, 1, 1); PG8_STAGE(PG8_SA(1, 0), a3, voffA);
            PG8_BAR; PG8_WAIT_L(0); PG8_MMA(1, 0, At, B0); PG8_BAR; PG8_SCHED;
            PG8_STAGE(PG8_SB(1, 1), b3 + hstep, voffB);
            PG8_WAIT_V(6); PG8_BAR; PG8_MMA(1, 1, At, B1); PG8_BAR;
            }
        }
        if constexpr (ALIGN_EPI) { if (wr == 0) PG8_BAR; }
        if constexpr (!Epi::AFTER_DRAIN) { E(acc, cur, wr, wc, fr, fq); S.done(cur); }
        if (!has_next) break;
#pragma unroll
        for (int a = 0; a < 2; ++a)
#pragma unroll
            for (int b = 0; b < 2; ++b)
#pragma unroll
                for (int m = 0; m < 4; ++m)
#pragma unroll
                    for (int n = 0; n < 2; ++n) acc[a][b][m][n] = (f32x4){0.f, 0.f, 0.f, 0.f};
        cur = nxt; cA = nA; cB = nB; ++ui;
        if constexpr (ALIGN_EPI) { if (wr == 1) PG8_BAR; }
    }
    PG8_WAIT_V(0);
    if constexpr (!ALIGN_EPI) { if (wr == 0) PG8_BAR; }
    PG8_BAR;
    if constexpr (Epi::AFTER_DRAIN) { E.fused(acc, cur, wr, wc, fr, fq, lds, wid, lane); S.done(cur); }
#undef PG8_SA
#undef PG8_SB
#undef PG8_STAGE
#undef PG8_LDA
#undef PG8_LDB
#undef PG8_MMA
#undef PG8_WAIT_V
#undef PG8_WAIT_L
#undef PG8_BAR
#undef PG8_SCHED
}
}

namespace pg8 {
struct EpiF32 {
    static constexpr bool PERM = false, AFTER_DRAIN = false;
    float* C; int ldc;
    __device__ __forceinline__ void operator()(const f32x4 (&acc)[2][2][4][2], const Unit& u, int wr, int wc, int fr, int fq) const {
        const int row0 = u.pm * BM + wr * 64 + fr, col0 = u.pn * BM + wc * 32 + 4 * fq;
#pragma unroll
        for (int ai = 0; ai < 2; ++ai)
#pragma unroll
            for (int m = 0; m < 4; ++m) { float* rowp = C + (size_t)(row0 + ai * HALF + m * 16) * ldc + col0;
#pragma unroll
                for (int bj = 0; bj < 2; ++bj)
#pragma unroll
                    for (int n = 0; n < 2; ++n) *(f32x4*)(rowp + bj * HALF + n * 16) = acc[ai][bj][m][n]; }
    }
};
struct EpiResid {
    static constexpr bool PERM = false, AFTER_DRAIN = false;
    const float* base; float* out; int ldc; const float* gate0; int rows_per_b; int gstride;
    __device__ __forceinline__ void operator()(const f32x4 (&acc)[2][2][4][2], const Unit& u, int wr, int wc, int fr, int fq) const {
        const int row0 = u.pm * BM + wr * 64 + fr, col0 = u.pn * BM + wc * 32 + 4 * fq;
        const float* gp = gate0 + (size_t)((u.pm * BM) / rows_per_b) * gstride + col0;
        f32x4 gv[2][2];
#pragma unroll
        for (int bj = 0; bj < 2; ++bj)
#pragma unroll
            for (int n = 0; n < 2; ++n) gv[bj][n] = *(const f32x4*)(gp + bj * HALF + n * 16);
#pragma unroll
        for (int ai = 0; ai < 2; ++ai)
#pragma unroll
            for (int m = 0; m < 4; ++m) { const size_t off = (size_t)(row0 + ai * HALF + m * 16) * ldc + col0;
#pragma unroll
                for (int bj = 0; bj < 2; ++bj)
#pragma unroll
                    for (int n = 0; n < 2; ++n) { const f32x4 bs = *(const f32x4*)(base + off + bj * HALF + n * 16);
                        *(f32x4*)(out + off + bj * HALF + n * 16) = bs + gv[bj][n] * acc[ai][bj][m][n]; }
                if (m & 1) asm volatile("" ::: "memory"); }
    }
};
}

namespace mk {
#define GAS __attribute__((address_space(1)))
#define LAS __attribute__((address_space(3)))
typedef unsigned short bf16;
typedef unsigned v4u __attribute__((ext_vector_type(4)));
typedef unsigned v2u __attribute__((ext_vector_type(2)));
typedef float f32x4 __attribute__((ext_vector_type(4)));
#define LDS_WAIT() asm volatile("s_waitcnt lgkmcnt(0)" ::: "memory")
#define VM_WAIT() asm volatile("s_waitcnt vmcnt(0)" ::: "memory")
__device__ __forceinline__ unsigned f2bf(float f) { unsigned u = __builtin_bit_cast(unsigned, f); return (u + 0x7fffu + ((u >> 16) & 1u)) >> 16; }
__device__ __forceinline__ unsigned pk2(float lo, float hi) { return f2bf(lo) | (f2bf(hi) << 16); }
__device__ __forceinline__ float bf2f(unsigned short h) { return __builtin_bit_cast(float, (unsigned)h << 16); }

constexpr int NWAVES = 8, NT = 512;
constexpr int RING_BYTES = 131072, LDSCTL_OFF = RING_BYTES, LDS_BYTES = 147456;
constexpr size_t MiB = 1u << 20;
constexpr size_t WS_CTL = 0, CTL_ZERO_BYTES = 1 * MiB;
constexpr size_t WS_MOD = 1 * MiB, WS_KEYS = 2 * MiB, WS_WIN = 4 * MiB, WS_WOUT = 12 * MiB, WS_WQ = 16 * MiB, WS_H = 24 * MiB, WS_X1 = 56 * MiB;
constexpr size_t WS_EIDX = 120 * MiB, WS_GATE = 128 * MiB, WS_A = 136 * MiB, WS_MIX = 200 * MiB, WS_U = 232 * MiB, WS_V = 296 * MiB, WS_END = 360 * MiB;
constexpr size_t WS_T1 = 232 * MiB, WS_T2 = 360 * MiB, WS_TEND = 488 * MiB;
constexpr int CW_BAR = 4096;

enum { PH_PRO = 0, PH_H0 = 1, PH_L0 = 2, PH_PER_LAYER = 7, PH_G1 = 0, PH_AT = 1, PH_G2 = 2, PH_N2 = 3, PH_G3 = 4, PH_TK = 5, PH_PE = 6, PH_END = PH_L0 + 2 * PH_PER_LAYER, PH_H1 = 100 };

struct Args { const float* in[19]; float* out; unsigned char* ws; int ph_lo, ph_hi; };

__device__ __forceinline__ void p0_transpose_item(const float* W, int K, int N, bf16* WT, LAS float* scr, int item, int lane) {
    const int nblk = N / 32, kb = item / nblk, nb = item % nblk, k0 = 64 * kb, n0 = 32 * nb;
#pragma unroll 8
    for (int i = 0; i < 32; ++i) { const int kk = 2 * i + (lane >> 5); scr[kk * 33 + (lane & 31)] = W[(size_t)(k0 + kk) * N + n0 + (lane & 31)]; }
    LDS_WAIT(); asm volatile("" ::: "memory");
    const int c = lane & 7;
#pragma unroll
    for (int j = 0; j < 4; ++j) { const int n = (lane >> 3) + 8 * j; const LAS float* s = scr + (8 * c) * 33 + n;
        v4u o; o.x = pk2(s[0 * 33], s[1 * 33]); o.y = pk2(s[2 * 33], s[3 * 33]); o.z = pk2(s[4 * 33], s[5 * 33]); o.w = pk2(s[6 * 33], s[7 * 33]);
        *(GAS v4u*)(WT + (size_t)(n0 + n) * K + k0 + 8 * c) = o; }
    LDS_WAIT(); asm volatile("" ::: "memory");
}
__device__ __forceinline__ float wave_sum(float v) {
#pragma unroll
    for (int o = 1; o < 64; o <<= 1) v += __shfl_xor(v, o);
    return v;
}
__device__ __forceinline__ void hmod_row(const float* xrow, const float* g, const float* mod_b, int which, bf16* orow, int lane) {
    const GAS f32x4* xr = (const GAS f32x4*)xrow + lane;
    f32x4 v[4]; float s = 0.f;
#pragma unroll
    for (int j = 0; j < 4; ++j) { v[j] = xr[64 * j]; s += (v[j].x * v[j].x + v[j].y * v[j].y) + (v[j].z * v[j].z + v[j].w * v[j].w); }
    const float rstd = 1.0f / sqrtf(wave_sum(s) * (1.f / D) + EPS);
    const float* shp = mod_b + (which * 3 + 0) * D; const float* scp = mod_b + (which * 3 + 1) * D;
    GAS unsigned long long* o8 = (GAS unsigned long long*)orow + lane;
#pragma unroll
    for (int j = 0; j < 4; ++j) { const int k = 4 * lane + 256 * j;
        const f32x4 gg = *(const f32x4*)(g + k), sh = *(const f32x4*)(shp + k), sc = *(const f32x4*)(scp + k);
        const f32x4 hv = v[j] * rstd * gg * (sc + 1.0f) + sh;
        o8[64 * j] = (unsigned long long)pk2(hv.x, hv.y) | ((unsigned long long)pk2(hv.z, hv.w) << 32); }
}


#define MK_GW(wave) (((gridDim.x % 8 == 0) ? (blockIdx.x % 8) * (gridDim.x / 8) + blockIdx.x / 8 : blockIdx.x) * NWAVES + (wave))
#define MK_NGW (gridDim.x * NWAVES)

__device__ __forceinline__ void ph_prologue(const Args& args, LAS unsigned char* lds) {
    const int tid = threadIdx.x, lane = tid & 63, wave = __builtin_amdgcn_readfirstlane(tid >> 6);
    const int G = gridDim.x, bx = blockIdx.x;
    unsigned char* ws = args.ws;
    {
        const float* c = args.in[1]; const float* w_ada = args.in[5]; const float* b_ada = args.in[6]; float* mod = (float*)(ws + WS_MOD);
        LAS float* sact = (LAS float*)lds; LAS float* red = (LAS float*)(lds + 32768);
        for (int i = tid; i < B * D; i += NT) { const float cv = c[i]; sact[i] = cv / (1.0f + __expf(-cv)); }
        __syncthreads();
        for (int item = bx; item < DEPTH * (6 * D / 32); item += G) {
            const int l = item / (6 * D / 32), n0 = (item % (6 * D / 32)) * 32, cc = tid & 31, kg = tid >> 5;
            float acc[B];
#pragma unroll
            for (int b = 0; b < B; ++b) acc[b] = 0.f;
            const float* w = w_ada + (size_t)l * D * 6 * D + n0 + cc;
            for (int kk = 0; kk < 64; ++kk) { const int k = kg * 64 + kk; const float wv = w[(size_t)k * 6 * D];
#pragma unroll
                for (int b = 0; b < B; ++b) acc[b] += sact[b * D + k] * wv; }
#pragma unroll
            for (int b = 0; b < B; ++b) red[(kg * 32 + cc) * B + b] = acc[b];
            __syncthreads();
            if (tid < 32 * B) { const int c2 = tid & 31, b = tid >> 5; float s = 0.f;
                for (int k2 = 0; k2 < 16; ++k2) s += red[(k2 * 32 + c2) * B + b];
                mod[((size_t)l * B + b) * 6 * D + n0 + c2] = s + b_ada[(size_t)l * 6 * D + n0 + c2]; }
            __syncthreads();
        }
    }
    const int gw = MK_GW(wave), NGW = MK_NGW;
    {
        const float* w_in = args.in[7]; const float* w_out = args.in[14]; const float* peer_wq = args.in[15];
        bf16* WinT = (bf16*)(ws + WS_WIN); bf16* WoutT = (bf16*)(ws + WS_WOUT); bf16* WqT = (bf16*)(ws + WS_WQ);
        LAS float* scr = (LAS float*)(lds + wave * 16384);
        constexpr int I_IN = (D / 64) * (INW / 32), I_OUT = (D / 64) * (D / 32), I_Q = (D / 64) * (PW / 32), I_L = I_IN + I_OUT + I_Q;
        for (int it = gw; it < DEPTH * I_L; it += NGW) {
            const int l = it / I_L; int r = it % I_L;
            if (r < I_IN) { p0_transpose_item(w_in + (size_t)l * D * INW, D, INW, WinT + (size_t)l * INW * D, scr, r, lane); continue; } r -= I_IN;
            if (r < I_OUT) { p0_transpose_item(w_out + (size_t)l * D * D, D, D, WoutT + (size_t)l * D * D, scr, r, lane); continue; } r -= I_OUT;
            p0_transpose_item(peer_wq + (size_t)l * D * PW, D, PW, WqT + (size_t)l * PW * D, scr, r, lane);
        }
    }
    {
        const float* peer_keys = args.in[16]; bf16* keysb = (bf16*)(ws + WS_KEYS);
        for (int i = gw * 64 + lane; i < DEPTH * 2 * NK * 128 / 2; i += NGW * 64) ((GAS unsigned*)keysb)[i] = pk2(peer_keys[2 * i], peer_keys[2 * i + 1]);
    }
#if DO_UV
    {
        const float* peer_u = args.in[17]; const float* peer_v = args.in[18]; bf16* Ub = (bf16*)(ws + WS_U); bf16* Vb = (bf16*)(ws + WS_V);
        for (size_t i = (size_t)gw * 64 + lane; i < (size_t)DEPTH * NE * D / 8; i += (size_t)NGW * 64) {
            { const f32x4 a = ((const GAS f32x4*)peer_u)[2 * i], b = ((const GAS f32x4*)peer_u)[2 * i + 1];
              v4u o; o.x = pk2(a.x, a.y); o.y = pk2(a.z, a.w); o.z = pk2(b.x, b.y); o.w = pk2(b.z, b.w); ((GAS v4u*)Ub)[i] = o; }
            { const f32x4 a = ((const GAS f32x4*)peer_v)[2 * i], b = ((const GAS f32x4*)peer_v)[2 * i + 1];
              v4u o; o.x = pk2(a.x, a.y); o.y = pk2(a.z, a.w); o.z = pk2(b.x, b.y); o.w = pk2(b.z, b.w); ((GAS v4u*)Vb)[i] = o; }
        }
    }
#endif
}
template <int L, int WHICH> __device__ __forceinline__ void ph_hmod(const Args& args) {
    const int lane = threadIdx.x & 63, wave = __builtin_amdgcn_readfirstlane(threadIdx.x >> 6);
    unsigned char* ws = args.ws;
    const float* src = WHICH ? (const float*)(ws + WS_X1) : (L == 0 ? args.in[0] : args.out);
    const float* g = args.in[WHICH ? 4 : 3] + L * D; const float* mod_l = (const float*)(ws + WS_MOD) + (size_t)L * B * 6 * D; bf16* Hb = (bf16*)(ws + WS_H);
    const int gw = MK_GW(wave), NGW = MK_NGW;
    for (int m = gw; m < T; m += NGW) hmod_row(src + (size_t)m * D, g, mod_l + (size_t)(m / S) * 6 * D, WHICH, Hb + (size_t)m * D, lane);
}
template <int L> __device__ __forceinline__ void ph_g1(const Args& args, LAS unsigned char* lds) {
    unsigned char* ws = args.ws;
    pg8::Gemm g{(const bf16*)(ws + WS_H), (const bf16*)(ws + WS_WIN) + (size_t)L * INW * D, T, INW, D}; pg8::StaticOrder SO; SO.init(T, INW, gridDim.x, blockIdx.x);
#if Z_F32
    pg8::EpiF32 E{(float*)(ws + WS_T1), INW};
    pg8::gemm_phase<pg8::EpiF32, pg8::StaticOrder, true, true>(lds, g, SO, E);
#else
    pg8::EpiBf16<0> E{(bf16*)(ws + WS_A), INW, nullptr, 0, 0, 1.f};
    pg8::gemm_phase<pg8::EpiBf16<0>, pg8::StaticOrder, true, true>(lds, g, SO, E);
#endif
}
template <int L> __device__ __forceinline__ void ph_g2(const Args& args, LAS unsigned char* lds) {
    unsigned char* ws = args.ws;
    pg8::Gemm g{(const bf16*)(ws + WS_MIX), (const bf16*)(ws + WS_WOUT) + (size_t)L * D * D, T, D, D}; pg8::StaticOrder SO; SO.init(T, D, gridDim.x, blockIdx.x);
    pg8::EpiResid E{L == 0 ? args.in[0] : args.out, (float*)(ws + WS_X1), D, (const float*)(ws + WS_MOD) + (size_t)L * B * 6 * D + 2 * D, S, 6 * D};
    pg8::gemm_phase<pg8::EpiResid, pg8::StaticOrder, true, true>(lds, g, SO, E);
}
template <int L> __device__ __forceinline__ void ph_g3(const Args& args, LAS unsigned char* lds) {
    unsigned char* ws = args.ws;
    pg8::Gemm g{(const bf16*)(ws + WS_H), (const bf16*)(ws + WS_WQ) + (size_t)L * PW * D, T, PW, D}; pg8::StaticOrder SO; SO.init(T, PW, gridDim.x, blockIdx.x);
#if QP_F32
    pg8::EpiF32 E{(float*)(ws + WS_T1), PW};
    pg8::gemm_phase<pg8::EpiF32, pg8::StaticOrder, true, true>(lds, g, SO, E);
#else
    pg8::EpiBf16<0> E{(bf16*)(ws + WS_A), PW, nullptr, 0, 0, 1.f};
    pg8::gemm_phase<pg8::EpiBf16<0>, pg8::StaticOrder, true, true>(lds, g, SO, E);
#endif
}
}


namespace mk {
typedef short bf16x8 __attribute__((ext_vector_type(8)));
typedef float f32x16 __attribute__((ext_vector_type(16)));
__device__ __forceinline__ unsigned f2sort(float f) { const unsigned u = __builtin_bit_cast(unsigned, f); return u ^ ((unsigned)((int)u >> 31) | 0x80000000u); }
__device__ __forceinline__ float sort2f(unsigned s) { const unsigned m = (unsigned)((int)s >> 31); return __builtin_bit_cast(float, s ^ (~m | 0x80000000u)); }
__device__ __forceinline__ unsigned umax_(unsigned a, unsigned b) { return a > b ? a : b; }
__device__ __forceinline__ unsigned umin_(unsigned a, unsigned b) { return a < b ? a : b; }
__device__ __forceinline__ void sort16_desc(unsigned (&v)[16]) {
#pragma unroll
    for (int k = 2; k <= 16; k <<= 1)
#pragma unroll
        for (int j = k >> 1; j > 0; j >>= 1)
#pragma unroll
            for (int i = 0; i < 16; ++i) { const int l = i ^ j; if (l > i) { const unsigned a = v[i], b = v[l], mx = umax_(a, b), mn = umin_(a, b);
                if ((i & k) == 0) { v[i] = mx; v[l] = mn; } else { v[i] = mn; v[l] = mx; } } }
}
__device__ __forceinline__ void merge16_desc(unsigned (&a)[16], const unsigned (&b)[16]) {
#pragma unroll
    for (int i = 0; i < 16; ++i) a[i] = umax_(a[i], b[15 - i]);
#pragma unroll
    for (int j = 8; j > 0; j >>= 1)
#pragma unroll
        for (int i = 0; i < 16; ++i) { const int l = i ^ j; if (l > i) { const unsigned x = a[i], y = a[l]; a[i] = umax_(x, y); a[l] = umin_(x, y); } }
}
__device__ __forceinline__ void xmerge16_desc(unsigned (&a)[16]) {
    unsigned p[16];
#pragma unroll
    for (int i = 0; i < 16; ++i) p[i] = (unsigned)__shfl_xor((int)a[i], 32);
    merge16_desc(a, p);
}
#define TK_CANDS \
    TKC(0, 0, 0, 2, 1) \
    TKC(1, 0, 1, 2, 2) \
    TKC(2, 0, 2, 2, 3) \
    TKC(3, 0, 3, 2, 4) \
    TKC(4, 0, 4, 3, 0) \
    TKC(5, 0, 5, 3, 1) \
    TKC(6, 0, 6, 3, 2) \
    TKC(7, 0, 7, 3, 3) \
    TKC(8, 0, 8, 4, 0) \
    TKC(9, 0, 9, 4, 1) \
    TKC(10, 0, 10, 4, 2) \
    TKC(11, 0, 11, 5, 0) \
    TKC(12, 0, 12, 5, 1) \
    TKC(13, 0, 13, 6, 0) \
    TKC(14, 0, 14, 6, 1) \
    TKC(15, 0, 15, 7, 0) \
    TKC(16, 1, 0, 7, 1) \
    TKC(17, 1, 1, 8, 0) \
    TKC(18, 1, 2, 9, 0) \
    TKC(19, 1, 3, 10, 0) \
    TKC(20, 1, 4, 11, 0) \
    TKC(21, 1, 5, 12, 0) \
    TKC(22, 1, 6, 13, 0) \
    TKC(23, 1, 7, 14, 0) \
    TKC(24, 2, 0, 15, 0)

template <int L> __device__ __forceinline__ void ph_topk(const Args& args, LAS unsigned char* lds) {
    const int tid = threadIdx.x, lane = tid & 63, wave = __builtin_amdgcn_readfirstlane(tid >> 6);
    const int c = lane & 31, hi = lane >> 5;
    unsigned char* ws = args.ws;
    const bf16* keysb = (const bf16*)(ws + WS_KEYS) + (size_t)L * 2 * NK * 128;
    const bf16* qp = (const bf16*)(ws + WS_A);
    int* eidx = (int*)(ws + WS_EIDX); float* gate = (float*)(ws + WS_GATE);
    constexpr int KROW = 272;
    for (int ch = tid; ch < 256 * 16; ch += NT) { const int r = ch >> 4, cc = ch & 15; *(LAS v4u*)(lds + r * KROW + cc * 16) = *(const GAS v4u*)(keysb + r * 128 + cc * 8); }
    __syncthreads();
    LAS unsigned* wl = (LAS unsigned*)(lds + 256 * KROW + wave * 4096) + c * 32;
    const int gw = MK_GW(wave), NGW = MK_NGW;
    const unsigned h4 = 4u * (unsigned)hi;
    for (int pass = gw; pass < T * PH / 32; pass += NGW) {
        const int row = pass * 32 + c;
        const bf16* qrow = qp + (size_t)row * 256 + hi * 8;
        unsigned top[2][16];
#pragma unroll
        for (int half = 0; half < 2; ++half) {
            bf16x8 bq[8];
#pragma unroll
            for (int ks = 0; ks < 8; ++ks) bq[ks] = *(const GAS bf16x8*)(qrow + half * 128 + ks * 16);
            f32x16 acc[4];
#pragma unroll
            for (int mt = 0; mt < 4; ++mt)
#pragma unroll
                for (int r = 0; r < 16; ++r) acc[mt][r] = 0.f;
#pragma unroll
            for (int ks = 0; ks < 8; ++ks)
#pragma unroll
                for (int mt = 0; mt < 4; ++mt) { const bf16x8 a = *(const LAS bf16x8*)(lds + (half * 128 + mt * 32 + c) * KROW + (ks * 16 + hi * 8) * 2);
                    acc[mt] = __builtin_amdgcn_mfma_f32_32x32x16_bf16(a, bq[ks], acc[mt], 0, 0, 0); }
            unsigned g[4][16];
#pragma unroll
            for (int mt = 0; mt < 4; ++mt)
#pragma unroll
                for (int r = 0; r < 16; ++r) { const unsigned code = (unsigned)(127 - mt * 32 - (r & 3) - 8 * (r >> 2)) - h4;
                    g[mt][r] = (f2sort(acc[mt][r]) & ~127u) | code; }
#pragma unroll
            for (int mt = 0; mt < 4; ++mt) sort16_desc(g[mt]);
            merge16_desc(g[0], g[1]); merge16_desc(g[2], g[3]); merge16_desc(g[0], g[2]);
            xmerge16_desc(g[0]);
#pragma unroll
            for (int i = 0; i < 16; ++i) top[half][i] = g[0][i];
        }
#pragma unroll
        for (int q = 0; q < 4; ++q) { v4u w;
            w.x = hi ? top[1][4 * q + 0] : top[0][4 * q + 0]; w.y = hi ? top[1][4 * q + 1] : top[0][4 * q + 1];
            w.z = hi ? top[1][4 * q + 2] : top[0][4 * q + 2]; w.w = hi ? top[1][4 * q + 3] : top[0][4 * q + 3];
            *(LAS v4u*)(wl + hi * 16 + 4 * q) = w; }
        float v1[16], v2[16];
#pragma unroll
        for (int i = 0; i < 16; ++i) { v1[i] = sort2f(top[0][i] & ~127u); v2[i] = sort2f(top[1][i] & ~127u); }
        unsigned cd[2][16];
#pragma unroll
        for (int i = 0; i < 16; ++i) { cd[0][i] = 0u; cd[1][i] = 0u; }
#define TKC(q, i0, j0, i1, j1) { const float sm = hi ? (v1[i1] + v2[j1]) : (v1[i0] + v2[j0]); const unsigned code = hi ? (unsigned)(255 - ((i1) * 16 + (j1))) : (unsigned)(255 - ((i0) * 16 + (j0))); \
            cd[(q) >> 4][(q) & 15] = (f2sort(sm) & ~255u) | code; }
        TK_CANDS
#undef TKC
        sort16_desc(cd[0]); sort16_desc(cd[1]); merge16_desc(cd[0], cd[1]); xmerge16_desc(cd[0]);
        float ev[16]; int ex[16]; float den = 0.f;
        const float vmax = sort2f(cd[0][0] & ~255u);
#pragma unroll
        for (int r = 0; r < 16; ++r) { const unsigned key = cd[0][r], pos = 255u - (key & 255u);
            const unsigned k1 = wl[pos >> 4], k2 = wl[16 + (pos & 15u)];
            ex[r] = (int)((127u - (k1 & 127u)) * 128u + (127u - (k2 & 127u)));
            ev[r] = __expf(sort2f(key & ~255u) - vmax); den += ev[r]; }
        const float inv = 1.0f / den;
        if (hi == 0) {
#pragma unroll
            for (int q = 0; q < 4; ++q) { v4u w; w.x = (unsigned)ex[4 * q]; w.y = (unsigned)ex[4 * q + 1]; w.z = (unsigned)ex[4 * q + 2]; w.w = (unsigned)ex[4 * q + 3]; *(GAS v4u*)(eidx + (size_t)row * 16 + 4 * q) = w; }
        } else {
#pragma unroll
            for (int q = 0; q < 4; ++q) { f32x4 w; w.x = ev[4 * q] * inv; w.y = ev[4 * q + 1] * inv; w.z = ev[4 * q + 2] * inv; w.w = ev[4 * q + 3] * inv; *(GAS f32x4*)(gate + (size_t)row * 16 + 4 * q) = w; }
        }
    }
}
}


namespace mk {
typedef short bf16x4v __attribute__((ext_vector_type(4)));
__device__ __forceinline__ unsigned cvt_pk_bf16(float lo, float hi) { unsigned r; asm volatile("v_cvt_pk_bf16_f32 %0, %1, %2" : "=v"(r) : "v"(lo), "v"(hi)); return r; }
__device__ __forceinline__ void head_prep(const bf16* src  , const float* g, int h, int pos, float scl, v4u (&outp)[4]) {
    float v[4][8]; float ss = 0.f;
#pragma unroll
    for (int ks = 0; ks < 4; ++ks) { const v4u w = *(const GAS v4u*)(src + ks * 16);
        const unsigned ww[4] = {w.x, w.y, w.z, w.w};
#pragma unroll
        for (int q = 0; q < 4; ++q) { v[ks][2 * q] = __builtin_bit_cast(float, ww[q] << 16); v[ks][2 * q + 1] = __builtin_bit_cast(float, ww[q] & 0xffff0000u); }
#pragma unroll
        for (int j = 0; j < 8; ++j) ss += v[ks][j] * v[ks][j]; }
    ss += __shfl_xor(ss, 32);
    const float r = scl / sqrtf(ss * (1.0f / 64.0f) + EPS);
#pragma unroll
    for (int ks = 0; ks < 4; ++ks) { const f32x4 g0 = *(const f32x4*)(g + ks * 16 + 8 * h), g1 = *(const f32x4*)(g + ks * 16 + 8 * h + 4);
        v[ks][0] *= r * g0.x; v[ks][1] *= r * g0.y; v[ks][2] *= r * g0.z; v[ks][3] *= r * g0.w; v[ks][4] *= r * g1.x; v[ks][5] *= r * g1.y; v[ks][6] *= r * g1.z; v[ks][7] *= r * g1.w; }
#pragma unroll
    for (int i = 0; i < 8; ++i) { const float other = __shfl_xor(v[0][i], 32);
        constexpr float INVF[8] = {1.0f, 0.1939227432012558f, 0.03760603070259094f, 0.007292664609849453f, 0.0014142135623842478f, 0.00027424818836152554f, 5.318296098266728e-05f, 1.0313386155758053e-05f};
        float rev = ((float)pos * INVF[i]) * 0.15915494309189535f; rev -= floorf(rev);
        const float sn = __builtin_amdgcn_sinf(rev), cs = __builtin_amdgcn_cosf(rev);
        v[0][i] = h ? (v[0][i] * cs + other * sn) : (v[0][i] * cs - other * sn); }
#pragma unroll
    for (int ks = 0; ks < 4; ++ks) { outp[ks].x = pk2(v[ks][0], v[ks][1]); outp[ks].y = pk2(v[ks][2], v[ks][3]); outp[ks].z = pk2(v[ks][4], v[ks][5]); outp[ks].w = pk2(v[ks][6], v[ks][7]); }
}

template <int L> __device__ __forceinline__ void ph_mixer(const Args& args, LAS unsigned char* lds) {
    const int tid = threadIdx.x, lane = tid & 63, wave = __builtin_amdgcn_readfirstlane(tid >> 6);
    const int c = lane & 31, hi = lane >> 5;
    unsigned char* ws = args.ws;
    const bf16* z = (const bf16*)(ws + WS_A); bf16* mix = (bf16*)(ws + WS_MIX);
    const int* positions = (const int*)args.in[2];
    const float* qg = args.in[8] + L * 64; const float* kg = args.in[9] + L * 64; const float* sink = args.in[10] + L * NQH;
    const float* conv_w = args.in[11] + L * 3 * 256; const float* pool_w = args.in[12] + (size_t)L * 4 * 64 * 64; const float* pool_scale = args.in[13] + L * 256;
    constexpr int KROW = 144, VROW = 776, K_OFF = 0, V_OFF = 384 * KROW, P_OFF = V_OFF + 64 * VROW, PROW = 68;
    constexpr int NQB = S / 128;
    for (int unit = blockIdx.x; unit < B * NKVH * NQB; unit += gridDim.x) {
        const int qb = unit % NQB, kvh = (unit / NQB) % NKVH, b = unit / (NQB * NKVH);
        const int tok0 = b * S, kbase = qb * 128 - 128;
        __syncthreads();
        for (int pass = wave; pass < 12; pass += NWAVES) { const int kr = pass * 32 + c, kp = kbase + kr;
            if (kp >= 0 && kp < S) {
                v4u o[4]; head_prep(z + (size_t)(tok0 + kp) * INW + OK_ + kvh * 64 + 8 * hi, kg, hi, positions[tok0 + kp], 1.0f, o);
#pragma unroll
                for (int ks = 0; ks < 4; ++ks) *(LAS v4u*)(lds + K_OFF + kr * KROW + (ks * 16 + 8 * hi) * 2) = o[ks]; } }
        for (int ch = tid; ch < 384 * 8; ch += NT) { const int kr = ch >> 3, dc = ch & 7, kp = kbase + kr;
            if (kp >= 0 && kp < S) { const v4u w = *(const GAS v4u*)(z + (size_t)(tok0 + kp) * INW + OV + kvh * 64 + dc * 8);
                const unsigned ww[4] = {w.x, w.y, w.z, w.w};
#pragma unroll
                for (int q = 0; q < 4; ++q) { *(LAS unsigned short*)(lds + V_OFF + (dc * 8 + 2 * q) * VROW + kr * 2) = (unsigned short)(ww[q] & 0xffffu);
                                              *(LAS unsigned short*)(lds + V_OFF + (dc * 8 + 2 * q + 1) * VROW + kr * 2) = (unsigned short)(ww[q] >> 16); } } }
        __syncthreads();
        {
            const int g = wave >> 1, qh = wave & 1, hq = kvh * GRP + g;
            const float sk = sink[hq];
#pragma unroll 1
            for (int qt = 0; qt < 2; ++qt) {
                const int a = qb * 128 + qh * 64 + qt * 32;
                const int tq = tok0 + a + c;
                v4u qf[4]; head_prep(z + (size_t)tq * INW + OQ + hq * 64 + 8 * hi, qg, hi, positions[tq], 0.125f, qf);
                bf16x8 bq[4];
#pragma unroll
                for (int ks = 0; ks < 4; ++ks) bq[ks] = __builtin_bit_cast(bf16x8, qf[ks]);
                float m = sk, lsum = hi ? 0.f : 1.f;
                f32x16 O0, O1;
#pragma unroll
                for (int r = 0; r < 16; ++r) { O0[r] = 0.f; O1[r] = 0.f; }
#pragma unroll 1
                for (int kt = 0; kt < 9; ++kt) {
                    const int kp0 = a - 128 + 32 * kt;
                    if (kp0 < 0 || kp0 >= S) continue;
                    const int kr0 = kp0 - kbase;
                    f32x16 sa;
#pragma unroll
                    for (int r = 0; r < 16; ++r) sa[r] = 0.f;
#pragma unroll
                    for (int ks = 0; ks < 4; ++ks) { const bf16x8 ka = *(const LAS bf16x8*)(lds + K_OFF + (kr0 + c) * KROW + (ks * 16 + 8 * hi) * 2);
                        sa = __builtin_amdgcn_mfma_f32_32x32x16_bf16(ka, bq[ks], sa, 0, 0, 0); }
                    if (kt == 0) {
#pragma unroll
                        for (int r = 0; r < 16; ++r) { const int i = (r & 3) + 8 * (r >> 2) + 4 * hi; if (i < c) sa[r] = -1e30f; }
                    } else if (kt == 8) {
#pragma unroll
                        for (int r = 0; r < 16; ++r) { const int i = (r & 3) + 8 * (r >> 2) + 4 * hi; if (i > c) sa[r] = -1e30f; }
                    }
                    float mx = sa[0];
#pragma unroll
                    for (int r = 1; r < 16; ++r) mx = fmaxf(mx, sa[r]);
                    mx = fmaxf(mx, __shfl_xor(mx, 32));
                    const float mn = fmaxf(m, mx), al = __expf(m - mn);
                    m = mn;
                    float p[16]; float rs = 0.f;
#pragma unroll
                    for (int r = 0; r < 16; ++r) { p[r] = __expf(sa[r] - mn); rs += p[r]; }
                    lsum = lsum * al + rs;
#pragma unroll
                    for (int r = 0; r < 16; ++r) { O0[r] *= al; O1[r] *= al; }
#pragma unroll
                    for (int s2 = 0; s2 < 2; ++s2) {
                        v4u pw; pw.x = cvt_pk_bf16(p[8 * s2 + 0], p[8 * s2 + 1]); pw.y = cvt_pk_bf16(p[8 * s2 + 2], p[8 * s2 + 3]); pw.z = cvt_pk_bf16(p[8 * s2 + 4], p[8 * s2 + 5]); pw.w = cvt_pk_bf16(p[8 * s2 + 6], p[8 * s2 + 7]);
                        const bf16x8 pb = __builtin_bit_cast(bf16x8, pw);
#pragma unroll
                        for (int mt = 0; mt < 2; ++mt) { const LAS unsigned char* vp = lds + V_OFF + (mt * 32 + c) * VROW + (kr0 + 16 * s2 + 4 * hi) * 2;
                            const v2u lo2 = *(const LAS v2u*)vp, hi2 = *(const LAS v2u*)(vp + 16);
                            v4u va; va.x = lo2.x; va.y = lo2.y; va.z = hi2.x; va.w = hi2.y;
                            if (mt == 0) O0 = __builtin_amdgcn_mfma_f32_32x32x16_bf16(__builtin_bit_cast(bf16x8, va), pb, O0, 0, 0, 0);
                            else         O1 = __builtin_amdgcn_mfma_f32_32x32x16_bf16(__builtin_bit_cast(bf16x8, va), pb, O1, 0, 0, 0); }
                    }
                }
                const float inv = 1.0f / (lsum + __shfl_xor(lsum, 32));
                bf16* orow = mix + (size_t)tq * D + hq * 64 + 4 * hi;
#pragma unroll
                for (int q = 0; q < 4; ++q) { v2u w0, w1;
                    w0.x = pk2(O0[4 * q] * inv, O0[4 * q + 1] * inv); w0.y = pk2(O0[4 * q + 2] * inv, O0[4 * q + 3] * inv);
                    w1.x = pk2(O1[4 * q] * inv, O1[4 * q + 1] * inv); w1.y = pk2(O1[4 * q + 2] * inv, O1[4 * q + 3] * inv);
                    *(GAS v2u*)(orow + 8 * q) = w0; *(GAS v2u*)(orow + 32 + 8 * q) = w1; }
            }
        }
        if (kvh == 0) {
            const int cp = tid & 127, tg = tid >> 7;
            const float w0a = conv_w[2 * cp], w0b = conv_w[2 * cp + 1], w1a = conv_w[256 + 2 * cp], w1b = conv_w[256 + 2 * cp + 1], w2a = conv_w[512 + 2 * cp], w2b = conv_w[512 + 2 * cp + 1];
            const int s0 = qb * 128 + tg * 32;
            float upa = 0.f, upb = 0.f, uca, ucb;
            { const bf16* zr = z + (size_t)(tok0 + s0) * INW;
              const unsigned cx = *(const GAS unsigned*)(zr + OCX + 2 * cp), cc = *(const GAS unsigned*)(zr + OCC + 2 * cp);
              uca = bf2f((unsigned short)(cx & 0xffffu)) * bf2f((unsigned short)(cc & 0xffffu)); ucb = bf2f((unsigned short)(cx >> 16)) * bf2f((unsigned short)(cc >> 16));
              if (s0 > 0) { const bf16* zp = zr - INW; const unsigned px = *(const GAS unsigned*)(zp + OCX + 2 * cp), pc = *(const GAS unsigned*)(zp + OCC + 2 * cp);
                  upa = bf2f((unsigned short)(px & 0xffffu)) * bf2f((unsigned short)(pc & 0xffffu)); upb = bf2f((unsigned short)(px >> 16)) * bf2f((unsigned short)(pc >> 16)); } }
            for (int i = 0; i < 32; ++i) { const int s = s0 + i; const bf16* zr = z + (size_t)(tok0 + s) * INW;
                float una = 0.f, unb = 0.f;
                if (s + 1 < S) { const unsigned nx = *(const GAS unsigned*)(zr + INW + OCX + 2 * cp), nc = *(const GAS unsigned*)(zr + INW + OCC + 2 * cp);
                    una = bf2f((unsigned short)(nx & 0xffffu)) * bf2f((unsigned short)(nc & 0xffffu)); unb = bf2f((unsigned short)(nx >> 16)) * bf2f((unsigned short)(nc >> 16)); }
                const unsigned cb = *(const GAS unsigned*)(zr + OCB + 2 * cp);
                const float oa = bf2f((unsigned short)(cb & 0xffffu)) * (w0a * upa + w1a * uca + w2a * una), ob = bf2f((unsigned short)(cb >> 16)) * (w0b * upb + w1b * ucb + w2b * unb);
                *(GAS unsigned*)(mix + (size_t)(tok0 + s) * D + 512 + 2 * cp) = pk2(oa, ob);
                upa = uca; upb = ucb; uca = una; ucb = unb; }
        }
#pragma unroll 1
        for (int gi = 0; gi < 2; ++gi) {
            const int gq = kvh * 2 + gi, half = 1 << gq;
            __syncthreads();
            { const int tt = tid >> 2, cq = tid & 3, s = qb * 128 + tt;
              int lo = s - half, hi2 = s + half; lo = lo < 0 ? 0 : lo; hi2 = hi2 > S ? S : hi2;
              float acc[16];
#pragma unroll
              for (int j = 0; j < 16; ++j) acc[j] = 0.f;
              for (int ss = lo; ss < hi2; ++ss) { const bf16* zp = z + (size_t)(tok0 + ss) * INW + OPX + gq * 64 + cq * 16;
                  const v4u w0 = *(const GAS v4u*)zp, w1 = *(const GAS v4u*)(zp + 8); const unsigned ww[8] = {w0.x, w0.y, w0.z, w0.w, w1.x, w1.y, w1.z, w1.w};
#pragma unroll
                  for (int q = 0; q < 8; ++q) { acc[2 * q] += __builtin_bit_cast(float, ww[q] << 16); acc[2 * q + 1] += __builtin_bit_cast(float, ww[q] & 0xffff0000u); } }
              const float icnt = 1.0f / (float)(hi2 - lo);
              const bf16* zc = z + (size_t)(tok0 + s) * INW + OPX + gq * 64 + cq * 16;
              const v4u w0 = *(const GAS v4u*)zc, w1 = *(const GAS v4u*)(zc + 8); const unsigned ww[8] = {w0.x, w0.y, w0.z, w0.w, w1.x, w1.y, w1.z, w1.w};
              LAS float* pr = (LAS float*)(lds + P_OFF) + tt * PROW + cq * 16;
#pragma unroll
              for (int q = 0; q < 8; ++q) { pr[2 * q] = acc[2 * q] * icnt - __builtin_bit_cast(float, ww[q] << 16); pr[2 * q + 1] = acc[2 * q + 1] * icnt - __builtin_bit_cast(float, ww[q] & 0xffff0000u); } }
            __syncthreads();
            { const int e = tid & 63, tq8 = tid >> 6;
              float acc[16];
#pragma unroll
              for (int j = 0; j < 16; ++j) acc[j] = 0.f;
              const float* pw = pool_w + (size_t)gq * 64 * 64 + e;
              for (int c4 = 0; c4 < 16; ++c4) { const float wa = pw[(4 * c4) * 64], wb = pw[(4 * c4 + 1) * 64], wc = pw[(4 * c4 + 2) * 64], wd = pw[(4 * c4 + 3) * 64];
#pragma unroll
                  for (int tt = 0; tt < 16; ++tt) { const f32x4 pv = *(const LAS f32x4*)((LAS float*)(lds + P_OFF) + (tq8 * 16 + tt) * PROW + 4 * c4);
                      acc[tt] += pv.x * wa + pv.y * wb + pv.z * wc + pv.w * wd; } }
              const float sc = pool_scale[gq * 64 + e];
#pragma unroll
              for (int tt = 0; tt < 16; ++tt) mix[(size_t)(tok0 + qb * 128 + tq8 * 16 + tt) * D + 768 + gq * 64 + e] = (bf16)f2bf(acc[tt] * sc); }
        }
    }
}
}


namespace mk {
typedef __bf16 bf16x2_t __attribute__((ext_vector_type(2)));
__device__ __forceinline__ float dot2bf(unsigned a, unsigned b, float c) { return __builtin_amdgcn_fdot2_f32_bf16(__builtin_bit_cast(bf16x2_t, a), __builtin_bit_cast(bf16x2_t, b), c, false); }
__device__ __forceinline__ float gelu_erf(float x) { return 0.5f * x * (1.0f + erff(x * 0.70710678118654752f)); }

template <int L> __device__ __forceinline__ void ph_peer(const Args& args) {
    const int lane = threadIdx.x & 63, wave = __builtin_amdgcn_readfirstlane(threadIdx.x >> 6);
    unsigned char* ws = args.ws;
    const bf16* Ub = (const bf16*)(ws + WS_U) + (size_t)L * NE * D; const bf16* Vb = (const bf16*)(ws + WS_V) + (size_t)L * NE * D;
    const bf16* Hb = (const bf16*)(ws + WS_H); const float* X1 = (const float*)(ws + WS_X1);
    const int* eidx = (const int*)(ws + WS_EIDX); const float* gate = (const float*)(ws + WS_GATE);
    const float* mod = (const float*)(ws + WS_MOD);
    float* outp = args.out;
    const int b5 = (lane >> 5) & 1, b4 = (lane >> 4) & 1, b3 = (lane >> 3) & 1, jl = 4 * b5 + 2 * b4 + b3;
    const int gw = MK_GW(wave), NGW = MK_NGW;
#pragma unroll 1
    for (int t = gw; t < T; t += NGW) {
        const v4u h0 = *(const GAS v4u*)(Hb + (size_t)t * D + 8 * lane), h1 = *(const GAS v4u*)(Hb + (size_t)t * D + 512 + 8 * lane);
        const unsigned hw[8] = {h0.x, h0.y, h0.z, h0.w, h1.x, h1.y, h1.z, h1.w};
        const int e0 = eidx[(size_t)t * 128 + lane], e1 = eidx[(size_t)t * 128 + 64 + lane];
        const float g0 = gate[(size_t)t * 128 + lane], g1 = gate[(size_t)t * 128 + 64 + lane];
        float y[16];
#pragma unroll
        for (int i = 0; i < 16; ++i) y[i] = 0.f;
#pragma unroll 1
        for (int bt = 0; bt < 16; ++bt) {
            const int ev = (bt < 8) ? e0 : e1; const float gv = (bt < 8) ? g0 : g1; const int lbase = (bt & 7) * 8;
            v4u ua[8][2], va[8][2];
#pragma unroll
            for (int j = 0; j < 8; ++j) { const int ek = __builtin_amdgcn_readlane(ev, lbase + j);
                const bf16* ur = Ub + (size_t)ek * D + 8 * lane; const bf16* vr = Vb + (size_t)ek * D + 8 * lane;
                ua[j][0] = *(const GAS v4u*)ur; ua[j][1] = *(const GAS v4u*)(ur + 512);
                va[j][0] = *(const GAS v4u*)vr; va[j][1] = *(const GAS v4u*)(vr + 512); }
            float p[8];
#pragma unroll
            for (int j = 0; j < 8; ++j) { float s = 0.f;
                s = dot2bf(ua[j][0].x, hw[0], s); s = dot2bf(ua[j][0].y, hw[1], s); s = dot2bf(ua[j][0].z, hw[2], s); s = dot2bf(ua[j][0].w, hw[3], s);
                s = dot2bf(ua[j][1].x, hw[4], s); s = dot2bf(ua[j][1].y, hw[5], s); s = dot2bf(ua[j][1].z, hw[6], s); s = dot2bf(ua[j][1].w, hw[7], s);
                p[j] = s; }
            float q[4], r2[2], sd;
#pragma unroll
            for (int i = 0; i < 4; ++i) { const float snd = b5 ? p[i] : p[i + 4]; const float rcv = __shfl_xor(snd, 32); q[i] = (b5 ? p[i + 4] : p[i]) + rcv; }
#pragma unroll
            for (int i = 0; i < 2; ++i) { const float snd = b4 ? q[i] : q[i + 2]; const float rcv = __shfl_xor(snd, 16); r2[i] = (b4 ? q[i + 2] : q[i]) + rcv; }
            { const float snd = b3 ? r2[0] : r2[1]; const float rcv = __shfl_xor(snd, 8); sd = (b3 ? r2[1] : r2[0]) + rcv; }
            sd += __shfl_xor(sd, 4); sd += __shfl_xor(sd, 2); sd += __shfl_xor(sd, 1);
            const float gk = __shfl(gv, lbase + jl);
            const float w = gk * gelu_erf(sd);
#pragma unroll
            for (int j = 0; j < 8; ++j) { const float wj = __builtin_bit_cast(float, __builtin_amdgcn_readlane(__builtin_bit_cast(int, w), 32 * (j >> 2) + 16 * ((j >> 1) & 1) + 8 * (j & 1)));
                const unsigned vw[8] = {va[j][0].x, va[j][0].y, va[j][0].z, va[j][0].w, va[j][1].x, va[j][1].y, va[j][1].z, va[j][1].w};
#pragma unroll
                for (int qd = 0; qd < 8; ++qd) { y[2 * qd] += wj * __builtin_bit_cast(float, vw[qd] << 16); y[2 * qd + 1] += wj * __builtin_bit_cast(float, vw[qd] & 0xffff0000u); } }
        }
        const float* g2 = mod + ((size_t)L * B + t / S) * 6 * D + 5 * D;
        float xo[16]; float ssq = 0.f;
#pragma unroll
        for (int pc = 0; pc < 2; ++pc)
#pragma unroll
            for (int hf = 0; hf < 2; ++hf) { const int col = pc * 512 + 8 * lane + 4 * hf;
                const f32x4 xv = *(const GAS f32x4*)(X1 + (size_t)t * D + col), gg = *(const f32x4*)(g2 + col);
                f32x4 o; o.x = xv.x + gg.x * y[pc * 8 + hf * 4 + 0]; o.y = xv.y + gg.y * y[pc * 8 + hf * 4 + 1]; o.z = xv.z + gg.z * y[pc * 8 + hf * 4 + 2]; o.w = xv.w + gg.w * y[pc * 8 + hf * 4 + 3];
                *(GAS f32x4*)(outp + (size_t)t * D + col) = o;
                xo[pc * 8 + hf * 4 + 0] = o.x; xo[pc * 8 + hf * 4 + 1] = o.y; xo[pc * 8 + hf * 4 + 2] = o.z; xo[pc * 8 + hf * 4 + 3] = o.w;
                ssq += (o.x * o.x + o.y * o.y) + (o.z * o.z + o.w * o.w); }
        if (L + 1 < DEPTH) {
            const float rstd = 1.0f / sqrtf(wave_sum(ssq) * (1.f / D) + EPS);
            const float* g = args.in[3] + (L + 1) * D; const float* mb = mod + ((size_t)(L + 1) * B + t / S) * 6 * D;
#pragma unroll
            for (int pc = 0; pc < 2; ++pc) { const int col = pc * 512 + 8 * lane; float hv[8];
#pragma unroll
                for (int hf = 0; hf < 2; ++hf) { const f32x4 gg = *(const f32x4*)(g + col + 4 * hf), sh = *(const f32x4*)(mb + col + 4 * hf), sc = *(const f32x4*)(mb + D + col + 4 * hf);
                    hv[4 * hf + 0] = xo[pc * 8 + 4 * hf + 0] * rstd * gg.x * (1.0f + sc.x) + sh.x; hv[4 * hf + 1] = xo[pc * 8 + 4 * hf + 1] * rstd * gg.y * (1.0f + sc.y) + sh.y;
                    hv[4 * hf + 2] = xo[pc * 8 + 4 * hf + 2] * rstd * gg.z * (1.0f + sc.z) + sh.z; hv[4 * hf + 3] = xo[pc * 8 + 4 * hf + 3] * rstd * gg.w * (1.0f + sc.w) + sh.w; }
                v4u o; o.x = pk2(hv[0], hv[1]); o.y = pk2(hv[2], hv[3]); o.z = pk2(hv[4], hv[5]); o.w = pk2(hv[6], hv[7]);
                *(GAS v4u*)((bf16*)(ws + WS_H) + (size_t)t * D + col) = o; }
        }
    }
}
}


namespace mk {
template <int L> __device__ __forceinline__ void layer_phases(const Args& args, LAS unsigned char* lds) {
    const int lo = args.ph_lo, hi = args.ph_hi;
#define IN(k) (lo <= (k) && (k) < hi)
    constexpr int pb = PH_L0 + L * PH_PER_LAYER;
    if (IN(pb + PH_G1)) ph_g1<L>(args, lds);
    if (IN(pb + PH_AT)) ph_mixer<L>(args, lds);
    if (IN(pb + PH_G2)) ph_g2<L>(args, lds);
    if (IN(pb + PH_N2)) ph_hmod<L, 1>(args);
    if (IN(pb + PH_G3)) ph_g3<L>(args, lds);
    if (IN(pb + PH_TK)) ph_topk<L>(args, lds);
    if (IN(pb + PH_PE)) ph_peer<L>(args);
#undef IN
}

__global__ void __launch_bounds__(NT, 2) mk_fwd(Args args) {
    extern __shared__ __attribute__((aligned(16))) unsigned char lds_raw[];
    LAS unsigned char* lds = (LAS unsigned char*)lds_raw;
    const int lo = args.ph_lo, hi = args.ph_hi;
#define IN(k) (lo <= (k) && (k) < hi)
    if (IN(PH_PRO)) ph_prologue(args, lds);
    if (IN(PH_H0)) ph_hmod<0, 0>(args);
    layer_phases<0>(args, lds);
    if (IN(PH_H1)) ph_hmod<1, 0>(args);
    layer_phases<1>(args, lds);
#undef IN
}
}


__global__ void k_cvt_bf16(const float* src, unsigned short* dst, size_t n) {
    const size_t i = (size_t)blockIdx.x * 256 + threadIdx.x;
    if (i < n) dst[i] = (unsigned short)mk::f2bf(src[i]);
}
__global__ void k_peer_u_b16(const unsigned short* h2, const float* u_l, const int* eidx, const float* gate, float* wact) {
    const int i = blockIdx.x * 4 + (threadIdx.x >> 6), lane = threadIdx.x & 63;
    if (i >= T * 128) return;
    const int t = i >> 7;
    const float* ur = u_l + (size_t)eidx[i] * D; const unsigned short* hr = h2 + (size_t)t * D;
    float s = 0.f;
    for (int k = lane; k < D; k += 64) s += mk::bf2f(hr[k]) * ur[k];
    for (int o = 32; o; o >>= 1) s += __shfl_xor(s, o);
    if (lane == 0) wact[i] = gate[i] * gelu_f(s);
}

extern "C" void kernel_launch(void* const* d_in, const int* in_sizes, int n_in, void* d_out, int out_size, void* d_ws, size_t ws_size, hipStream_t stream) {
    using namespace mk;
    static int grid = 0;
    if (grid == 0) {
        if (n_in != 19 || ws_size < WS_TEND) { fprintf(stderr, "kernel_launch: bad n_in %d or ws_size %zu\n", n_in, ws_size); grid = -1; return; }
        int dev = 0, cus = 0, per_cu = 0;
        hipGetDevice(&dev); hipDeviceGetAttribute(&cus, hipDeviceAttributeMultiprocessorCount, dev);
        if (hipFuncSetAttribute((const void*)mk_fwd, hipFuncAttributeMaxDynamicSharedMemorySize, LDS_BYTES) != hipSuccess) { fprintf(stderr, "hipFuncSetAttribute failed\n"); grid = -1; return; }
        hipOccupancyMaxActiveBlocksPerMultiprocessor(&per_cu, (const void*)mk_fwd, NT, LDS_BYTES);
        (void)hipGetLastError();
        grid = (per_cu >= 1) ? cus : -1;
        if (grid != 256) fprintf(stderr, "kernel_launch: grid %d (per_cu %d)\n", grid, per_cu);
    }
    if (grid < 0) return;
    const float* positions_f = (const float*)d_in[2]; const int* positions = (const int*)positions_f;
    const float* q_norm_g = (const float*)d_in[8]; const float* k_norm_g = (const float*)d_in[9]; const float* attn_sink = (const float*)d_in[10];
    const float* conv_w = (const float*)d_in[11]; const float* pool_w = (const float*)d_in[12]; const float* pool_scale = (const float*)d_in[13];
    const float* peer_keys = (const float*)d_in[16]; const float* peer_u = (const float*)d_in[17]; const float* peer_v = (const float*)d_in[18];
    float* out = (float*)d_out; unsigned char* ws = (unsigned char*)d_ws;
    hipMemsetAsync(ws + WS_CTL, 0, CTL_ZERO_BYTES, stream);
    Args a{};
    for (int i = 0; i < 19; ++i) a.in[i] = (const float*)d_in[i];
    a.out = out; a.ws = ws;
    auto run = [&](int lo, int hi) { a.ph_lo = lo; a.ph_hi = hi; hipLaunchKernelGGL(mk_fwd, dim3(grid), dim3(NT), LDS_BYTES, stream, a); };
    float* mod = (float*)(ws + WS_MOD); unsigned short* Hb = (unsigned short*)(ws + WS_H); float* X1 = (float*)(ws + WS_X1);
    int* eidx = (int*)(ws + WS_EIDX); float* gate = (float*)(ws + WS_GATE); unsigned short* MIXb = (unsigned short*)(ws + WS_MIX);
    float* z = (float*)(ws + WS_T1); float* qp = (float*)(ws + WS_T1);
    float* selv = (float*)(ws + WS_T1); int* seli = (int*)(ws + WS_T1 + 16 * MiB); float* wact = (float*)(ws + WS_T1 + 32 * MiB);
    float* qn = (float*)(ws + WS_T2); float* kn = qn + (size_t)T * 512; float* pooled = kn + (size_t)T * 128; float* mixin = pooled + (size_t)T * 256;
    float* sc = (float*)(ws + WS_T2);
    run(PH_PRO, PH_PRO + 1);
    run(PH_H0, PH_H0 + 1);
    for (int l = 0; l < DEPTH; ++l) {
        const float* mod_l = mod + (size_t)l * B * 6 * D; const int pb = PH_L0 + l * PH_PER_LAYER;
        run(pb + PH_G1, pb + PH_G1 + 1);
        run(pb + PH_AT, pb + PH_AT + 1);
        run(pb + PH_G2, pb + PH_G2 + 1);
        run(pb + PH_N2, pb + PH_N2 + 1);
        run(pb + PH_G3, pb + PH_G3 + 1);
        run(pb + PH_TK, pb + PH_TK + 1);
        run(pb + PH_PE, pb + PH_PE + 1);
    }
}
#endif
```

```cpp
#include <hip/hip_runtime.h>
#include <stdint.h>
#include <math.h>
#include <cstdio>

#ifndef BATCH
#define BATCH 8
#endif
#ifndef SEQ
#define SEQ 2048
#endif
#ifndef MK_SPLIT
#define MK_SPLIT 0
#endif
#define Z_F32 0
#define QP_F32 0
#define DO_UV 1

namespace cfg {
constexpr int B = BATCH, S = SEQ, T = B * S, D = 1024, DEPTH = 2;
constexpr int HDIM = 64, NQH = 8, NKVH = 2, GRP = 4, WIN = 128;
constexpr int INW = 1792, OQ = 0, OK_ = 512, OV = 640, OCX = 768, OCB = 1024, OCC = 1280, OPX = 1536;
constexpr int PH = 8, NK = 128, NE = 16384, QD = 256, TOPK = 16, PW = 2048;
constexpr float EPS = 1e-6f;
}
using namespace cfg;

namespace pg8 {
#define PG8_LAS __attribute__((address_space(3)))
typedef unsigned short bf16_t;
typedef short bf16x8 __attribute__((ext_vector_type(8)));
typedef float f32x4 __attribute__((ext_vector_type(4)));
typedef unsigned u32x4 __attribute__((ext_vector_type(4)));
constexpr int BM = 256, BK = 64, HALF = 128, HTB = HALF * BK * 2  , STAGE_BYTES = 8 * HTB, NXCD = 8, WGM = 8;

__host__ __device__ __forceinline__ int lds_byte(int r, int c) { const int st = (r >> 4) * 2 + (c >> 5), rr = r & 15, cc = c & 31, ob = rr * 64 + cc * 2; return st * 1024 + (ob ^ (((ob >> 9) & 1) << 5)); }
__host__ __device__ __forceinline__ void stage_rc(int b, int& R, int& C) { const int st = b / 1024, sb = b % 1024, swz = sb ^ (((sb >> 9) & 1) << 5); R = (st >> 1) * 16 + swz / 64; C = (st & 1) * 32 + (swz % 64) / 2; }
__host__ __device__ __forceinline__ int perm32(int rho) { const int n = rho >> 4, i = rho & 15; return 8 * (i >> 2) + 4 * n + (i & 3); }

struct Unit { int pm, pn; };
struct Gemm { const bf16_t* A; const bf16_t* Bt; int M, N, K; };

struct StaticOrder {
    int nM, nN, nwg, G, c;
    __host__ __device__ void init(int M, int N, int G_, int c_) { nM = M / BM; nN = N / BM; nwg = nM * nN; G = G_; c = c_; }
    __host__ __device__ bool next(int i, Unit& u) const {
        const long L = (long)i * G + c; if (L >= nwg) return false;
        int wgid = (int)L; { const int q = nwg / NXCD, r = nwg % NXCD, xcd = wgid % NXCD, off = wgid / NXCD; wgid = (xcd < r ? xcd * (q + 1) : r * (q + 1) + (xcd - r) * q) + off; }
        const int nig = WGM * nN, gid = wgid / nig, fm = gid * WGM, gsz = (nM - fm) < WGM ? (nM - fm) : WGM;
        u.pm = fm + ((wgid % nig) % gsz); u.pn = (wgid % nig) / gsz; return true;
    }
    __device__ __forceinline__ void a_ready(const Unit&) const {}
    __device__ __forceinline__ void done(const Unit&) const {}
};

__device__ __forceinline__ unsigned cvt_pk_bf16(float lo, float hi) { unsigned r; asm volatile("v_cvt_pk_bf16_f32 %0, %1, %2" : "=v"(r) : "v"(lo), "v"(hi)); return r; }
typedef float f32x2 __attribute__((ext_vector_type(2)));
__device__ __forceinline__ f32x2 gelu_pk(f32x2 v) {
    const f32x2 av = __builtin_elementwise_abs(v), d = av * 0.2316418882f + 1.0f;
    f32x2 t; t.x = __builtin_amdgcn_rcpf(d.x); t.y = __builtin_amdgcn_rcpf(d.y);
    f32x2 q = t * 0.5307027145f + (-0.7265760135f); q = q * t + 0.7107068705f; q = q * t + (-0.142248368f); q = q * t + 0.127414796f; q = q * t;
    const f32x2 s = (v * v) * (-0.72134752044f);
    f32x2 e; e.x = __builtin_amdgcn_exp2f(s.x); e.y = __builtin_amdgcn_exp2f(s.y);
    const f32x2 m = v * (q * e), r = v - m;
    f32x2 o; o.x = v.x < 0.f ? m.x : r.x; o.y = v.y < 0.f ? m.y : r.y; return o;
}

template <int ACT  > struct EpiBf16 {
    static constexpr bool PERM = true, AFTER_DRAIN = false; static_assert(ACT == 0 || ACT == 1, "EpiBf16: ACT is 0 (none) or 1 (gelu_pk)");
    bf16_t* O; int ldc; const float* bias; int split_cols; size_t split_stride; float scale0;
    __device__ __forceinline__ void operator()(const f32x4 (&acc)[2][2][4][2], const Unit& u, int wr, int wc, int fr, int fq) const {
        const int row0 = u.pm * BM + wr * 64 + fr; int colt = u.pn * BM; bf16_t* base = O;
        float sc = 1.f; if (split_cols) { const int t = colt / split_cols; base += (size_t)t * split_stride; colt -= t * split_cols; if (t == 0) sc = scale0; }
        const int col0 = colt + wc * 32 + 8 * fq, bcol0 = u.pn * BM + wc * 32 + 8 * fq;
        f32x4 bv[2][2];
#pragma unroll
        for (int bj = 0; bj < 2; ++bj)
#pragma unroll
            for (int n = 0; n < 2; ++n) bv[bj][n] = bias ? *(const f32x4*)(bias + bcol0 + bj * HALF + 4 * n) : (f32x4){0.f, 0.f, 0.f, 0.f};
#pragma unroll
        for (int ai = 0; ai < 2; ++ai)
#pragma unroll
            for (int m = 0; m < 4; ++m) { bf16_t* rowp = base + (size_t)(row0 + ai * HALF + m * 16) * ldc + col0;
#pragma unroll
                for (int bj = 0; bj < 2; ++bj) { f32x4 v0 = acc[ai][bj][m][0] + bv[bj][0], v1 = acc[ai][bj][m][1] + bv[bj][1];
                    if (ACT == 1) { f32x2 a = gelu_pk((f32x2){v0[0], v0[1]}), b = gelu_pk((f32x2){v0[2], v0[3]}), c = gelu_pk((f32x2){v1[0], v1[1]}), d = gelu_pk((f32x2){v1[2], v1[3]});
                        v0 = (f32x4){a.x, a.y, b.x, b.y}; v1 = (f32x4){c.x, c.y, d.x, d.y}; }
                    v0 = v0 * sc; v1 = v1 * sc; u32x4 w; w.x = cvt_pk_bf16(v0[0], v0[1]); w.y = cvt_pk_bf16(v0[2], v0[3]); w.z = cvt_pk_bf16(v1[0], v1[1]); w.w = cvt_pk_bf16(v1[2], v1[3]);
                    *(u32x4*)(rowp + bj * HALF) = w; } }
    }
};

template <class Epi, class Sched, bool ALIGN_EPI = false, bool SP2 = false>
__device__ __forceinline__ void gemm_phase(PG8_LAS unsigned char* lds, const Gemm g, const Sched& S, const Epi& E) {
    const int tid = threadIdx.x, wid = __builtin_amdgcn_readfirstlane(tid >> 6), lane = tid & 63, wr = wid >> 2, wc = wid & 3, fr = lane & 15, fq = lane >> 4;
    const int K = g.K, nt = K / BK;
    unsigned voffA[2], voffB[2];
#pragma unroll
    for (int i = 0; i < 2; ++i) { int R, C; stage_rc(tid * 16 + i * 8192, R, C); const int Rb = Epi::PERM ? ((R & ~31) + perm32(R & 31)) : R;
        voffA[i] = (unsigned)(R * K + C) * 2u; voffB[i] = (unsigned)(Rb * K + C) * 2u; }
    const size_t kstep = (size_t)(BK * 2);
    const size_t hstep = (size_t)HALF * K * 2;
    const size_t tstep = 2 * hstep;
    const unsigned ldsw = (unsigned)wid * 1024u;
    const int aoff = lds_byte(wr * 64 + fr, fq * 8), boff = lds_byte(wc * 32 + fr, fq * 8);
#define PG8_SA(b, h) (((b) * 2 + (h)) * HTB)
#define PG8_SB(b, h) ((4 + (b) * 2 + (h)) * HTB)
#define PG8_STAGE(bufoff, gbase, voff) do { _Pragma("unroll") for (int _i = 0; _i < 2; ++_i) \
        __builtin_amdgcn_global_load_lds((const unsigned*)((const char*)(gbase) + (voff)[_i]), (PG8_LAS unsigned*)(lds + (bufoff) + ldsw + _i * 8192), 16, 0, 0); } while (0)
#define PG8_LDA(dst, b, h) do { _Pragma("unroll") for (int m = 0; m < 4; ++m) _Pragma("unroll") for (int k = 0; k < 2; ++k) dst[m][k] = *(const PG8_LAS bf16x8*)(lds + PG8_SA(b, h) + aoff + m * 2048 + k * 1024); } while (0)
#define PG8_LDB(dst, b, h) do { _Pragma("unroll") for (int n = 0; n < 2; ++n) _Pragma("unroll") for (int k = 0; k < 2; ++k) dst[n][k] = *(const PG8_LAS bf16x8*)(lds + PG8_SB(b, h) + boff + n * 2048 + k * 1024); } while (0)
#define PG8_MMA(ai, bj, At, Bt) do { __builtin_amdgcn_s_setprio(1); _Pragma("unroll") for (int m = 0; m < 4; ++m) _Pragma("unroll") for (int n = 0; n < 2; ++n) _Pragma("unroll") for (int k = 0; k < 2; ++k) \
        acc[ai][bj][m][n] = __builtin_amdgcn_mfma_f32_16x16x32_bf16(Bt[n][k], At[m][k], acc[ai][bj][m][n], 0, 0, 0); __builtin_amdgcn_s_setprio(0); } while (0)
#define PG8_WAIT_V(n) asm volatile("s_waitcnt vmcnt(" #n ")" ::: "memory")
#define PG8_WAIT_L(n) asm volatile("s_waitcnt lgkmcnt(" #n ")" ::: "memory")
#define PG8_BAR __builtin_amdgcn_s_barrier()
#define PG8_SCHED __builtin_amdgcn_sched_barrier(0)
    Unit cur, nxt; int ui = 0;
    if (!S.next(0, cur)) return;
    f32x4 acc[2][2][4][2];
#pragma unroll
    for (int a = 0; a < 2; ++a)
#pragma unroll
        for (int b = 0; b < 2; ++b)
#pragma unroll
            for (int m = 0; m < 4; ++m)
#pragma unroll
                for (int n = 0; n < 2; ++n) acc[a][b][m][n] = (f32x4){0.f, 0.f, 0.f, 0.f};
    bf16x8 At[4][2], B0[2][2], B1[2][2];
    const char* cA = (const char*)g.A + (size_t)cur.pm * tstep; const char* cB = (const char*)g.Bt + (size_t)cur.pn * tstep;
    S.a_ready(cur);
    if constexpr (SP2) {
        PG8_STAGE(PG8_SB(0, 0), cB, voffB); PG8_STAGE(PG8_SB(0, 1), cB + hstep, voffB); PG8_STAGE(PG8_SA(0, 0), cA, voffA); PG8_STAGE(PG8_SA(0, 1), cA + hstep, voffA);
        if (wr == 1) PG8_BAR;
        PG8_WAIT_V(2); PG8_BAR;
        PG8_STAGE(PG8_SB(1, 0), cB + kstep, voffB); PG8_STAGE(PG8_SA(1, 0), cA + kstep, voffA); PG8_STAGE(PG8_SB(1, 1), cB + hstep + kstep, voffB);
        PG8_WAIT_V(6); PG8_BAR;
    } else {
        PG8_STAGE(PG8_SB(0, 0), cB, voffB); PG8_STAGE(PG8_SA(0, 0), cA, voffA); PG8_STAGE(PG8_SB(0, 1), cB + hstep, voffB); PG8_STAGE(PG8_SA(0, 1), cA + hstep, voffA);
        if (wr == 1) PG8_BAR;
        PG8_WAIT_V(4); PG8_BAR;
        PG8_STAGE(PG8_SB(1, 0), cB + kstep, voffB); PG8_STAGE(PG8_SA(1, 0), cA + kstep, voffA); PG8_STAGE(PG8_SB(1, 1), cB + hstep + kstep, voffB);
        PG8_WAIT_V(6); PG8_BAR;
    }
    for (;;) {
        const bool has_next = S.next(ui + 1, nxt);
        const char* nA = has_next ? (const char*)g.A + (size_t)nxt.pm * tstep : cA; const char* nB = has_next ? (const char*)g.Bt + (size_t)nxt.pn * tstep : cB;
        for (int t = 0; t < nt; t += 2) {
            const bool last = (t == nt - 2);
            const char* a1 = cA + (size_t)(t + 1) * kstep;
            const char* a2 = last ? nA : cA + (size_t)(t + 2) * kstep; const char* b2 = last ? nB : cB + (size_t)(t + 2) * kstep;
            const char* a3 = a2 + kstep; const char* b3 = b2 + kstep;
            if (last && has_next) S.a_ready(nxt);
            if constexpr (SP2) {
            PG8_LDB(B0, 0, 0); PG8_LDB(B1, 0, 1); PG8_SCHED; PG8_LDA(At, 0, 0); PG8_STAGE(PG8_SA(1, 1), a1 + hstep, voffA);
            PG8_WAIT_V(8); PG8_WAIT_L(0); PG8_BAR; PG8_MMA(0, 0, At, B0); PG8_MMA(0, 1, At, B1); PG8_BAR; PG8_SCHED;
            PG8_LDA(At, 0, 1); PG8_STAGE(PG8_SB(0, 0), b2, voffB); PG8_STAGE(PG8_SB(0, 1), b2 + hstep, voffB); PG8_STAGE(PG8_SA(0, 0), a2, voffA);
            PG8_WAIT_V(8); PG8_WAIT_L(0); PG8_BAR; PG8_MMA(1, 0, At, B0); PG8_MMA(1, 1, At, B1); PG8_BAR; PG8_SCHED;
            PG8_LDB(B0, 1, 0); PG8_LDB(B1, 1, 1); PG8_SCHED; PG8_LDA(At, 1, 0); PG8_STAGE(PG8_SA(0, 1), a2 + hstep, voffA);
            PG8_WAIT_V(8); PG8_WAIT_L(0); PG8_BAR; PG8_MMA(0, 0, At, B0); PG8_MMA(0, 1, At, B1); PG8_BAR; PG8_SCHED;
            PG8_LDA(At, 1, 1); PG8_STAGE(PG8_SB(1, 0), b3, voffB); PG8_STAGE(PG8_SB(1, 1), b3 + hstep, voffB); PG8_STAGE(PG8_SA(1, 0), a3, voffA);
            PG8_WAIT_V(8); PG8_WAIT_L(0); PG8_BAR; PG8_MMA(1, 0, At, B0); PG8_MMA(1, 1, At, B1); PG8_BAR; PG8_SCHED;
            } else {
            PG8_LDB(B0, 0, 0); PG8_SCHED; PG8_LDA(At, 0, 0); PG8_STAGE(PG8_SA(1, 1), a1 + hstep, voffA);
            PG8_WAIT_L(8); PG8_BAR; PG8_WAIT_L(0); PG8_MMA(0, 0, At, B0); PG8_BAR; PG8_SCHED;
            PG8_LDB(B1, 0, 1); PG8_STAGE(PG8_SB(0, 0), b2, voffB);
            PG8_BAR; PG8_WAIT_L(0); PG8_MMA(0, 1, At, B1); PG8_BAR;
            PG8_LDA(At, 0, 1); PG8_STAGE(PG8_SA(0, 0), a2, voffA);
            PG8_BAR; PG8_WAIT_L(0); PG8_MMA(1, 0, At, B0); PG8_BAR; PG8_SCHED;
            PG8_STAGE(PG8_SB(0, 1), b2 + hstep, voffB);
            PG8_WAIT_V(6); PG8_BAR; PG8_MMA(1, 1, At, B1); PG8_BAR;
            PG8_LDB(B0, 1, 0); PG8_SCHED; PG8_LDA(At, 1, 0); PG8_STAGE(PG8_SA(0, 1), a2 + hstep, voffA);
            PG8_WAIT_L(8); PG8_BAR; PG8_WAIT_L(0); PG8_MMA(0, 0, At, B0); PG8_BAR; PG8_SCHED;
            PG8_LDB(B1, 1, 1); PG8_STAGE(PG8_SB(1, 0), b3, voffB);
            PG8_BAR; PG8_WAIT_L(0); PG8_MMA(0, 1, At, B1); PG8_BAR;
            PG8_LDA(At, 1, 1); PG8_STAGE(PG8_SA(1, 0), a3, voffA);
            PG8_BAR; PG8_WAIT_L(0); PG8_MMA(1, 0, At, B0); PG8_BAR; PG8_SCHED;
            PG8_STAGE(PG8_SB(1, 1), b3 + hstep, voffB);
            PG8_WAIT_V(6); PG8_BAR; PG8_MMA(1, 1, At, B1); PG8_BAR;
            }
        }
        if constexpr (ALIGN_EPI) { if (wr == 0) PG8_BAR; }
        if constexpr (!Epi::AFTER_DRAIN) { E(acc, cur, wr, wc, fr, fq); S.done(cur); }
        if (!has_next) break;
#pragma unroll
        for (int a = 0; a < 2; ++a)
#pragma unroll
            for (int b = 0; b < 2; ++b)
#pragma unroll
                for (int m = 0; m < 4; ++m)
#pragma unroll
                    for (int n = 0; n < 2; ++n) acc[a][b][m][n] = (f32x4){0.f, 0.f, 0.f, 0.f};
        cur = nxt; cA = nA; cB = nB; ++ui;
        if constexpr (ALIGN_EPI) { if (wr == 1) PG8_BAR; }
    }
    PG8_WAIT_V(0);
    if constexpr (!ALIGN_EPI) { if (wr == 0) PG8_BAR; }
    PG8_BAR;
    if constexpr (Epi::AFTER_DRAIN) { E.fused(acc, cur, wr, wc, fr, fq, lds, wid, lane); S.done(cur); }
#undef PG8_SA
#undef PG8_SB
#undef PG8_STAGE
#undef PG8_LDA
#undef PG8_LDB
#undef PG8_MMA
#undef PG8_WAIT_V
#undef PG8_WAIT_L
#undef PG8_BAR
#undef PG8_SCHED
}
}

namespace pg8 {
struct EpiF32 {
    static constexpr bool PERM = false, AFTER_DRAIN = false;
    float* C; int ldc;
    __device__ __forceinline__ void operator()(const f32x4 (&acc)[2][2][4][2], const Unit& u, int wr, int wc, int fr, int fq) const {
        const int row0 = u.pm * BM + wr * 64 + fr, col0 = u.pn * BM + wc * 32 + 4 * fq;
#pragma unroll
        for (int ai = 0; ai < 2; ++ai)
#pragma unroll
            for (int m = 0; m < 4; ++m) { float* rowp = C + (size_t)(row0 + ai * HALF + m * 16) * ldc + col0;
#pragma unroll
                for (int bj = 0; bj < 2; ++bj)
#pragma unroll
                    for (int n = 0; n < 2; ++n) *(f32x4*)(rowp + bj * HALF + n * 16) = acc[ai][bj][m][n]; }
    }
};
struct EpiResid {
    static constexpr bool PERM = false, AFTER_DRAIN = false;
    const float* base; float* out; int ldc; const float* gate0; int rows_per_b; int gstride;
    __device__ __forceinline__ void operator()(const f32x4 (&acc)[2][2][4][2], const Unit& u, int wr, int wc, int fr, int fq) const {
        const int row0 = u.pm * BM + wr * 64 + fr, col0 = u.pn * BM + wc * 32 + 4 * fq;
        const float* gp = gate0 + (size_t)((u.pm * BM) / rows_per_b) * gstride + col0;
        f32x4 gv[2][2];
#pragma unroll
        for (int bj = 0; bj < 2; ++bj)
#pragma unroll
            for (int n = 0; n < 2; ++n) gv[bj][n] = *(const f32x4*)(gp + bj * HALF + n * 16);
#pragma unroll
        for (int ai = 0; ai < 2; ++ai)
#pragma unroll
            for (int m = 0; m < 4; ++m) { const size_t off = (size_t)(row0 + ai * HALF + m * 16) * ldc + col0;
#pragma unroll
                for (int bj = 0; bj < 2; ++bj)
#pragma unroll
                    for (int n = 0; n < 2; ++n) { const f32x4 bs = *(const f32x4*)(base + off + bj * HALF + n * 16);
                        *(f32x4*)(out + off + bj * HALF + n * 16) = bs + gv[bj][n] * acc[ai][bj][m][n]; }
                if (m & 1) asm volatile("" ::: "memory"); }
    }
};
}

namespace mk {
#define GAS __attribute__((address_space(1)))
#define LAS __attribute__((address_space(3)))
typedef unsigned short bf16;
typedef unsigned v4u __attribute__((ext_vector_type(4)));
typedef unsigned v2u __attribute__((ext_vector_type(2)));
typedef float f32x4 __attribute__((ext_vector_type(4)));
#define LDS_WAIT() asm volatile("s_waitcnt lgkmcnt(0)" ::: "memory")
#define VM_WAIT() asm volatile("s_waitcnt vmcnt(0)" ::: "memory")
__device__ __forceinline__ unsigned f2bf(float f) { unsigned u = __builtin_bit_cast(unsigned, f); return (u + 0x7fffu + ((u >> 16) & 1u)) >> 16; }
__device__ __forceinline__ unsigned pk2(float lo, float hi) { return f2bf(lo) | (f2bf(hi) << 16); }
__device__ __forceinline__ float bf2f(unsigned short h) { return __builtin_bit_cast(float, (unsigned)h << 16); }

constexpr int NWAVES = 8, NT = 512;
constexpr int RING_BYTES = 131072, LDSCTL_OFF = RING_BYTES, LDS_BYTES = 147456;
constexpr size_t MiB = 1u << 20;
constexpr size_t WS_CTL = 0, CTL_ZERO_BYTES = 65536;
constexpr size_t WS_MOD = 1 * MiB, WS_KEYS = 2 * MiB, WS_WIN = 4 * MiB, WS_WOUT = 12 * MiB, WS_WQ = 16 * MiB, WS_H = 24 * MiB, WS_X1 = 56 * MiB;
constexpr size_t WS_EIDX = 120 * MiB, WS_GATE = 128 * MiB, WS_A = 136 * MiB, WS_MIX = 200 * MiB, WS_U = 232 * MiB, WS_V = 296 * MiB, WS_END = 360 * MiB;
constexpr size_t WS_T1 = 232 * MiB, WS_T2 = 360 * MiB, WS_TEND = 488 * MiB;
constexpr int CW_BAR = 4096;

enum { PH_PRO = 0, PH_H0 = 1, PH_L0 = 2, PH_PER_LAYER = 7, PH_G1 = 0, PH_AT = 1, PH_G2 = 2, PH_N2 = 3, PH_G3 = 4, PH_TK = 5, PH_PE = 6, PH_END = PH_L0 + 2 * PH_PER_LAYER, PH_H1 = 100 };

struct Args { const float* in[19]; float* out; unsigned char* ws; int ph_lo, ph_hi; };

__device__ __forceinline__ void p0_transpose_item(const float* W, int K, int N, bf16* WT, LAS float* scr, int item, int lane) {
    const int nblk = N / 32, kb = item / nblk, nb = item % nblk, k0 = 64 * kb, n0 = 32 * nb;
#pragma unroll 8
    for (int i = 0; i < 32; ++i) { const int kk = 2 * i + (lane >> 5); scr[kk * 33 + (lane & 31)] = W[(size_t)(k0 + kk) * N + n0 + (lane & 31)]; }
    LDS_WAIT(); asm volatile("" ::: "memory");
    const int c = lane & 7;
#pragma unroll
    for (int j = 0; j < 4; ++j) { const int n = (lane >> 3) + 8 * j; const LAS float* s = scr + (8 * c) * 33 + n;
        v4u o; o.x = pk2(s[0 * 33], s[1 * 33]); o.y = pk2(s[2 * 33], s[3 * 33]); o.z = pk2(s[4 * 33], s[5 * 33]); o.w = pk2(s[6 * 33], s[7 * 33]);
        *(GAS v4u*)(WT + (size_t)(n0 + n) * K + k0 + 8 * c) = o; }
    LDS_WAIT(); asm volatile("" ::: "memory");
}
__device__ __forceinline__ float wave_sum(float v) {
#pragma unroll
    for (int o = 1; o < 64; o <<= 1) v += __shfl_xor(v, o);
    return v;
}
__device__ __forceinline__ void hmod_row(const float* xrow, const float* g, const float* mod_b, int which, bf16* orow, int lane) {
    const GAS f32x4* xr = (const GAS f32x4*)xrow + lane;
    f32x4 v[4]; float s = 0.f;
#pragma unroll
    for (int j = 0; j < 4; ++j) { v[j] = xr[64 * j]; s += (v[j].x * v[j].x + v[j].y * v[j].y) + (v[j].z * v[j].z + v[j].w * v[j].w); }
    const float rstd = 1.0f / sqrtf(wave_sum(s) * (1.f / D) + EPS);
    const float* shp = mod_b + (which * 3 + 0) * D; const float* scp = mod_b + (which * 3 + 1) * D;
    GAS unsigned long long* o8 = (GAS unsigned long long*)orow + lane;
#pragma unroll
    for (int j = 0; j < 4; ++j) { const int k = 4 * lane + 256 * j;
        const f32x4 gg = *(const f32x4*)(g + k), sh = *(const f32x4*)(shp + k), sc = *(const f32x4*)(scp + k);
        const f32x4 hv = v[j] * rstd * gg * (sc + 1.0f) + sh;
        o8[64 * j] = (unsigned long long)pk2(hv.x, hv.y) | ((unsigned long long)pk2(hv.z, hv.w) << 32); }
}


#define MK_GW(wave) (((gridDim.x % 8 == 0) ? (blockIdx.x % 8) * (gridDim.x / 8) + blockIdx.x / 8 : blockIdx.x) * NWAVES + (wave))
#define MK_NGW (gridDim.x * NWAVES)

__device__ __forceinline__ void ph_prologue(const Args& args, LAS unsigned char* lds) {
    const int tid = threadIdx.x, lane = tid & 63, wave = __builtin_amdgcn_readfirstlane(tid >> 6);
    const int G = gridDim.x, bx = blockIdx.x;
    unsigned char* ws = args.ws;
    {
        const float* c = args.in[1]; const float* w_ada = args.in[5]; const float* b_ada = args.in[6]; float* mod = (float*)(ws + WS_MOD);
        LAS float* sact = (LAS float*)lds; LAS float* red = (LAS float*)(lds + 32768);
        for (int i = tid; i < B * D; i += NT) { const float cv = c[i]; sact[i] = cv / (1.0f + __expf(-cv)); }
        __syncthreads();
        for (int item = bx; item < DEPTH * (6 * D / 32); item += G) {
            const int l = item / (6 * D / 32), n0 = (item % (6 * D / 32)) * 32, cc = tid & 31, kg = tid >> 5;
            float acc[B];
#pragma unroll
            for (int b = 0; b < B; ++b) acc[b] = 0.f;
            const float* w = w_ada + (size_t)l * D * 6 * D + n0 + cc;
            for (int kk = 0; kk < 64; ++kk) { const int k = kg * 64 + kk; const float wv = w[(size_t)k * 6 * D];
#pragma unroll
                for (int b = 0; b < B; ++b) acc[b] += sact[b * D + k] * wv; }
#pragma unroll
            for (int b = 0; b < B; ++b) red[(kg * 32 + cc) * B + b] = acc[b];
            __syncthreads();
            if (tid < 32 * B) { const int c2 = tid & 31, b = tid >> 5; float s = 0.f;
                for (int k2 = 0; k2 < 16; ++k2) s += red[(k2 * 32 + c2) * B + b];
                mod[((size_t)l * B + b) * 6 * D + n0 + c2] = s + b_ada[(size_t)l * 6 * D + n0 + c2]; }
            __syncthreads();
        }
    }
    const int gw = MK_GW(wave), NGW = MK_NGW;
    {
        const float* w_in = args.in[7]; const float* w_out = args.in[14]; const float* peer_wq = args.in[15];
        bf16* WinT = (bf16*)(ws + WS_WIN); bf16* WoutT = (bf16*)(ws + WS_WOUT); bf16* WqT = (bf16*)(ws + WS_WQ);
        LAS float* scr = (LAS float*)(lds + wave * 16384);
        constexpr int I_IN = (D / 64) * (INW / 32), I_OUT = (D / 64) * (D / 32), I_Q = (D / 64) * (PW / 32), I_L = I_IN + I_OUT + I_Q;
        for (int it = gw; it < DEPTH * I_L; it += NGW) {
            const int l = it / I_L; int r = it % I_L;
            if (r < I_IN) { p0_transpose_item(w_in + (size_t)l * D * INW, D, INW, WinT + (size_t)l * INW * D, scr, r, lane); continue; } r -= I_IN;
            if (r < I_OUT) { p0_transpose_item(w_out + (size_t)l * D * D, D, D, WoutT + (size_t)l * D * D, scr, r, lane); continue; } r -= I_OUT;
            p0_transpose_item(peer_wq + (size_t)l * D * PW, D, PW, WqT + (size_t)l * PW * D, scr, r, lane);
        }
    }
    {
        const float* peer_keys = args.in[16]; bf16* keysb = (bf16*)(ws + WS_KEYS);
        for (int i = gw * 64 + lane; i < DEPTH * 2 * NK * 128 / 2; i += NGW * 64) ((GAS unsigned*)keysb)[i] = pk2(peer_keys[2 * i], peer_keys[2 * i + 1]);
    }
#if DO_UV
    {
        const float* peer_u = args.in[17]; const float* peer_v = args.in[18]; bf16* Ub = (bf16*)(ws + WS_U); bf16* Vb = (bf16*)(ws + WS_V);
        for (size_t i = (size_t)gw * 64 + lane; i < (size_t)DEPTH * NE * D / 8; i += (size_t)NGW * 64) {
            { const f32x4 a = ((const GAS f32x4*)peer_u)[2 * i], b = ((const GAS f32x4*)peer_u)[2 * i + 1];
              v4u o; o.x = pk2(a.x, a.y); o.y = pk2(a.z, a.w); o.z = pk2(b.x, b.y); o.w = pk2(b.z, b.w); ((GAS v4u*)Ub)[i] = o; }
            { const f32x4 a = ((const GAS f32x4*)peer_v)[2 * i], b = ((const GAS f32x4*)peer_v)[2 * i + 1];
              v4u o; o.x = pk2(a.x, a.y); o.y = pk2(a.z, a.w); o.z = pk2(b.x, b.y); o.w = pk2(b.z, b.w); ((GAS v4u*)Vb)[i] = o; }
        }
    }
#endif
}
template <int L, int WHICH> __device__ __forceinline__ void ph_hmod(const Args& args) {
    const int lane = threadIdx.x & 63, wave = __builtin_amdgcn_readfirstlane(threadIdx.x >> 6);
    unsigned char* ws = args.ws;
    const float* src = WHICH ? (const float*)(ws + WS_X1) : (L == 0 ? args.in[0] : args.out);
    const float* g = args.in[WHICH ? 4 : 3] + L * D; const float* mod_l = (const float*)(ws + WS_MOD) + (size_t)L * B * 6 * D; bf16* Hb = (bf16*)(ws + WS_H);
    const int gw = MK_GW(wave), NGW = MK_NGW;
    for (int m = gw; m < T; m += NGW) hmod_row(src + (size_t)m * D, g, mod_l + (size_t)(m / S) * 6 * D, WHICH, Hb + (size_t)m * D, lane);
}
template <int L> __device__ __forceinline__ void ph_g1(const Args& args, LAS unsigned char* lds) {
    unsigned char* ws = args.ws;
    pg8::Gemm g{(const bf16*)(ws + WS_H), (const bf16*)(ws + WS_WIN) + (size_t)L * INW * D, T, INW, D}; pg8::StaticOrder SO; SO.init(T, INW, gridDim.x, blockIdx.x);
#if Z_F32
    pg8::EpiF32 E{(float*)(ws + WS_T1), INW};
    pg8::gemm_phase<pg8::EpiF32, pg8::StaticOrder, true, true>(lds, g, SO, E);
#else
    pg8::EpiBf16<0> E{(bf16*)(ws + WS_A), INW, nullptr, 0, 0, 1.f};
    pg8::gemm_phase<pg8::EpiBf16<0>, pg8::StaticOrder, true, true>(lds, g, SO, E);
#endif
}
template <int L> __device__ __forceinline__ void ph_g2(const Args& args, LAS unsigned char* lds) {
    unsigned char* ws = args.ws;
    pg8::Gemm g{(const bf16*)(ws + WS_MIX), (const bf16*)(ws + WS_WOUT) + (size_t)L * D * D, T, D, D}; pg8::StaticOrder SO; SO.init(T, D, gridDim.x, blockIdx.x);
    pg8::EpiResid E{L == 0 ? args.in[0] : args.out, (float*)(ws + WS_X1), D, (const float*)(ws + WS_MOD) + (size_t)L * B * 6 * D + 2 * D, S, 6 * D};
    pg8::gemm_phase<pg8::EpiResid, pg8::StaticOrder, true, true>(lds, g, SO, E);
}
template <int L> __device__ __forceinline__ void ph_g3(const Args& args, LAS unsigned char* lds) {
    unsigned char* ws = args.ws;
    pg8::Gemm g{(const bf16*)(ws + WS_H), (const bf16*)(ws + WS_WQ) + (size_t)L * PW * D, T, PW, D}; pg8::StaticOrder SO; SO.init(T, PW, gridDim.x, blockIdx.x);
#if QP_F32
    pg8::EpiF32 E{(float*)(ws + WS_T1), PW};
    pg8::gemm_phase<pg8::EpiF32, pg8::StaticOrder, true, true>(lds, g, SO, E);
#else
    pg8::EpiBf16<0> E{(bf16*)(ws + WS_A), PW, nullptr, 0, 0, 1.f};
    pg8::gemm_phase<pg8::EpiBf16<0>, pg8::StaticOrder, true, true>(lds, g, SO, E);
#endif
}
}

namespace mk {
#define XB_TMO      128
#define XB_XCNT(j)  (256  + 64 * (j))
#define XB_XSUB(j)  (1280 + 64 * (j))
#define XB_XGEN(j)  (2304 + 64 * (j))
#define XB_TOP      3328
#define XB_TOPGEN   3392
#define XCD_BAR_WORDS 3456
#define XB_SPIN_CAP (1u << 18)

__device__ __forceinline__ unsigned xb_ld(unsigned* p)              { return __hip_atomic_load(p, __ATOMIC_RELAXED, __HIP_MEMORY_SCOPE_AGENT); }
__device__ __forceinline__ unsigned xb_add(unsigned* p, unsigned v) { return __hip_atomic_fetch_add(p, v, __ATOMIC_RELAXED, __HIP_MEMORY_SCOPE_AGENT); }
__device__ __forceinline__ unsigned xb_xcc_id() { return (unsigned)__builtin_amdgcn_s_getreg((3 << 11) | 20) & 0xFu; }
#define XB_SPIN(cond, bar) do { unsigned _sp = 0; while (cond) { __builtin_amdgcn_s_sleep(1); \
    if ((++_sp & 255u) == 0u) { if (xb_ld(&(bar)[XB_TMO])) break; if (_sp > XB_SPIN_CAP) { atomicAdd(&(bar)[XB_TMO], 1u); break; } } } } while (0)

struct XcdBarrier {
    unsigned* bar; unsigned x;
    volatile LAS unsigned* st;
};

__device__ __forceinline__ XcdBarrier xcd_barrier_post(unsigned* bar, volatile LAS unsigned* st) {
    XcdBarrier b; b.bar = bar; b.x = xb_xcc_id(); b.st = st;
    if (threadIdx.x == 0) (void)xb_add(&bar[XB_XCNT(b.x)], 1u);
    return b;
}
__device__ __forceinline__ void xcd_barrier_complete(unsigned* bar, unsigned x, unsigned& nloc, unsigned& nx) {
    const unsigned G = gridDim.x * gridDim.y * gridDim.z;
    unsigned sum, cnt, mine, sp = 0u;
    for (;;) {
        sum = 0u; cnt = 0u; mine = 0u;
#pragma unroll
        for (unsigned j = 0; j < 16; ++j) { const unsigned c = xb_ld(&bar[XB_XCNT(j)]); sum += c; cnt += (c > 0u) ? 1u : 0u; mine = (j == x) ? c : mine; }
        if (sum == G) break;
        __builtin_amdgcn_s_sleep(1);
        if ((++sp & 255u) == 0u) { if (xb_ld(&bar[XB_TMO])) break; if (sp > XB_SPIN_CAP) { atomicAdd(&bar[XB_TMO], 1u); break; } }
    }
    nloc = mine > 0u ? mine : 1u; nx = cnt > 0u ? cnt : 1u;
}

__device__ __forceinline__ void xcd_barrier(const XcdBarrier& b) {
    asm volatile("s_waitcnt vmcnt(0)" ::: "memory");
    __syncthreads();
    if (threadIdx.x == 0) {
        unsigned* bar = b.bar;
        __builtin_amdgcn_s_waitcnt(0);
        unsigned nloc = b.st[0], nx = b.st[1];
        if (nloc == 0u) { xcd_barrier_complete(bar, b.x, nloc, nx); b.st[0] = nloc; b.st[1] = nx; }
        const unsigned old = xb_add(&bar[XB_XSUB(b.x)], 1u);
        const unsigned gen = old / nloc;
        if (old + 1u == (gen + 1u) * nloc) {
            __builtin_amdgcn_fence(__ATOMIC_RELEASE, "agent");
            asm volatile("s_waitcnt vmcnt(0)" ::: "memory");
            const unsigned og = xb_add(&bar[XB_TOP], 1u);
            const unsigned tg = og / nx;
            if (og + 1u == (tg + 1u) * nx) xb_add(&bar[XB_TOPGEN], 1u);
            else XB_SPIN(xb_ld(&bar[XB_TOPGEN]) == tg, bar);
            __builtin_amdgcn_fence(__ATOMIC_ACQUIRE, "agent");
            xb_add(&bar[XB_XGEN(b.x)], 1u);
            asm volatile("s_waitcnt vmcnt(0)" ::: "memory");
        } else {
            XB_SPIN(xb_ld(&bar[XB_XGEN(b.x)]) == gen, bar);
            __builtin_amdgcn_fence(__ATOMIC_ACQUIRE, "agent");
            asm volatile("s_waitcnt vmcnt(0)" ::: "memory");
        }
    }
    __syncthreads();
}

}


namespace mk {
typedef short bf16x8 __attribute__((ext_vector_type(8)));
typedef float f32x16 __attribute__((ext_vector_type(16)));
__device__ __forceinline__ unsigned f2sort(float f) { const unsigned u = __builtin_bit_cast(unsigned, f); return u ^ ((unsigned)((int)u >> 31) | 0x80000000u); }
__device__ __forceinline__ float sort2f(unsigned s) { const unsigned m = (unsigned)((int)s >> 31); return __builtin_bit_cast(float, s ^ (~m | 0x80000000u)); }
__device__ __forceinline__ unsigned umax_(unsigned a, unsigned b) { return a > b ? a : b; }
__device__ __forceinline__ unsigned umin_(unsigned a, unsigned b) { return a < b ? a : b; }
__device__ __forceinline__ void sort16_desc(unsigned (&v)[16]) {
#pragma unroll
    for (int k = 2; k <= 16; k <<= 1)
#pragma unroll
        for (int j = k >> 1; j > 0; j >>= 1)
#pragma unroll
            for (int i = 0; i < 16; ++i) { const int l = i ^ j; if (l > i) { const unsigned a = v[i], b = v[l], mx = umax_(a, b), mn = umin_(a, b);
                if ((i & k) == 0) { v[i] = mx; v[l] = mn; } else { v[i] = mn; v[l] = mx; } } }
}
__device__ __forceinline__ void merge16_desc(unsigned (&a)[16], const unsigned (&b)[16]) {
#pragma unroll
    for (int i = 0; i < 16; ++i) a[i] = umax_(a[i], b[15 - i]);
#pragma unroll
    for (int j = 8; j > 0; j >>= 1)
#pragma unroll
        for (int i = 0; i < 16; ++i) { const int l = i ^ j; if (l > i) { const unsigned x = a[i], y = a[l]; a[i] = umax_(x, y); a[l] = umin_(x, y); } }
}
__device__ __forceinline__ void xmerge16_desc(unsigned (&a)[16]) {
    unsigned p[16];
#pragma unroll
    for (int i = 0; i < 16; ++i) p[i] = (unsigned)__shfl_xor((int)a[i], 32);
    merge16_desc(a, p);
}
#define TK_CANDS \
    TKC(0, 0, 0, 2, 1) \
    TKC(1, 0, 1, 2, 2) \
    TKC(2, 0, 2, 2, 3) \
    TKC(3, 0, 3, 2, 4) \
    TKC(4, 0, 4, 3, 0) \
    TKC(5, 0, 5, 3, 1) \
    TKC(6, 0, 6, 3, 2) \
    TKC(7, 0, 7, 3, 3) \
    TKC(8, 0, 8, 4, 0) \
    TKC(9, 0, 9, 4, 1) \
    TKC(10, 0, 10, 4, 2) \
    TKC(11, 0, 11, 5, 0) \
    TKC(12, 0, 12, 5, 1) \
    TKC(13, 0, 13, 6, 0) \
    TKC(14, 0, 14, 6, 1) \
    TKC(15, 0, 15, 7, 0) \
    TKC(16, 1, 0, 7, 1) \
    TKC(17, 1, 1, 8, 0) \
    TKC(18, 1, 2, 9, 0) \
    TKC(19, 1, 3, 10, 0) \
    TKC(20, 1, 4, 11, 0) \
    TKC(21, 1, 5, 12, 0) \
    TKC(22, 1, 6, 13, 0) \
    TKC(23, 1, 7, 14, 0) \
    TKC(24, 2, 0, 15, 0)

template <int L> __device__ __forceinline__ void ph_topk(const Args& args, LAS unsigned char* lds) {
    const int tid = threadIdx.x, lane = tid & 63, wave = __builtin_amdgcn_readfirstlane(tid >> 6);
    const int c = lane & 31, hi = lane >> 5;
    unsigned char* ws = args.ws;
    const bf16* keysb = (const bf16*)(ws + WS_KEYS) + (size_t)L * 2 * NK * 128;
    const bf16* qp = (const bf16*)(ws + WS_A);
    int* eidx = (int*)(ws + WS_EIDX); float* gate = (float*)(ws + WS_GATE);
    constexpr int KROW = 272;
    for (int ch = tid; ch < 256 * 16; ch += NT) { const int r = ch >> 4, cc = ch & 15; *(LAS v4u*)(lds + r * KROW + cc * 16) = *(const GAS v4u*)(keysb + r * 128 + cc * 8); }
    __syncthreads();
    LAS unsigned* wl = (LAS unsigned*)(lds + 256 * KROW + wave * 4096) + c * 32;
    const int gw = MK_GW(wave), NGW = MK_NGW;
    const unsigned h4 = 4u * (unsigned)hi;
    for (int pass = gw; pass < T * PH / 32; pass += NGW) {
        const int row = pass * 32 + c;
        const bf16* qrow = qp + (size_t)row * 256 + hi * 8;
        unsigned top[2][16];
#pragma unroll
        for (int half = 0; half < 2; ++half) {
            bf16x8 bq[8];
#pragma unroll
            for (int ks = 0; ks < 8; ++ks) bq[ks] = *(const GAS bf16x8*)(qrow + half * 128 + ks * 16);
            f32x16 acc[4];
#pragma unroll
            for (int mt = 0; mt < 4; ++mt)
#pragma unroll
                for (int r = 0; r < 16; ++r) acc[mt][r] = 0.f;
#pragma unroll
            for (int ks = 0; ks < 8; ++ks)
#pragma unroll
                for (int mt = 0; mt < 4; ++mt) { const bf16x8 a = *(const LAS bf16x8*)(lds + (half * 128 + mt * 32 + c) * KROW + (ks * 16 + hi * 8) * 2);
                    acc[mt] = __builtin_amdgcn_mfma_f32_32x32x16_bf16(a, bq[ks], acc[mt], 0, 0, 0); }
            unsigned g[4][16];
#pragma unroll
            for (int mt = 0; mt < 4; ++mt)
#pragma unroll
                for (int r = 0; r < 16; ++r) { const unsigned code = (unsigned)(127 - mt * 32 - (r & 3) - 8 * (r >> 2)) - h4;
                    g[mt][r] = (f2sort(acc[mt][r]) & ~127u) | code; }
#pragma unroll
            for (int mt = 0; mt < 4; ++mt) sort16_desc(g[mt]);
            merge16_desc(g[0], g[1]); merge16_desc(g[2], g[3]); merge16_desc(g[0], g[2]);
            xmerge16_desc(g[0]);
#pragma unroll
            for (int i = 0; i < 16; ++i) top[half][i] = g[0][i];
        }
#pragma unroll
        for (int q = 0; q < 4; ++q) { v4u w;
            w.x = hi ? top[1][4 * q + 0] : top[0][4 * q + 0]; w.y = hi ? top[1][4 * q + 1] : top[0][4 * q + 1];
            w.z = hi ? top[1][4 * q + 2] : top[0][4 * q + 2]; w.w = hi ? top[1][4 * q + 3] : top[0][4 * q + 3];
            *(LAS v4u*)(wl + hi * 16 + 4 * q) = w; }
        float v1[16], v2[16];
#pragma unroll
        for (int i = 0; i < 16; ++i) { v1[i] = sort2f(top[0][i] & ~127u); v2[i] = sort2f(top[1][i] & ~127u); }
        unsigned cd[2][16];
#pragma unroll
        for (int i = 0; i < 16; ++i) { cd[0][i] = 0u; cd[1][i] = 0u; }
#define TKC(q, i0, j0, i1, j1) { const float sm = hi ? (v1[i1] + v2[j1]) : (v1[i0] + v2[j0]); const unsigned code = hi ? (unsigned)(255 - ((i1) * 16 + (j1))) : (unsigned)(255 - ((i0) * 16 + (j0))); \
            cd[(q) >> 4][(q) & 15] = (f2sort(sm) & ~255u) | code; }
        TK_CANDS
#undef TKC
        sort16_desc(cd[0]); sort16_desc(cd[1]); merge16_desc(cd[0], cd[1]); xmerge16_desc(cd[0]);
        float ev[16]; int ex[16]; float den = 0.f;
        const float vmax = sort2f(cd[0][0] & ~255u);
#pragma unroll
        for (int r = 0; r < 16; ++r) { const unsigned key = cd[0][r], pos = 255u - (key & 255u);
            const unsigned k1 = wl[pos >> 4], k2 = wl[16 + (pos & 15u)];
            ex[r] = (int)((127u - (k1 & 127u)) * 128u + (127u - (k2 & 127u)));
            ev[r] = __expf(sort2f(key & ~255u) - vmax); den += ev[r]; }
        const float inv = 1.0f / den;
        if (hi == 0) {
#pragma unroll
            for (int q = 0; q < 4; ++q) { v4u w; w.x = (unsigned)ex[4 * q]; w.y = (unsigned)ex[4 * q + 1]; w.z = (unsigned)ex[4 * q + 2]; w.w = (unsigned)ex[4 * q + 3]; *(GAS v4u*)(eidx + (size_t)row * 16 + 4 * q) = w; }
        } else {
#pragma unroll
            for (int q = 0; q < 4; ++q) { f32x4 w; w.x = ev[4 * q] * inv; w.y = ev[4 * q + 1] * inv; w.z = ev[4 * q + 2] * inv; w.w = ev[4 * q + 3] * inv; *(GAS f32x4*)(gate + (size_t)row * 16 + 4 * q) = w; }
        }
    }
}
}


namespace mk {
typedef short bf16x4v __attribute__((ext_vector_type(4)));
__device__ __forceinline__ unsigned cvt_pk_bf16(float lo, float hi) { unsigned r; asm volatile("v_cvt_pk_bf16_f32 %0, %1, %2" : "=v"(r) : "v"(lo), "v"(hi)); return r; }
__device__ __forceinline__ void head_prep(const bf16* src  , const float* g, int h, int pos, float scl, v4u (&outp)[4]) {
    float v[4][8]; float ss = 0.f;
#pragma unroll
    for (int ks = 0; ks < 4; ++ks) { const v4u w = *(const GAS v4u*)(src + ks * 16);
        const unsigned ww[4] = {w.x, w.y, w.z, w.w};
#pragma unroll
        for (int q = 0; q < 4; ++q) { v[ks][2 * q] = __builtin_bit_cast(float, ww[q] << 16); v[ks][2 * q + 1] = __builtin_bit_cast(float, ww[q] & 0xffff0000u); }
#pragma unroll
        for (int j = 0; j < 8; ++j) ss += v[ks][j] * v[ks][j]; }
    ss += __shfl_xor(ss, 32);
    const float r = scl / sqrtf(ss * (1.0f / 64.0f) + EPS);
#pragma unroll
    for (int ks = 0; ks < 4; ++ks) { const f32x4 g0 = *(const f32x4*)(g + ks * 16 + 8 * h), g1 = *(const f32x4*)(g + ks * 16 + 8 * h + 4);
        v[ks][0] *= r * g0.x; v[ks][1] *= r * g0.y; v[ks][2] *= r * g0.z; v[ks][3] *= r * g0.w; v[ks][4] *= r * g1.x; v[ks][5] *= r * g1.y; v[ks][6] *= r * g1.z; v[ks][7] *= r * g1.w; }
#pragma unroll
    for (int i = 0; i < 8; ++i) { const float other = __shfl_xor(v[0][i], 32);
        constexpr float INVF[8] = {1.0f, 0.1939227432012558f, 0.03760603070259094f, 0.007292664609849453f, 0.0014142135623842478f, 0.00027424818836152554f, 5.318296098266728e-05f, 1.0313386155758053e-05f};
        float rev = ((float)pos * INVF[i]) * 0.15915494309189535f; rev -= floorf(rev);
        const float sn = __builtin_amdgcn_sinf(rev), cs = __builtin_amdgcn_cosf(rev);
        v[0][i] = h ? (v[0][i] * cs + other * sn) : (v[0][i] * cs - other * sn); }
#pragma unroll
    for (int ks = 0; ks < 4; ++ks) { outp[ks].x = pk2(v[ks][0], v[ks][1]); outp[ks].y = pk2(v[ks][2], v[ks][3]); outp[ks].z = pk2(v[ks][4], v[ks][5]); outp[ks].w = pk2(v[ks][6], v[ks][7]); }
}

template <int L> __device__ __forceinline__ void ph_mixer(const Args& args, LAS unsigned char* lds) {
    const int tid = threadIdx.x, lane = tid & 63, wave = __builtin_amdgcn_readfirstlane(tid >> 6);
    const int c = lane & 31, hi = lane >> 5;
    unsigned char* ws = args.ws;
    const bf16* z = (const bf16*)(ws + WS_A); bf16* mix = (bf16*)(ws + WS_MIX);
    const int* positions = (const int*)args.in[2];
    const float* qg = args.in[8] + L * 64; const float* kg = args.in[9] + L * 64; const float* sink = args.in[10] + L * NQH;
    const float* conv_w = args.in[11] + L * 3 * 256; const float* pool_w = args.in[12] + (size_t)L * 4 * 64 * 64; const float* pool_scale = args.in[13] + L * 256;
    constexpr int KROW = 144, VROW = 776, K_OFF = 0, V_OFF = 384 * KROW, P_OFF = V_OFF + 64 * VROW, PROW = 68;
    constexpr int NQB = S / 128;
    for (int unit = blockIdx.x; unit < B * NKVH * NQB; unit += gridDim.x) {
        const int qb = unit % NQB, kvh = (unit / NQB) % NKVH, b = unit / (NQB * NKVH);
        const int tok0 = b * S, kbase = qb * 128 - 128;
        __syncthreads();
        for (int pass = wave; pass < 12; pass += NWAVES) { const int kr = pass * 32 + c, kp = kbase + kr;
            if (kp >= 0 && kp < S) {
                v4u o[4]; head_prep(z + (size_t)(tok0 + kp) * INW + OK_ + kvh * 64 + 8 * hi, kg, hi, positions[tok0 + kp], 1.0f, o);
#pragma unroll
                for (int ks = 0; ks < 4; ++ks) *(LAS v4u*)(lds + K_OFF + kr * KROW + (ks * 16 + 8 * hi) * 2) = o[ks]; } }
        for (int ch = tid; ch < 384 * 8; ch += NT) { const int kr = ch >> 3, dc = ch & 7, kp = kbase + kr;
            if (kp >= 0 && kp < S) { const v4u w = *(const GAS v4u*)(z + (size_t)(tok0 + kp) * INW + OV + kvh * 64 + dc * 8);
                const unsigned ww[4] = {w.x, w.y, w.z, w.w};
#pragma unroll
                for (int q = 0; q < 4; ++q) { *(LAS unsigned short*)(lds + V_OFF + (dc * 8 + 2 * q) * VROW + kr * 2) = (unsigned short)(ww[q] & 0xffffu);
                                              *(LAS unsigned short*)(lds + V_OFF + (dc * 8 + 2 * q + 1) * VROW + kr * 2) = (unsigned short)(ww[q] >> 16); } } }
        __syncthreads();
        {
            const int g = wave >> 1, qh = wave & 1, hq = kvh * GRP + g;
            const float sk = sink[hq];
#pragma unroll 1
            for (int qt = 0; qt < 2; ++qt) {
                const int a = qb * 128 + qh * 64 + qt * 32;
                const int tq = tok0 + a + c;
                v4u qf[4]; head_prep(z + (size_t)tq * INW + OQ + hq * 64 + 8 * hi, qg, hi, positions[tq], 0.125f, qf);
                bf16x8 bq[4];
#pragma unroll
                for (int ks = 0; ks < 4; ++ks) bq[ks] = __builtin_bit_cast(bf16x8, qf[ks]);
                float m = sk, lsum = hi ? 0.f : 1.f;
                f32x16 O0, O1;
#pragma unroll
                for (int r = 0; r < 16; ++r) { O0[r] = 0.f; O1[r] = 0.f; }
#pragma unroll 1
                for (int kt = 0; kt < 9; ++kt) {
                    const int kp0 = a - 128 + 32 * kt;
                    if (kp0 < 0 || kp0 >= S) continue;
                    const int kr0 = kp0 - kbase;
                    f32x16 sa;
#pragma unroll
                    for (int r = 0; r < 16; ++r) sa[r] = 0.f;
#pragma unroll
                    for (int ks = 0; ks < 4; ++ks) { const bf16x8 ka = *(const LAS bf16x8*)(lds + K_OFF + (kr0 + c) * KROW + (ks * 16 + 8 * hi) * 2);
                        sa = __builtin_amdgcn_mfma_f32_32x32x16_bf16(ka, bq[ks], sa, 0, 0, 0); }
                    if (kt == 0) {
#pragma unroll
                        for (int r = 0; r < 16; ++r) { const int i = (r & 3) + 8 * (r >> 2) + 4 * hi; if (i < c) sa[r] = -1e30f; }
                    } else if (kt == 8) {
#pragma unroll
                        for (int r = 0; r < 16; ++r) { const int i = (r & 3) + 8 * (r >> 2) + 4 * hi; if (i > c) sa[r] = -1e30f; }
                    }
                    float mx = sa[0];
#pragma unroll
                    for (int r = 1; r < 16; ++r) mx = fmaxf(mx, sa[r]);
                    mx = fmaxf(mx, __shfl_xor(mx, 32));
                    const float mn = fmaxf(m, mx), al = __expf(m - mn);
                    m = mn;
                    float p[16]; float rs = 0.f;
#pragma unroll
                    for (int r = 0; r < 16; ++r) { p[r] = __expf(sa[r] - mn); rs += p[r]; }
                    lsum = lsum * al + rs;
#pragma unroll
                    for (int r = 0; r < 16; ++r) { O0[r] *= al; O1[r] *= al; }
#pragma unroll
                    for (int s2 = 0; s2 < 2; ++s2) {
                        v4u pw; pw.x = cvt_pk_bf16(p[8 * s2 + 0], p[8 * s2 + 1]); pw.y = cvt_pk_bf16(p[8 * s2 + 2], p[8 * s2 + 3]); pw.z = cvt_pk_bf16(p[8 * s2 + 4], p[8 * s2 + 5]); pw.w = cvt_pk_bf16(p[8 * s2 + 6], p[8 * s2 + 7]);
                        const bf16x8 pb = __builtin_bit_cast(bf16x8, pw);
#pragma unroll
                        for (int mt = 0; mt < 2; ++mt) { const LAS unsigned char* vp = lds + V_OFF + (mt * 32 + c) * VROW + (kr0 + 16 * s2 + 4 * hi) * 2;
                            const v2u lo2 = *(const LAS v2u*)vp, hi2 = *(const LAS v2u*)(vp + 16);
                            v4u va; va.x = lo2.x; va.y = lo2.y; va.z = hi2.x; va.w = hi2.y;
                            if (mt == 0) O0 = __builtin_amdgcn_mfma_f32_32x32x16_bf16(__builtin_bit_cast(bf16x8, va), pb, O0, 0, 0, 0);
                            else         O1 = __builtin_amdgcn_mfma_f32_32x32x16_bf16(__builtin_bit_cast(bf16x8, va), pb, O1, 0, 0, 0); }
                    }
                }
                const float inv = 1.0f / (lsum + __shfl_xor(lsum, 32));
                bf16* orow = mix + (size_t)tq * D + hq * 64 + 4 * hi;
#pragma unroll
                for (int q = 0; q < 4; ++q) { v2u w0, w1;
                    w0.x = pk2(O0[4 * q] * inv, O0[4 * q + 1] * inv); w0.y = pk2(O0[4 * q + 2] * inv, O0[4 * q + 3] * inv);
                    w1.x = pk2(O1[4 * q] * inv, O1[4 * q + 1] * inv); w1.y = pk2(O1[4 * q + 2] * inv, O1[4 * q + 3] * inv);
                    *(GAS v2u*)(orow + 8 * q) = w0; *(GAS v2u*)(orow + 32 + 8 * q) = w1; }
            }
        }
        if (kvh == 0) {
            const int cp = tid & 127, tg = tid >> 7;
            const float w0a = conv_w[2 * cp], w0b = conv_w[2 * cp + 1], w1a = conv_w[256 + 2 * cp], w1b = conv_w[256 + 2 * cp + 1], w2a = conv_w[512 + 2 * cp], w2b = conv_w[512 + 2 * cp + 1];
            const int s0 = qb * 128 + tg * 32;
            float upa = 0.f, upb = 0.f, uca, ucb;
            { const bf16* zr = z + (size_t)(tok0 + s0) * INW;
              const unsigned cx = *(const GAS unsigned*)(zr + OCX + 2 * cp), cc = *(const GAS unsigned*)(zr + OCC + 2 * cp);
              uca = bf2f((unsigned short)(cx & 0xffffu)) * bf2f((unsigned short)(cc & 0xffffu)); ucb = bf2f((unsigned short)(cx >> 16)) * bf2f((unsigned short)(cc >> 16));
              if (s0 > 0) { const bf16* zp = zr - INW; const unsigned px = *(const GAS unsigned*)(zp + OCX + 2 * cp), pc = *(const GAS unsigned*)(zp + OCC + 2 * cp);
                  upa = bf2f((unsigned short)(px & 0xffffu)) * bf2f((unsigned short)(pc & 0xffffu)); upb = bf2f((unsigned short)(px >> 16)) * bf2f((unsigned short)(pc >> 16)); } }
            for (int i = 0; i < 32; ++i) { const int s = s0 + i; const bf16* zr = z + (size_t)(tok0 + s) * INW;
                float una = 0.f, unb = 0.f;
                if (s + 1 < S) { const unsigned nx = *(const GAS unsigned*)(zr + INW + OCX + 2 * cp), nc = *(const GAS unsigned*)(zr + INW + OCC + 2 * cp);
                    una = bf2f((unsigned short)(nx & 0xffffu)) * bf2f((unsigned short)(nc & 0xffffu)); unb = bf2f((unsigned short)(nx >> 16)) * bf2f((unsigned short)(nc >> 16)); }
                const unsigned cb = *(const GAS unsigned*)(zr + OCB + 2 * cp);
                const float oa = bf2f((unsigned short)(cb & 0xffffu)) * (w0a * upa + w1a * uca + w2a * una), ob = bf2f((unsigned short)(cb >> 16)) * (w0b * upb + w1b * ucb + w2b * unb);
                *(GAS unsigned*)(mix + (size_t)(tok0 + s) * D + 512 + 2 * cp) = pk2(oa, ob);
                upa = uca; upb = ucb; uca = una; ucb = unb; }
        }
#pragma unroll 1
        for (int gi = 0; gi < 2; ++gi) {
            const int gq = kvh * 2 + gi, half = 1 << gq;
            __syncthreads();
            { const int tt = tid >> 2, cq = tid & 3, s = qb * 128 + tt;
              int lo = s - half, hi2 = s + half; lo = lo < 0 ? 0 : lo; hi2 = hi2 > S ? S : hi2;
              float acc[16];
#pragma unroll
              for (int j = 0; j < 16; ++j) acc[j] = 0.f;
              for (int ss = lo; ss < hi2; ++ss) { const bf16* zp = z + (size_t)(tok0 + ss) * INW + OPX + gq * 64 + cq * 16;
                  const v4u w0 = *(const GAS v4u*)zp, w1 = *(const GAS v4u*)(zp + 8); const unsigned ww[8] = {w0.x, w0.y, w0.z, w0.w, w1.x, w1.y, w1.z, w1.w};
#pragma unroll
                  for (int q = 0; q < 8; ++q) { acc[2 * q] += __builtin_bit_cast(float, ww[q] << 16); acc[2 * q + 1] += __builtin_bit_cast(float, ww[q] & 0xffff0000u); } }
              const float icnt = 1.0f / (float)(hi2 - lo);
              const bf16* zc = z + (size_t)(tok0 + s) * INW + OPX + gq * 64 + cq * 16;
              const v4u w0 = *(const GAS v4u*)zc, w1 = *(const GAS v4u*)(zc + 8); const unsigned ww[8] = {w0.x, w0.y, w0.z, w0.w, w1.x, w1.y, w1.z, w1.w};
              LAS float* pr = (LAS float*)(lds + P_OFF) + tt * PROW + cq * 16;
#pragma unroll
              for (int q = 0; q < 8; ++q) { pr[2 * q] = acc[2 * q] * icnt - __builtin_bit_cast(float, ww[q] << 16); pr[2 * q + 1] = acc[2 * q + 1] * icnt - __builtin_bit_cast(float, ww[q] & 0xffff0000u); } }
            __syncthreads();
            { const int e = tid & 63, tq8 = tid >> 6;
              float acc[16];
#pragma unroll
              for (int j = 0; j < 16; ++j) acc[j] = 0.f;
              const float* pw = pool_w + (size_t)gq * 64 * 64 + e;
              for (int c4 = 0; c4 < 16; ++c4) { const float wa = pw[(4 * c4) * 64], wb = pw[(4 * c4 + 1) * 64], wc = pw[(4 * c4 + 2) * 64], wd = pw[(4 * c4 + 3) * 64];
#pragma unroll
                  for (int tt = 0; tt < 16; ++tt) { const f32x4 pv = *(const LAS f32x4*)((LAS float*)(lds + P_OFF) + (tq8 * 16 + tt) * PROW + 4 * c4);
                      acc[tt] += pv.x * wa + pv.y * wb + pv.z * wc + pv.w * wd; } }
              const float sc = pool_scale[gq * 64 + e];
#pragma unroll
              for (int tt = 0; tt < 16; ++tt) mix[(size_t)(tok0 + qb * 128 + tq8 * 16 + tt) * D + 768 + gq * 64 + e] = (bf16)f2bf(acc[tt] * sc); }
        }
    }
}
}


namespace mk {
typedef __bf16 bf16x2_t __attribute__((ext_vector_type(2)));
__device__ __forceinline__ float dot2bf(unsigned a, unsigned b, float c) { return __builtin_amdgcn_fdot2_f32_bf16(__builtin_bit_cast(bf16x2_t, a), __builtin_bit_cast(bf16x2_t, b), c, false); }
__device__ __forceinline__ float gelu_erf(float x) { return 0.5f * x * (1.0f + erff(x * 0.70710678118654752f)); }

template <int L> __device__ __forceinline__ void ph_peer(const Args& args) {
    const int lane = threadIdx.x & 63, wave = __builtin_amdgcn_readfirstlane(threadIdx.x >> 6);
    unsigned char* ws = args.ws;
    const bf16* Ub = (const bf16*)(ws + WS_U) + (size_t)L * NE * D; const bf16* Vb = (const bf16*)(ws + WS_V) + (size_t)L * NE * D;
    const bf16* Hb = (const bf16*)(ws + WS_H); const float* X1 = (const float*)(ws + WS_X1);
    const int* eidx = (const int*)(ws + WS_EIDX); const float* gate = (const float*)(ws + WS_GATE);
    const float* mod = (const float*)(ws + WS_MOD);
    float* outp = args.out;
    const int b5 = (lane >> 5) & 1, b4 = (lane >> 4) & 1, b3 = (lane >> 3) & 1, jl = 4 * b5 + 2 * b4 + b3;
    const int gw = MK_GW(wave), NGW = MK_NGW;
#pragma unroll 1
    for (int t = gw; t < T; t += NGW) {
        const v4u h0 = *(const GAS v4u*)(Hb + (size_t)t * D + 8 * lane), h1 = *(const GAS v4u*)(Hb + (size_t)t * D + 512 + 8 * lane);
        const unsigned hw[8] = {h0.x, h0.y, h0.z, h0.w, h1.x, h1.y, h1.z, h1.w};
        const int e0 = eidx[(size_t)t * 128 + lane], e1 = eidx[(size_t)t * 128 + 64 + lane];
        const float g0 = gate[(size_t)t * 128 + lane], g1 = gate[(size_t)t * 128 + 64 + lane];
        float y[16];
#pragma unroll
        for (int i = 0; i < 16; ++i) y[i] = 0.f;
#pragma unroll 1
        for (int bt = 0; bt < 16; ++bt) {
            const int ev = (bt < 8) ? e0 : e1; const float gv = (bt < 8) ? g0 : g1; const int lbase = (bt & 7) * 8;
            v4u ua[8][2], va[8][2];
#pragma unroll
            for (int j = 0; j < 8; ++j) { const int ek = __builtin_amdgcn_readlane(ev, lbase + j);
                const bf16* ur = Ub + (size_t)ek * D + 8 * lane; const bf16* vr = Vb + (size_t)ek * D + 8 * lane;
                ua[j][0] = *(const GAS v4u*)ur; ua[j][1] = *(const GAS v4u*)(ur + 512);
                va[j][0] = *(const GAS v4u*)vr; va[j][1] = *(const GAS v4u*)(vr + 512); }
            float p[8];
#pragma unroll
            for (int j = 0; j < 8; ++j) { float s = 0.f;
                s = dot2bf(ua[j][0].x, hw[0], s); s = dot2bf(ua[j][0].y, hw[1], s); s = dot2bf(ua[j][0].z, hw[2], s); s = dot2bf(ua[j][0].w, hw[3], s);
                s = dot2bf(ua[j][1].x, hw[4], s); s = dot2bf(ua[j][1].y, hw[5], s); s = dot2bf(ua[j][1].z, hw[6], s); s = dot2bf(ua[j][1].w, hw[7], s);
                p[j] = s; }
            float q[4], r2[2], sd;
#pragma unroll
            for (int i = 0; i < 4; ++i) { const float snd = b5 ? p[i] : p[i + 4]; const float rcv = __shfl_xor(snd, 32); q[i] = (b5 ? p[i + 4] : p[i]) + rcv; }
#pragma unroll
            for (int i = 0; i < 2; ++i) { const float snd = b4 ? q[i] : q[i + 2]; const float rcv = __shfl_xor(snd, 16); r2[i] = (b4 ? q[i + 2] : q[i]) + rcv; }
            { const float snd = b3 ? r2[0] : r2[1]; const float rcv = __shfl_xor(snd, 8); sd = (b3 ? r2[1] : r2[0]) + rcv; }
            sd += __shfl_xor(sd, 4); sd += __shfl_xor(sd, 2); sd += __shfl_xor(sd, 1);
            const float gk = __shfl(gv, lbase + jl);
            const float w = gk * gelu_erf(sd);
#pragma unroll
            for (int j = 0; j < 8; ++j) { const float wj = __builtin_bit_cast(float, __builtin_amdgcn_readlane(__builtin_bit_cast(int, w), 32 * (j >> 2) + 16 * ((j >> 1) & 1) + 8 * (j & 1)));
                const unsigned vw[8] = {va[j][0].x, va[j][0].y, va[j][0].z, va[j][0].w, va[j][1].x, va[j][1].y, va[j][1].z, va[j][1].w};
#pragma unroll
                for (int qd = 0; qd < 8; ++qd) { y[2 * qd] += wj * __builtin_bit_cast(float, vw[qd] << 16); y[2 * qd + 1] += wj * __builtin_bit_cast(float, vw[qd] & 0xffff0000u); } }
        }
        const float* g2 = mod + ((size_t)L * B + t / S) * 6 * D + 5 * D;
        float xo[16]; float ssq = 0.f;
#pragma unroll
        for (int pc = 0; pc < 2; ++pc)
#pragma unroll
            for (int hf = 0; hf < 2; ++hf) { const int col = pc * 512 + 8 * lane + 4 * hf;
                const f32x4 xv = *(const GAS f32x4*)(X1 + (size_t)t * D + col), gg = *(const f32x4*)(g2 + col);
                f32x4 o; o.x = xv.x + gg.x * y[pc * 8 + hf * 4 + 0]; o.y = xv.y + gg.y * y[pc * 8 + hf * 4 + 1]; o.z = xv.z + gg.z * y[pc * 8 + hf * 4 + 2]; o.w = xv.w + gg.w * y[pc * 8 + hf * 4 + 3];
                *(GAS f32x4*)(outp + (size_t)t * D + col) = o;
                xo[pc * 8 + hf * 4 + 0] = o.x; xo[pc * 8 + hf * 4 + 1] = o.y; xo[pc * 8 + hf * 4 + 2] = o.z; xo[pc * 8 + hf * 4 + 3] = o.w;
                ssq += (o.x * o.x + o.y * o.y) + (o.z * o.z + o.w * o.w); }
        if (L + 1 < DEPTH) {
            const float rstd = 1.0f / sqrtf(wave_sum(ssq) * (1.f / D) + EPS);
            const float* g = args.in[3] + (L + 1) * D; const float* mb = mod + ((size_t)(L + 1) * B + t / S) * 6 * D;
#pragma unroll
            for (int pc = 0; pc < 2; ++pc) { const int col = pc * 512 + 8 * lane; float hv[8];
#pragma unroll
                for (int hf = 0; hf < 2; ++hf) { const f32x4 gg = *(const f32x4*)(g + col + 4 * hf), sh = *(const f32x4*)(mb + col + 4 * hf), sc = *(const f32x4*)(mb + D + col + 4 * hf);
                    hv[4 * hf + 0] = xo[pc * 8 + 4 * hf + 0] * rstd * gg.x * (1.0f + sc.x) + sh.x; hv[4 * hf + 1] = xo[pc * 8 + 4 * hf + 1] * rstd * gg.y * (1.0f + sc.y) + sh.y;
                    hv[4 * hf + 2] = xo[pc * 8 + 4 * hf + 2] * rstd * gg.z * (1.0f + sc.z) + sh.z; hv[4 * hf + 3] = xo[pc * 8 + 4 * hf + 3] * rstd * gg.w * (1.0f + sc.w) + sh.w; }
                v4u o; o.x = pk2(hv[0], hv[1]); o.y = pk2(hv[2], hv[3]); o.z = pk2(hv[4], hv[5]); o.w = pk2(hv[6], hv[7]);
                *(GAS v4u*)((bf16*)(ws + WS_H) + (size_t)t * D + col) = o; }
        }
    }
}
}


namespace mk {
constexpr int LDS_XB_OFF = LDS_BYTES - 64;
template <int L> __device__ __forceinline__ void layer_phases(const Args& args, LAS unsigned char* lds, const XcdBarrier& bar) {
    const int lo = args.ph_lo, hi = args.ph_hi;
#define IN(k) (lo <= (k) && (k) < hi)
#define SEAM(k) do { if (IN(k) && IN((k) + 1)) xcd_barrier(bar); } while (0)
    constexpr int pb = PH_L0 + L * PH_PER_LAYER;
    if (IN(pb + PH_G1)) ph_g1<L>(args, lds);
    SEAM(pb + PH_G1);
    if (IN(pb + PH_AT)) ph_mixer<L>(args, lds);
    SEAM(pb + PH_AT);
    if (IN(pb + PH_G2)) ph_g2<L>(args, lds);
    SEAM(pb + PH_G2);
    if (IN(pb + PH_N2)) ph_hmod<L, 1>(args);
    SEAM(pb + PH_N2);
    if (IN(pb + PH_G3)) ph_g3<L>(args, lds);
    SEAM(pb + PH_G3);
    if (IN(pb + PH_TK)) ph_topk<L>(args, lds);
    SEAM(pb + PH_TK);
    if (IN(pb + PH_PE)) ph_peer<L>(args);
    if (L + 1 < DEPTH) SEAM(pb + PH_PE);
#undef SEAM
#undef IN
}

__global__ void __launch_bounds__(NT, 2) mk_fwd(Args args) {
    extern __shared__ __attribute__((aligned(16))) unsigned char lds_raw[];
    LAS unsigned char* lds = (LAS unsigned char*)lds_raw;
    const int lo = args.ph_lo, hi = args.ph_hi;
    if (threadIdx.x < 16) ((LAS unsigned*)(lds + LDS_XB_OFF))[threadIdx.x] = 0u;
    __syncthreads();
    XcdBarrier bar; bar.bar = (unsigned*)(args.ws + WS_CTL) + CW_BAR; bar.x = 0; bar.st = nullptr;
    if (hi - lo > 1) bar = xcd_barrier_post((unsigned*)(args.ws + WS_CTL) + CW_BAR, (volatile LAS unsigned*)(lds + LDS_XB_OFF));
#define IN(k) (lo <= (k) && (k) < hi)
#define SEAM(k) do { if (IN(k) && IN((k) + 1)) xcd_barrier(bar); } while (0)
    if (IN(PH_PRO)) ph_prologue(args, lds);
    SEAM(PH_PRO);
    if (IN(PH_H0)) ph_hmod<0, 0>(args);
    SEAM(PH_H0);
    layer_phases<0>(args, lds, bar);
    layer_phases<1>(args, lds, bar);
#undef SEAM
#undef IN
}
}


extern "C" void kernel_launch(void* const* d_in, const int* in_sizes, int n_in, void* d_out, int out_size, void* d_ws, size_t ws_size, hipStream_t stream) {
    using namespace mk;
    static int grid = 0;
    if (grid == 0) {
        if (n_in != 19 || ws_size < WS_END || out_size != T * D) { fprintf(stderr, "kernel_launch: bad n_in %d / out_size %d / ws_size %zu\n", n_in, out_size, ws_size); grid = -1; return; }
        int dev = 0, cus = 0, per_cu = 0;
        if (hipGetDevice(&dev) != hipSuccess || hipDeviceGetAttribute(&cus, hipDeviceAttributeMultiprocessorCount, dev) != hipSuccess) { grid = -1; return; }
        if (hipFuncSetAttribute((const void*)mk_fwd, hipFuncAttributeMaxDynamicSharedMemorySize, LDS_BYTES) != hipSuccess) { fprintf(stderr, "hipFuncSetAttribute failed\n"); grid = -1; return; }
        if (hipOccupancyMaxActiveBlocksPerMultiprocessor(&per_cu, (const void*)mk_fwd, NT, LDS_BYTES) != hipSuccess) per_cu = 0;
        (void)hipGetLastError();
        grid = (per_cu >= 1) ? cus : -1;
        if (grid < 0) { fprintf(stderr, "kernel_launch: occupancy query says %d workgroups per CU; nothing launched\n", per_cu); return; }
    }
    if (grid < 0) return;
    unsigned char* ws = (unsigned char*)d_ws;
    (void)hipMemsetAsync(ws + WS_CTL, 0, CTL_ZERO_BYTES, stream);
    Args a{};
    for (int i = 0; i < 19; ++i) a.in[i] = (const float*)d_in[i];
    a.out = (float*)d_out; a.ws = ws;
#if MK_SPLIT
    for (int ph = 0; ph < PH_END; ++ph) { a.ph_lo = ph; a.ph_hi = ph + 1; hipLaunchKernelGGL(mk_fwd, dim3(grid), dim3(NT), LDS_BYTES, stream, a); }
#else
    a.ph_lo = 0; a.ph_hi = PH_END;
    hipLaunchKernelGGL(mk_fwd, dim3(grid), dim3(NT), LDS_BYTES, stream, a);
#endif
}
```

```cpp
#include <hip/hip_runtime.h>
#include <stdint.h>
#include <math.h>
#include <cstdio>

#ifndef BATCH
#define BATCH 8
#endif
#ifndef SEQ
#define SEQ 2048
#endif
#ifndef MK_SPLIT
#define MK_SPLIT 0
#endif
#define Z_F32 0
#define QP_F32 0
#define DO_UV 1

namespace cfg {
constexpr int B = BATCH, S = SEQ, T = B * S, D = 1024, DEPTH = 2;
constexpr int HDIM = 64, NQH = 8, NKVH = 2, GRP = 4, WIN = 128;
constexpr int INW = 1792, OQ = 0, OK_ = 512, OV = 640, OCX = 768, OCB = 1024, OCC = 1280, OPX = 1536;
constexpr int PH = 8, NK = 128, NE = 16384, QD = 256, TOPK = 16, PW = 2048;
constexpr float EPS = 1e-6f;
}
using namespace cfg;

namespace pg8 {
#define PG8_LAS __attribute__((address_space(3)))
typedef unsigned short bf16_t;
typedef short bf16x8 __attribute__((ext_vector_type(8)));
typedef float f32x4 __attribute__((ext_vector_type(4)));
typedef unsigned u32x4 __attribute__((ext_vector_type(4)));
constexpr int BM = 256, BK = 64, HALF = 128, HTB = HALF * BK * 2  , STAGE_BYTES = 8 * HTB, NXCD = 8, WGM = 8;

__host__ __device__ __forceinline__ int lds_byte(int r, int c) { const int st = (r >> 4) * 2 + (c >> 5), rr = r & 15, cc = c & 31, ob = rr * 64 + cc * 2; return st * 1024 + (ob ^ (((ob >> 9) & 1) << 5)); }
__host__ __device__ __forceinline__ void stage_rc(int b, int& R, int& C) { const int st = b / 1024, sb = b % 1024, swz = sb ^ (((sb >> 9) & 1) << 5); R = (st >> 1) * 16 + swz / 64; C = (st & 1) * 32 + (swz % 64) / 2; }
__host__ __device__ __forceinline__ int perm32(int rho) { const int n = rho >> 4, i = rho & 15; return 8 * (i >> 2) + 4 * n + (i & 3); }

struct Unit { int pm, pn; };
struct Gemm { const bf16_t* A; const bf16_t* Bt; int M, N, K; };

struct StaticOrder {
    int nM, nN, nwg, G, c;
    __host__ __device__ void init(int M, int N, int G_, int c_) { nM = M / BM; nN = N / BM; nwg = nM * nN; G = G_; c = c_; }
    __host__ __device__ bool next(int i, Unit& u) const {
        const long L = (long)i * G + c; if (L >= nwg) return false;
        int wgid = (int)L; { const int q = nwg / NXCD, r = nwg % NXCD, xcd = wgid % NXCD, off = wgid / NXCD; wgid = (xcd < r ? xcd * (q + 1) : r * (q + 1) + (xcd - r) * q) + off; }
        const int nig = WGM * nN, gid = wgid / nig, fm = gid * WGM, gsz = (nM - fm) < WGM ? (nM - fm) : WGM;
        u.pm = fm + ((wgid % nig) % gsz); u.pn = (wgid % nig) / gsz; return true;
    }
    __device__ __forceinline__ void a_ready(const Unit&) const {}
    __device__ __forceinline__ void done(const Unit&) const {}
};

__device__ __forceinline__ unsigned cvt_pk_bf16(float lo, float hi) { unsigned r; asm volatile("v_cvt_pk_bf16_f32 %0, %1, %2" : "=v"(r) : "v"(lo), "v"(hi)); return r; }
typedef float f32x2 __attribute__((ext_vector_type(2)));
__device__ __forceinline__ f32x2 gelu_pk(f32x2 v) {
    const f32x2 av = __builtin_elementwise_abs(v), d = av * 0.2316418882f + 1.0f;
    f32x2 t; t.x = __builtin_amdgcn_rcpf(d.x); t.y = __builtin_amdgcn_rcpf(d.y);
    f32x2 q = t * 0.5307027145f + (-0.7265760135f); q = q * t + 0.7107068705f; q = q * t + (-0.142248368f); q = q * t + 0.127414796f; q = q * t;
    const f32x2 s = (v * v) * (-0.72134752044f);
    f32x2 e; e.x = __builtin_amdgcn_exp2f(s.x); e.y = __builtin_amdgcn_exp2f(s.y);
    const f32x2 m = v * (q * e), r = v - m;
    f32x2 o; o.x = v.x < 0.f ? m.x : r.x; o.y = v.y < 0.f ? m.y : r.y; return o;
}

template <int ACT  > struct EpiBf16 {
    static constexpr bool PERM = true, AFTER_DRAIN = false; static_assert(ACT == 0 || ACT == 1, "EpiBf16: ACT is 0 (none) or 1 (gelu_pk)");
    bf16_t* O; int ldc; const float* bias; int split_cols; size_t split_stride; float scale0;
    __device__ __forceinline__ void operator()(const f32x4 (&acc)[2][2][4][2], const Unit& u, int wr, int wc, int fr, int fq) const {
        const int row0 = u.pm * BM + wr * 64 + fr; int colt = u.pn * BM; bf16_t* base = O;
        float sc = 1.f; if (split_cols) { const int t = colt / split_cols; base += (size_t)t * split_stride; colt -= t * split_cols; if (t == 0) sc = scale0; }
        const int col0 = colt + wc * 32 + 8 * fq, bcol0 = u.pn * BM + wc * 32 + 8 * fq;
        f32x4 bv[2][2];
#pragma unroll
        for (int bj = 0; bj < 2; ++bj)
#pragma unroll
            for (int n = 0; n < 2; ++n) bv[bj][n] = bias ? *(const f32x4*)(bias + bcol0 + bj * HALF + 4 * n) : (f32x4){0.f, 0.f, 0.f, 0.f};
#pragma unroll
        for (int ai = 0; ai < 2; ++ai)
#pragma unroll
            for (int m = 0; m < 4; ++m) { bf16_t* rowp = base + (size_t)(row0 + ai * HALF + m * 16) * ldc + col0;
#pragma unroll
                for (int bj = 0; bj < 2; ++bj) { f32x4 v0 = acc[ai][bj][m][0] + bv[bj][0], v1 = acc[ai][bj][m][1] + bv[bj][1];
                    if (ACT == 1) { f32x2 a = gelu_pk((f32x2){v0[0], v0[1]}), b = gelu_pk((f32x2){v0[2], v0[3]}), c = gelu_pk((f32x2){v1[0], v1[1]}), d = gelu_pk((f32x2){v1[2], v1[3]});
                        v0 = (f32x4){a.x, a.y, b.x, b.y}; v1 = (f32x4){c.x, c.y, d.x, d.y}; }
                    v0 = v0 * sc; v1 = v1 * sc; u32x4 w; w.x = cvt_pk_bf16(v0[0], v0[1]); w.y = cvt_pk_bf16(v0[2], v0[3]); w.z = cvt_pk_bf16(v1[0], v1[1]); w.w = cvt_pk_bf16(v1[2], v1[3]);
                    *(u32x4*)(rowp + bj * HALF) = w; } }
    }
};

template <class Epi, class Sched, bool ALIGN_EPI = false, bool SP2 = false>
__device__ __forceinline__ void gemm_phase(PG8_LAS unsigned char* lds, const Gemm g, const Sched& S, const Epi& E) {
    const int tid = threadIdx.x, wid = __builtin_amdgcn_readfirstlane(tid >> 6), lane = tid & 63, wr = wid >> 2, wc = wid & 3, fr = lane & 15, fq = lane >> 4;
    const int K = g.K, nt = K / BK;
    unsigned voffA[2], voffB[2];
#pragma unroll
    for (int i = 0; i < 2; ++i) { int R, C; stage_rc(tid * 16 + i * 8192, R, C); const int Rb = Epi::PERM ? ((R & ~31) + perm32(R & 31)) : R;
        voffA[i] = (unsigned)(R * K + C) * 2u; voffB[i] = (unsigned)(Rb * K + C) * 2u; }
    const size_t kstep = (size_t)(BK * 2);
    const size_t hstep = (size_t)HALF * K * 2;
    const size_t tstep = 2 * hstep;
    const unsigned ldsw = (unsigned)wid * 1024u;
    const int aoff = lds_byte(wr * 64 + fr, fq * 8), boff = lds_byte(wc * 32 + fr, fq * 8);
#define PG8_SA(b, h) (((b) * 2 + (h)) * HTB)
#define PG8_SB(b, h) ((4 + (b) * 2 + (h)) * HTB)
#define PG8_STAGE(bufoff, gbase, voff) do { _Pragma("unroll") for (int _i = 0; _i < 2; ++_i) \
        __builtin_amdgcn_global_load_lds((const unsigned*)((const char*)(gbase) + (voff)[_i]), (PG8_LAS unsigned*)(lds + (bufoff) + ldsw + _i * 8192), 16, 0, 0); } while (0)
#define PG8_LDA(dst, b, h) do { _Pragma("unroll") for (int m = 0; m < 4; ++m) _Pragma("unroll") for (int k = 0; k < 2; ++k) dst[m][k] = *(const PG8_LAS bf16x8*)(lds + PG8_SA(b, h) + aoff + m * 2048 + k * 1024); } while (0)
#define PG8_LDB(dst, b, h) do { _Pragma("unroll") for (int n = 0; n < 2; ++n) _Pragma("unroll") for (int k = 0; k < 2; ++k) dst[n][k] = *(const PG8_LAS bf16x8*)(lds + PG8_SB(b, h) + boff + n * 2048 + k * 1024); } while (0)
#define PG8_MMA(ai, bj, At, Bt) do { __builtin_amdgcn_s_setprio(1); _Pragma("unroll") for (int m = 0; m < 4; ++m) _Pragma("unroll") for (int n = 0; n < 2; ++n) _Pragma("unroll") for (int k = 0; k < 2; ++k) \
        acc[ai][bj][m][n] = __builtin_amdgcn_mfma_f32_16x16x32_bf16(Bt[n][k], At[m][k], acc[ai][bj][m][n], 0, 0, 0); __builtin_amdgcn_s_setprio(0); } while (0)
#define PG8_WAIT_V(n) asm volatile("s_waitcnt vmcnt(" #n ")" ::: "memory")
#define PG8_WAIT_L(n) asm volatile("s_waitcnt lgkmcnt(" #n ")" ::: "memory")
#define PG8_BAR __builtin_amdgcn_s_barrier()
#define PG8_SCHED __builtin_amdgcn_sched_barrier(0)
    Unit cur, nxt; int ui = 0;
    if (!S.next(0, cur)) return;
    f32x4 acc[2][2][4][2];
#pragma unroll
    for (int a = 0; a < 2; ++a)
#pragma unroll
        for (int b = 0; b < 2; ++b)
#pragma unroll
            for (int m = 0; m < 4; ++m)
#pragma unroll
                for (int n = 0; n < 2; ++n) acc[a][b][m][n] = (f32x4){0.f, 0.f, 0.f, 0.f};
    bf16x8 At[4][2], B0[2][2], B1[2][2];
    const char* cA = (const char*)g.A + (size_t)cur.pm * tstep; const char* cB = (const char*)g.Bt + (size_t)cur.pn * tstep;
    S.a_ready(cur);
    if constexpr (SP2) {
        PG8_STAGE(PG8_SB(0, 0), cB, voffB); PG8_STAGE(PG8_SB(0, 1), cB + hstep, voffB); PG8_STAGE(PG8_SA(0, 0), cA, voffA); PG8_STAGE(PG8_SA(0, 1), cA + hstep, voffA);
        if (wr == 1) PG8_BAR;
        PG8_WAIT_V(2); PG8_BAR;
        PG8_STAGE(PG8_SB(1, 0), cB + kstep, voffB); PG8_STAGE(PG8_SA(1, 0), cA + kstep, voffA); PG8_STAGE(PG8_SB(1, 1), cB + hstep + kstep, voffB);
        PG8_WAIT_V(6); PG8_BAR;
    } else {
        PG8_STAGE(PG8_SB(0, 0), cB, voffB); PG8_STAGE(PG8_SA(0, 0), cA, voffA); PG8_STAGE(PG8_SB(0, 1), cB + hstep, voffB); PG8_STAGE(PG8_SA(0, 1), cA + hstep, voffA);
        if (wr == 1) PG8_BAR;
        PG8_WAIT_V(4); PG8_BAR;
        PG8_STAGE(PG8_SB(1, 0), cB + kstep, voffB); PG8_STAGE(PG8_SA(1, 0), cA + kstep, voffA); PG8_STAGE(PG8_SB(1, 1), cB + hstep + kstep, voffB);
        PG8_WAIT_V(6); PG8_BAR;
    }
    for (;;) {
        const bool has_next = S.next(ui + 1, nxt);
        const char* nA = has_next ? (const char*)g.A + (size_t)nxt.pm * tstep : cA; const char* nB = has_next ? (const char*)g.Bt + (size_t)nxt.pn * tstep : cB;
        for (int t = 0; t < nt; t += 2) {
            const bool last = (t == nt - 2);
            const char* a1 = cA + (size_t)(t + 1) * kstep;
            const char* a2 = last ? nA : cA + (size_t)(t + 2) * kstep; const char* b2 = last ? nB : cB + (size_t)(t + 2) * kstep;
            const char* a3 = a2 + kstep; const char* b3 = b2 + kstep;
            if (last && has_next) S.a_ready(nxt);
            if constexpr (SP2) {
            PG8_LDB(B0, 0, 0); PG8_LDB(B1, 0, 1); PG8_SCHED; PG8_LDA(At, 0, 0); PG8_STAGE(PG8_SA(1, 1), a1 + hstep, voffA);
            PG8_WAIT_V(8); PG8_WAIT_L(0); PG8_BAR; PG8_MMA(0, 0, At, B0); PG8_MMA(0, 1, At, B1); PG8_BAR; PG8_SCHED;
            PG8_LDA(At, 0, 1); PG8_STAGE(PG8_SB(0, 0), b2, voffB); PG8_STAGE(PG8_SB(0, 1), b2 + hstep, voffB); PG8_STAGE(PG8_SA(0, 0), a2, voffA);
            PG8_WAIT_V(8); PG8_WAIT_L(0); PG8_BAR; PG8_MMA(1, 0, At, B0); PG8_MMA(1, 1, At, B1); PG8_BAR; PG8_SCHED;
            PG8_LDB(B0, 1, 0); PG8_LDB(B1, 1, 1); PG8_SCHED; PG8_LDA(At, 1, 0); PG8_STAGE(PG8_SA(0, 1), a2 + hstep, voffA);
            PG8_WAIT_V(8); PG8_WAIT_L(0); PG8_BAR; PG8_MMA(0, 0, At, B0); PG8_MMA(0, 1, At, B1); PG8_BAR; PG8_SCHED;
            PG8_LDA(At, 1, 1); PG8_STAGE(PG8_SB(1, 0), b3, voffB); PG8_STAGE(PG8_SB(1, 1), b3 + hstep, voffB); PG8_STAGE(PG8_SA(1, 0), a3, voffA);
            PG8_WAIT_V(8); PG8_WAIT_L(0); PG8_BAR; PG8_MMA(1, 0, At, B0); PG8_MMA(1, 1, At, B1); PG8_BAR; PG8_SCHED;
            } else {
            PG8_LDB(B0, 0, 0); PG8_SCHED; PG8_LDA(At, 0, 0); PG8_STAGE(PG8_SA(1, 1), a1 + hstep, voffA);
            PG8_WAIT_L(8); PG8_BAR; PG8_WAIT_L(0); PG8_MMA(0, 0, At, B0); PG8_BAR; PG8_SCHED;
            PG8_LDB(B1, 0, 1); PG8_STAGE(PG8_SB(0, 0), b2, voffB);
            PG8_BAR; PG8_WAIT_L(0); PG8_MMA(0, 1, At, B1); PG8_BAR;
            PG8_LDA(At, 0, 1); PG8_STAGE(PG8_SA(0, 0), a2, voffA);
            PG8_BAR; PG8_WAIT_L(0); PG8_MMA(1, 0, At, B0); PG8_BAR; PG8_SCHED;
            PG8_STAGE(PG8_SB(0, 1), b2 + hstep, voffB);
            PG8_WAIT_V(6); PG8_BAR; PG8_MMA(1, 1, At, B1); PG8_BAR;
            PG8_LDB(B0, 1, 0); PG8_SCHED; PG8_LDA(At, 1, 0); PG8_STAGE(PG8_SA(0, 1), a2 + hstep, voffA);
            PG8_WAIT_L(8); PG8_BAR; PG8_WAIT_L(0); PG8_MMA(0, 0, At, B0); PG8_BAR; PG8_SCHED;
            PG8_LDB(B1, 1, 1); PG8_STAGE(PG8_SB(1, 0), b3, voffB);
            PG8_BAR; PG8_WAIT_L(0); PG8_MMA(0, 1, At, B1); PG8_BAR;
            PG8_LDA(At, 1, 1); PG8_STAGE(PG8_SA(1, 0), a3, voffA);
            PG8_BAR; PG8_WAIT_L(0); PG8_MMA(1, 0, At, B0); PG8_BAR; PG8_SCHED;
            PG8_STAGE(PG8_SB(1, 1), b3 + hstep, voffB);
            PG8_WAIT_V(6); PG8_BAR; PG8_MMA(1, 1, At, B1); PG8_BAR;
            }
        }
        if constexpr (ALIGN_EPI) { if (wr == 0) PG8_BAR; }
        if constexpr (!Epi::AFTER_DRAIN) { E(acc, cur, wr, wc, fr, fq); S.done(cur); }
        if (!has_next) break;
#pragma unroll
        for (int a = 0; a < 2; ++a)
#pragma unroll
            for (int b = 0; b < 2; ++b)
#pragma unroll
                for (int m = 0; m < 4; ++m)
#pragma unroll
                    for (int n = 0; n < 2; ++n) acc[a][b][m][n] = (f32x4){0.f, 0.f, 0.f, 0.f};
        cur = nxt; cA = nA; cB = nB; ++ui;
        if constexpr (ALIGN_EPI) { if (wr == 1) PG8_BAR; }
    }
    PG8_WAIT_V(0);
    if constexpr (!ALIGN_EPI) { if (wr == 0) PG8_BAR; }
    PG8_BAR;
    if constexpr (Epi::AFTER_DRAIN) { E.fused(acc, cur, wr, wc, fr, fq, lds, wid, lane); S.done(cur); }
#undef PG8_SA
#undef PG8_SB
#undef PG8_STAGE
#undef PG8_LDA
#undef PG8_LDB
#undef PG8_MMA
#undef PG8_WAIT_V
#undef PG8_WAIT_L
#undef PG8_BAR
#undef PG8_SCHED
}
}

namespace pg8 {
struct EpiF32 {
    static constexpr bool PERM = false, AFTER_DRAIN = false;
    float* C; int ldc;
    __device__ __forceinline__ void operator()(const f32x4 (&acc)[2][2][4][2], const Unit& u, int wr, int wc, int fr, int fq) const {
        const int row0 = u.pm * BM + wr * 64 + fr, col0 = u.pn * BM + wc * 32 + 4 * fq;
#pragma unroll
        for (int ai = 0; ai < 2; ++ai)
#pragma unroll
            for (int m = 0; m < 4; ++m) { float* rowp = C + (size_t)(row0 + ai * HALF + m * 16) * ldc + col0;
#pragma unroll
                for (int bj = 0; bj < 2; ++bj)
#pragma unroll
                    for (int n = 0; n < 2; ++n) *(f32x4*)(rowp + bj * HALF + n * 16) = acc[ai][bj][m][n]; }
    }
};
struct EpiResid {
    static constexpr bool PERM = false, AFTER_DRAIN = false;
    const float* base; float* out; int ldc; const float* gate0; int rows_per_b; int gstride;
    __device__ __forceinline__ void operator()(const f32x4 (&acc)[2][2][4][2], const Unit& u, int wr, int wc, int fr, int fq) const {
        const int row0 = u.pm * BM + wr * 64 + fr, col0 = u.pn * BM + wc * 32 + 4 * fq;
        const float* gp = gate0 + (size_t)((u.pm * BM) / rows_per_b) * gstride + col0;
        f32x4 gv[2][2];
#pragma unroll
        for (int bj = 0; bj < 2; ++bj)
#pragma unroll
            for (int n = 0; n < 2; ++n) gv[bj][n] = *(const f32x4*)(gp + bj * HALF + n * 16);
#pragma unroll
        for (int ai = 0; ai < 2; ++ai)
#pragma unroll
            for (int m = 0; m < 4; ++m) { const size_t off = (size_t)(row0 + ai * HALF + m * 16) * ldc + col0;
#pragma unroll
                for (int bj = 0; bj < 2; ++bj)
#pragma unroll
                    for (int n = 0; n < 2; ++n) { const f32x4 bs = *(const f32x4*)(base + off + bj * HALF + n * 16);
                        *(f32x4*)(out + off + bj * HALF + n * 16) = bs + gv[bj][n] * acc[ai][bj][m][n]; }
                if (m & 1) asm volatile("" ::: "memory"); }
    }
};
}

namespace mk {
#define GAS __attribute__((address_space(1)))
#define LAS __attribute__((address_space(3)))
typedef unsigned short bf16;
typedef unsigned v4u __attribute__((ext_vector_type(4)));
typedef unsigned v2u __attribute__((ext_vector_type(2)));
typedef float f32x4 __attribute__((ext_vector_type(4)));
#define LDS_WAIT() asm volatile("s_waitcnt lgkmcnt(0)" ::: "memory")
#define VM_WAIT() asm volatile("s_waitcnt vmcnt(0)" ::: "memory")
__device__ __forceinline__ unsigned f2bf(float f) { unsigned u = __builtin_bit_cast(unsigned, f); return (u + 0x7fffu + ((u >> 16) & 1u)) >> 16; }
__device__ __forceinline__ unsigned pk2(float lo, float hi) { return f2bf(lo) | (f2bf(hi) << 16); }
__device__ __forceinline__ float bf2f(unsigned short h) { return __builtin_bit_cast(float, (unsigned)h << 16); }

constexpr int NWAVES = 8, NT = 512;
constexpr int RING_BYTES = 131072, LDSCTL_OFF = RING_BYTES, LDS_BYTES = 147456;
constexpr size_t MiB = 1u << 20;
constexpr size_t WS_CTL = 0, CTL_ZERO_BYTES = 1 * MiB;
constexpr size_t WS_MOD = 1 * MiB, WS_KEYS = 2 * MiB, WS_WIN = 4 * MiB, WS_WOUT = 12 * MiB, WS_WQ = 16 * MiB, WS_H = 24 * MiB, WS_X1 = 56 * MiB;
constexpr size_t WS_EIDX = 120 * MiB, WS_GATE = 128 * MiB, WS_A = 136 * MiB, WS_MIX = 200 * MiB, WS_U = 232 * MiB, WS_V = 264 * MiB, WS_END = 296 * MiB;
constexpr size_t WS_SU = 3 * MiB, WS_SV = 3 * MiB + 512 * 1024;
constexpr size_t WS_T1 = 232 * MiB, WS_T2 = 360 * MiB, WS_TEND = 488 * MiB;
constexpr int CW_BAR = 4096;

enum { PH_PRO = 0, PH_H0 = 1, PH_L0 = 2, PH_PER_LAYER = 7, PH_G1 = 0, PH_AT = 1, PH_G2 = 2, PH_N2 = 3, PH_G3 = 4, PH_TK = 5, PH_PE = 6, PH_END = PH_L0 + 2 * PH_PER_LAYER, PH_H1 = 100 };

struct Args { const float* in[19]; float* out; unsigned char* ws; int ph_lo, ph_hi; };

__device__ __forceinline__ void p0_transpose_item(const float* W, int K, int N, bf16* WT, LAS float* scr, int item, int lane) {
    const int nblk = N / 32, kb = item / nblk, nb = item % nblk, k0 = 64 * kb, n0 = 32 * nb;
#pragma unroll 8
    for (int i = 0; i < 32; ++i) { const int kk = 2 * i + (lane >> 5); scr[kk * 33 + (lane & 31)] = W[(size_t)(k0 + kk) * N + n0 + (lane & 31)]; }
    LDS_WAIT(); asm volatile("" ::: "memory");
    const int c = lane & 7;
#pragma unroll
    for (int j = 0; j < 4; ++j) { const int n = (lane >> 3) + 8 * j; const LAS float* s = scr + (8 * c) * 33 + n;
        v4u o; o.x = pk2(s[0 * 33], s[1 * 33]); o.y = pk2(s[2 * 33], s[3 * 33]); o.z = pk2(s[4 * 33], s[5 * 33]); o.w = pk2(s[6 * 33], s[7 * 33]);
        *(GAS v4u*)(WT + (size_t)(n0 + n) * K + k0 + 8 * c) = o; }
    LDS_WAIT(); asm volatile("" ::: "memory");
}
__device__ __forceinline__ float wave_sum(float v) {
#pragma unroll
    for (int o = 1; o < 64; o <<= 1) v += __shfl_xor(v, o);
    return v;
}
__device__ __forceinline__ void hmod_row(const float* xrow, const float* g, const float* mod_b, int which, bf16* orow, int lane) {
    const GAS f32x4* xr = (const GAS f32x4*)xrow + lane;
    f32x4 v[4]; float s = 0.f;
#pragma unroll
    for (int j = 0; j < 4; ++j) { v[j] = xr[64 * j]; s += (v[j].x * v[j].x + v[j].y * v[j].y) + (v[j].z * v[j].z + v[j].w * v[j].w); }
    const float rstd = 1.0f / sqrtf(wave_sum(s) * (1.f / D) + EPS);
    const float* shp = mod_b + (which * 3 + 0) * D; const float* scp = mod_b + (which * 3 + 1) * D;
    GAS unsigned long long* o8 = (GAS unsigned long long*)orow + lane;
#pragma unroll
    for (int j = 0; j < 4; ++j) { const int k = 4 * lane + 256 * j;
        const f32x4 gg = *(const f32x4*)(g + k), sh = *(const f32x4*)(shp + k), sc = *(const f32x4*)(scp + k);
        const f32x4 hv = v[j] * rstd * gg * (sc + 1.0f) + sh;
        o8[64 * j] = (unsigned long long)pk2(hv.x, hv.y) | ((unsigned long long)pk2(hv.z, hv.w) << 32); }
}


#define MK_GW(wave) (((gridDim.x % 8 == 0) ? (blockIdx.x % 8) * (gridDim.x / 8) + blockIdx.x / 8 : blockIdx.x) * NWAVES + (wave))
#define MK_NGW (gridDim.x * NWAVES)

__device__ __forceinline__ void ph_prologue(const Args& args, LAS unsigned char* lds) {
    const int tid = threadIdx.x, lane = tid & 63, wave = __builtin_amdgcn_readfirstlane(tid >> 6);
    const int G = gridDim.x, bx = blockIdx.x;
    unsigned char* ws = args.ws;
    {
        const float* c = args.in[1]; const float* w_ada = args.in[5]; const float* b_ada = args.in[6]; float* mod = (float*)(ws + WS_MOD);
        LAS float* sact = (LAS float*)lds; LAS float* red = (LAS float*)(lds + 32768);
        for (int i = tid; i < B * D; i += NT) { const float cv = c[i]; sact[i] = cv / (1.0f + __expf(-cv)); }
        __syncthreads();
        for (int item = bx; item < DEPTH * (6 * D / 32); item += G) {
            const int l = item / (6 * D / 32), n0 = (item % (6 * D / 32)) * 32, cc = tid & 31, kg = tid >> 5;
            float acc[B];
#pragma unroll
            for (int b = 0; b < B; ++b) acc[b] = 0.f;
            const float* w = w_ada + (size_t)l * D * 6 * D + n0 + cc;
            for (int kk = 0; kk < 64; ++kk) { const int k = kg * 64 + kk; const float wv = w[(size_t)k * 6 * D];
#pragma unroll
                for (int b = 0; b < B; ++b) acc[b] += sact[b * D + k] * wv; }
#pragma unroll
            for (int b = 0; b < B; ++b) red[(kg * 32 + cc) * B + b] = acc[b];
            __syncthreads();
            if (tid < 32 * B) { const int c2 = tid & 31, b = tid >> 5; float s = 0.f;
                for (int k2 = 0; k2 < 16; ++k2) s += red[(k2 * 32 + c2) * B + b];
                mod[((size_t)l * B + b) * 6 * D + n0 + c2] = s + b_ada[(size_t)l * 6 * D + n0 + c2]; }
            __syncthreads();
        }
    }
    const int gw = MK_GW(wave), NGW = MK_NGW;
    {
        const float* w_in = args.in[7]; const float* w_out = args.in[14]; const float* peer_wq = args.in[15];
        bf16* WinT = (bf16*)(ws + WS_WIN); bf16* WoutT = (bf16*)(ws + WS_WOUT); bf16* WqT = (bf16*)(ws + WS_WQ);
        LAS float* scr = (LAS float*)(lds + wave * 16384);
        constexpr int I_IN = (D / 64) * (INW / 32), I_OUT = (D / 64) * (D / 32), I_Q = (D / 64) * (PW / 32), I_L = I_IN + I_OUT + I_Q;
        for (int it = gw; it < DEPTH * I_L; it += NGW) {
            const int l = it / I_L; int r = it % I_L;
            if (r < I_IN) { p0_transpose_item(w_in + (size_t)l * D * INW, D, INW, WinT + (size_t)l * INW * D, scr, r, lane); continue; } r -= I_IN;
            if (r < I_OUT) { p0_transpose_item(w_out + (size_t)l * D * D, D, D, WoutT + (size_t)l * D * D, scr, r, lane); continue; } r -= I_OUT;
            p0_transpose_item(peer_wq + (size_t)l * D * PW, D, PW, WqT + (size_t)l * PW * D, scr, r, lane);
        }
    }
    {
        const float* peer_keys = args.in[16]; bf16* keysb = (bf16*)(ws + WS_KEYS);
        for (int i = gw * 64 + lane; i < DEPTH * 2 * NK * 128 / 2; i += NGW * 64) ((GAS unsigned*)keysb)[i] = pk2(peer_keys[2 * i], peer_keys[2 * i + 1]);
    }
    {
        const float* peer_u = args.in[17]; const float* peer_v = args.in[18];
        unsigned char* U8 = ws + WS_U; unsigned char* V8 = ws + WS_V; float* SU = (float*)(ws + WS_SU); float* SV = (float*)(ws + WS_SV);
        for (int r = gw; r < 2 * DEPTH * NE; r += NGW) {
            const int tb = r / (DEPTH * NE), row = r % (DEPTH * NE);
            const GAS f32x4* src = (const GAS f32x4*)((tb ? peer_v : peer_u) + (size_t)row * D) + lane;
            f32x4 v[4]; float am = 0.f;
#pragma unroll
            for (int j = 0; j < 4; ++j) { v[j] = src[64 * j]; am = fmaxf(am, fmaxf(fmaxf(fabsf(v[j].x), fabsf(v[j].y)), fmaxf(fabsf(v[j].z), fabsf(v[j].w)))); }
#pragma unroll
            for (int o = 1; o < 64; o <<= 1) am = fmaxf(am, __shfl_xor(am, o));
            const float sc = am > 0.f ? am * (1.0f / 448.0f) : 1.0f, inv = 1.0f / sc;
            GAS unsigned* dst = (GAS unsigned*)((tb ? V8 : U8) + (size_t)row * D) + lane;
#pragma unroll
            for (int j = 0; j < 4; ++j) { int p = 0; p = __builtin_amdgcn_cvt_pk_fp8_f32(v[j].x * inv, v[j].y * inv, p, false); p = __builtin_amdgcn_cvt_pk_fp8_f32(v[j].z * inv, v[j].w * inv, p, true); dst[64 * j] = (unsigned)p; }
            if (lane == 0) (tb ? SV : SU)[row] = sc;
        }
    }
}
template <int L, int WHICH> __device__ __forceinline__ void ph_hmod(const Args& args) {
    const int lane = threadIdx.x & 63, wave = __builtin_amdgcn_readfirstlane(threadIdx.x >> 6);
    unsigned char* ws = args.ws;
    const float* src = WHICH ? (const float*)(ws + WS_X1) : (L == 0 ? args.in[0] : args.out);
    const float* g = args.in[WHICH ? 4 : 3] + L * D; const float* mod_l = (const float*)(ws + WS_MOD) + (size_t)L * B * 6 * D; bf16* Hb = (bf16*)(ws + WS_H);
    const int gw = MK_GW(wave), NGW = MK_NGW;
    for (int m = gw; m < T; m += NGW) hmod_row(src + (size_t)m * D, g, mod_l + (size_t)(m / S) * 6 * D, WHICH, Hb + (size_t)m * D, lane);
}
template <int L> __device__ __forceinline__ void ph_g1(const Args& args, LAS unsigned char* lds) {
    unsigned char* ws = args.ws;
    pg8::Gemm g{(const bf16*)(ws + WS_H), (const bf16*)(ws + WS_WIN) + (size_t)L * INW * D, T, INW, D}; pg8::StaticOrder SO; SO.init(T, INW, gridDim.x, blockIdx.x);
#if Z_F32
    pg8::EpiF32 E{(float*)(ws + WS_T1), INW};
    pg8::gemm_phase<pg8::EpiF32, pg8::StaticOrder, true, true>(lds, g, SO, E);
#else
    pg8::EpiBf16<0> E{(bf16*)(ws + WS_A), INW, nullptr, 0, 0, 1.f};
    pg8::gemm_phase<pg8::EpiBf16<0>, pg8::StaticOrder, true, true>(lds, g, SO, E);
#endif
}
template <int L> __device__ __forceinline__ void ph_g2(const Args& args, LAS unsigned char* lds) {
    unsigned char* ws = args.ws;
    pg8::Gemm g{(const bf16*)(ws + WS_MIX), (const bf16*)(ws + WS_WOUT) + (size_t)L * D * D, T, D, D}; pg8::StaticOrder SO; SO.init(T, D, gridDim.x, blockIdx.x);
    pg8::EpiResid E{L == 0 ? args.in[0] : args.out, (float*)(ws + WS_X1), D, (const float*)(ws + WS_MOD) + (size_t)L * B * 6 * D + 2 * D, S, 6 * D};
    pg8::gemm_phase<pg8::EpiResid, pg8::StaticOrder, true, true>(lds, g, SO, E);
}
template <int L> __device__ __forceinline__ void ph_g3(const Args& args, LAS unsigned char* lds) {
    unsigned char* ws = args.ws;
    pg8::Gemm g{(const bf16*)(ws + WS_H), (const bf16*)(ws + WS_WQ) + (size_t)L * PW * D, T, PW, D}; pg8::StaticOrder SO; SO.init(T, PW, gridDim.x, blockIdx.x);
#if QP_F32
    pg8::EpiF32 E{(float*)(ws + WS_T1), PW};
    pg8::gemm_phase<pg8::EpiF32, pg8::StaticOrder, true, true>(lds, g, SO, E);
#else
    pg8::EpiBf16<0> E{(bf16*)(ws + WS_A), PW, nullptr, 0, 0, 1.f};
    pg8::gemm_phase<pg8::EpiBf16<0>, pg8::StaticOrder, true, true>(lds, g, SO, E);
#endif
}
}

namespace mk {
#define XB_TMO      128
#define XB_XCNT(j)  (256  + 64 * (j))
#define XB_XSUB(j)  (1280 + 64 * (j))
#define XB_XGEN(j)  (2304 + 64 * (j))
#define XB_TOP      3328
#define XB_TOPGEN   3392
#define XCD_BAR_WORDS 3456
#define XB_SPIN_CAP (1u << 18)

__device__ __forceinline__ unsigned xb_ld(unsigned* p)              { return __hip_atomic_load(p, __ATOMIC_RELAXED, __HIP_MEMORY_SCOPE_AGENT); }
__device__ __forceinline__ unsigned xb_add(unsigned* p, unsigned v) { return __hip_atomic_fetch_add(p, v, __ATOMIC_RELAXED, __HIP_MEMORY_SCOPE_AGENT); }
__device__ __forceinline__ unsigned xb_xcc_id() { return (unsigned)__builtin_amdgcn_s_getreg((3 << 11) | 20) & 0xFu; }
#define XB_SPIN(cond, bar) do { unsigned _sp = 0; while (cond) { __builtin_amdgcn_s_sleep(1); \
    if ((++_sp & 255u) == 0u) { if (xb_ld(&(bar)[XB_TMO])) break; if (_sp > XB_SPIN_CAP) { atomicAdd(&(bar)[XB_TMO], 1u); break; } } } } while (0)

struct XcdBarrier {
    unsigned* bar; unsigned x;
    volatile LAS unsigned* st;
};

__device__ __forceinline__ XcdBarrier xcd_barrier_post(unsigned* bar, volatile LAS unsigned* st) {
    XcdBarrier b; b.bar = bar; b.x = xb_xcc_id(); b.st = st;
    if (threadIdx.x == 0) (void)xb_add(&bar[XB_XCNT(b.x)], 1u);
    return b;
}
__device__ __forceinline__ void xcd_barrier_complete(unsigned* bar, unsigned x, unsigned& nloc, unsigned& nx) {
    const unsigned G = gridDim.x * gridDim.y * gridDim.z;
    unsigned sum, cnt, mine, sp = 0u;
    for (;;) {
        sum = 0u; cnt = 0u; mine = 0u;
#pragma unroll
        for (unsigned j = 0; j < 16; ++j) { const unsigned c = xb_ld(&bar[XB_XCNT(j)]); sum += c; cnt += (c > 0u) ? 1u : 0u; mine = (j == x) ? c : mine; }
        if (sum == G) break;
        __builtin_amdgcn_s_sleep(1);
        if ((++sp & 255u) == 0u) { if (xb_ld(&bar[XB_TMO])) break; if (sp > XB_SPIN_CAP) { atomicAdd(&bar[XB_TMO], 1u); break; } }
    }
    nloc = mine > 0u ? mine : 1u; nx = cnt > 0u ? cnt : 1u;
}

__device__ __forceinline__ void xcd_barrier(const XcdBarrier& b) {
    asm volatile("s_waitcnt vmcnt(0)" ::: "memory");
    __syncthreads();
    if (threadIdx.x == 0) {
        unsigned* bar = b.bar;
        __builtin_amdgcn_s_waitcnt(0);
        unsigned nloc = b.st[0], nx = b.st[1];
        if (nloc == 0u) { xcd_barrier_complete(bar, b.x, nloc, nx); b.st[0] = nloc; b.st[1] = nx; }
        const unsigned old = xb_add(&bar[XB_XSUB(b.x)], 1u);
        const unsigned gen = old / nloc;
        if (old + 1u == (gen + 1u) * nloc) {
            __builtin_amdgcn_fence(__ATOMIC_RELEASE, "agent");
            asm volatile("s_waitcnt vmcnt(0)" ::: "memory");
            const unsigned og = xb_add(&bar[XB_TOP], 1u);
            const unsigned tg = og / nx;
            if (og + 1u == (tg + 1u) * nx) xb_add(&bar[XB_TOPGEN], 1u);
            else XB_SPIN(xb_ld(&bar[XB_TOPGEN]) == tg, bar);
            __builtin_amdgcn_fence(__ATOMIC_ACQUIRE, "agent");
            xb_add(&bar[XB_XGEN(b.x)], 1u);
            asm volatile("s_waitcnt vmcnt(0)" ::: "memory");
        } else {
            XB_SPIN(xb_ld(&bar[XB_XGEN(b.x)]) == gen, bar);
            __builtin_amdgcn_fence(__ATOMIC_ACQUIRE, "agent");
            asm volatile("s_waitcnt vmcnt(0)" ::: "memory");
        }
    }
    __syncthreads();
}

}


namespace mk {
typedef short bf16x8 __attribute__((ext_vector_type(8)));
typedef float f32x16 __attribute__((ext_vector_type(16)));
__device__ __forceinline__ unsigned f2sort(float f) { const unsigned u = __builtin_bit_cast(unsigned, f); return u ^ ((unsigned)((int)u >> 31) | 0x80000000u); }
__device__ __forceinline__ float sort2f(unsigned s) { const unsigned m = (unsigned)((int)s >> 31); return __builtin_bit_cast(float, s ^ (~m | 0x80000000u)); }
__device__ __forceinline__ unsigned umax_(unsigned a, unsigned b) { return a > b ? a : b; }
__device__ __forceinline__ unsigned umin_(unsigned a, unsigned b) { return a < b ? a : b; }
__device__ __forceinline__ void sort16_desc(unsigned (&v)[16]) {
#pragma unroll
    for (int k = 2; k <= 16; k <<= 1)
#pragma unroll
        for (int j = k >> 1; j > 0; j >>= 1)
#pragma unroll
            for (int i = 0; i < 16; ++i) { const int l = i ^ j; if (l > i) { const unsigned a = v[i], b = v[l], mx = umax_(a, b), mn = umin_(a, b);
                if ((i & k) == 0) { v[i] = mx; v[l] = mn; } else { v[i] = mn; v[l] = mx; } } }
}
__device__ __forceinline__ void merge16_desc(unsigned (&a)[16], const unsigned (&b)[16]) {
#pragma unroll
    for (int i = 0; i < 16; ++i) a[i] = umax_(a[i], b[15 - i]);
#pragma unroll
    for (int j = 8; j > 0; j >>= 1)
#pragma unroll
        for (int i = 0; i < 16; ++i) { const int l = i ^ j; if (l > i) { const unsigned x = a[i], y = a[l]; a[i] = umax_(x, y); a[l] = umin_(x, y); } }
}
__device__ __forceinline__ void xmerge16_desc(unsigned (&a)[16]) {
    unsigned p[16];
#pragma unroll
    for (int i = 0; i < 16; ++i) p[i] = (unsigned)__shfl_xor((int)a[i], 32);
    merge16_desc(a, p);
}
#define TK_CANDS \
    TKC(0, 0, 0, 2, 1) \
    TKC(1, 0, 1, 2, 2) \
    TKC(2, 0, 2, 2, 3) \
    TKC(3, 0, 3, 2, 4) \
    TKC(4, 0, 4, 3, 0) \
    TKC(5, 0, 5, 3, 1) \
    TKC(6, 0, 6, 3, 2) \
    TKC(7, 0, 7, 3, 3) \
    TKC(8, 0, 8, 4, 0) \
    TKC(9, 0, 9, 4, 1) \
    TKC(10, 0, 10, 4, 2) \
    TKC(11, 0, 11, 5, 0) \
    TKC(12, 0, 12, 5, 1) \
    TKC(13, 0, 13, 6, 0) \
    TKC(14, 0, 14, 6, 1) \
    TKC(15, 0, 15, 7, 0) \
    TKC(16, 1, 0, 7, 1) \
    TKC(17, 1, 1, 8, 0) \
    TKC(18, 1, 2, 9, 0) \
    TKC(19, 1, 3, 10, 0) \
    TKC(20, 1, 4, 11, 0) \
    TKC(21, 1, 5, 12, 0) \
    TKC(22, 1, 6, 13, 0) \
    TKC(23, 1, 7, 14, 0) \
    TKC(24, 2, 0, 15, 0)

template <int L> __device__ __forceinline__ void ph_topk(const Args& args, LAS unsigned char* lds) {
    const int tid = threadIdx.x, lane = tid & 63, wave = __builtin_amdgcn_readfirstlane(tid >> 6);
    const int c = lane & 31, hi = lane >> 5;
    unsigned char* ws = args.ws;
    const bf16* keysb = (const bf16*)(ws + WS_KEYS) + (size_t)L * 2 * NK * 128;
    const bf16* qp = (const bf16*)(ws + WS_A);
    int* eidx = (int*)(ws + WS_EIDX); float* gate = (float*)(ws + WS_GATE);
    constexpr int KROW = 272;
    for (int ch = tid; ch < 256 * 16; ch += NT) { const int r = ch >> 4, cc = ch & 15; *(LAS v4u*)(lds + r * KROW + cc * 16) = *(const GAS v4u*)(keysb + r * 128 + cc * 8); }
    __syncthreads();
    LAS unsigned* wl = (LAS unsigned*)(lds + 256 * KROW + wave * 4096) + c * 32;
    const int gw = MK_GW(wave), NGW = MK_NGW;
    const unsigned h4 = 4u * (unsigned)hi;
    for (int pass = gw; pass < T * PH / 32; pass += NGW) {
        const int row = pass * 32 + c;
        const bf16* qrow = qp + (size_t)row * 256 + hi * 8;
        unsigned top[2][16];
#pragma unroll
        for (int half = 0; half < 2; ++half) {
            bf16x8 bq[8];
#pragma unroll
            for (int ks = 0; ks < 8; ++ks) bq[ks] = *(const GAS bf16x8*)(qrow + half * 128 + ks * 16);
            f32x16 acc[4];
#pragma unroll
            for (int mt = 0; mt < 4; ++mt)
#pragma unroll
                for (int r = 0; r < 16; ++r) acc[mt][r] = 0.f;
#pragma unroll
            for (int ks = 0; ks < 8; ++ks)
#pragma unroll
                for (int mt = 0; mt < 4; ++mt) { const bf16x8 a = *(const LAS bf16x8*)(lds + (half * 128 + mt * 32 + c) * KROW + (ks * 16 + hi * 8) * 2);
                    acc[mt] = __builtin_amdgcn_mfma_f32_32x32x16_bf16(a, bq[ks], acc[mt], 0, 0, 0); }
            unsigned g[4][16];
#pragma unroll
            for (int mt = 0; mt < 4; ++mt)
#pragma unroll
                for (int r = 0; r < 16; ++r) { const unsigned code = (unsigned)(127 - mt * 32 - (r & 3) - 8 * (r >> 2)) - h4;
                    g[mt][r] = (f2sort(acc[mt][r]) & ~127u) | code; }
#pragma unroll
            for (int mt = 0; mt < 4; ++mt) sort16_desc(g[mt]);
            merge16_desc(g[0], g[1]); merge16_desc(g[2], g[3]); merge16_desc(g[0], g[2]);
            xmerge16_desc(g[0]);
#pragma unroll
            for (int i = 0; i < 16; ++i) top[half][i] = g[0][i];
        }
#pragma unroll
        for (int q = 0; q < 4; ++q) { v4u w;
            w.x = hi ? top[1][4 * q + 0] : top[0][4 * q + 0]; w.y = hi ? top[1][4 * q + 1] : top[0][4 * q + 1];
            w.z = hi ? top[1][4 * q + 2] : top[0][4 * q + 2]; w.w = hi ? top[1][4 * q + 3] : top[0][4 * q + 3];
            *(LAS v4u*)(wl + hi * 16 + 4 * q) = w; }
        float v1[16], v2[16];
#pragma unroll
        for (int i = 0; i < 16; ++i) { v1[i] = sort2f(top[0][i] & ~127u); v2[i] = sort2f(top[1][i] & ~127u); }
        unsigned cd[2][16];
#pragma unroll
        for (int i = 0; i < 16; ++i) { cd[0][i] = 0u; cd[1][i] = 0u; }
#define TKC(q, i0, j0, i1, j1) { const float sm = hi ? (v1[i1] + v2[j1]) : (v1[i0] + v2[j0]); const unsigned code = hi ? (unsigned)(255 - ((i1) * 16 + (j1))) : (unsigned)(255 - ((i0) * 16 + (j0))); \
            cd[(q) >> 4][(q) & 15] = (f2sort(sm) & ~255u) | code; }
        TK_CANDS
#undef TKC
        sort16_desc(cd[0]); sort16_desc(cd[1]); merge16_desc(cd[0], cd[1]); xmerge16_desc(cd[0]);
        float ev[16]; int ex[16]; float den = 0.f;
        const float vmax = sort2f(cd[0][0] & ~255u);
#pragma unroll
        for (int r = 0; r < 16; ++r) { const unsigned key = cd[0][r], pos = 255u - (key & 255u);
            const unsigned k1 = wl[pos >> 4], k2 = wl[16 + (pos & 15u)];
            ex[r] = (int)((127u - (k1 & 127u)) * 128u + (127u - (k2 & 127u)));
            ev[r] = __expf(sort2f(key & ~255u) - vmax); den += ev[r]; }
        const float inv = 1.0f / den;
        if (hi == 0) {
#pragma unroll
            for (int q = 0; q < 4; ++q) { v4u w; w.x = (unsigned)ex[4 * q]; w.y = (unsigned)ex[4 * q + 1]; w.z = (unsigned)ex[4 * q + 2]; w.w = (unsigned)ex[4 * q + 3]; *(GAS v4u*)(eidx + (size_t)row * 16 + 4 * q) = w; }
        } else {
#pragma unroll
            for (int q = 0; q < 4; ++q) { f32x4 w; w.x = ev[4 * q] * inv; w.y = ev[4 * q + 1] * inv; w.z = ev[4 * q + 2] * inv; w.w = ev[4 * q + 3] * inv; *(GAS f32x4*)(gate + (size_t)row * 16 + 4 * q) = w; }
        }
    }
}
}


namespace mk {
typedef short bf16x4v __attribute__((ext_vector_type(4)));
__device__ __forceinline__ unsigned cvt_pk_bf16(float lo, float hi) { unsigned r; asm volatile("v_cvt_pk_bf16_f32 %0, %1, %2" : "=v"(r) : "v"(lo), "v"(hi)); return r; }
__device__ __forceinline__ void head_prep(const bf16* src  , const float* g, int h, int pos, float scl, v4u (&outp)[4]) {
    float v[4][8]; float ss = 0.f;
#pragma unroll
    for (int ks = 0; ks < 4; ++ks) { const v4u w = *(const GAS v4u*)(src + ks * 16);
        const unsigned ww[4] = {w.x, w.y, w.z, w.w};
#pragma unroll
        for (int q = 0; q < 4; ++q) { v[ks][2 * q] = __builtin_bit_cast(float, ww[q] << 16); v[ks][2 * q + 1] = __builtin_bit_cast(float, ww[q] & 0xffff0000u); }
#pragma unroll
        for (int j = 0; j < 8; ++j) ss += v[ks][j] * v[ks][j]; }
    ss += __shfl_xor(ss, 32);
    const float r = scl / sqrtf(ss * (1.0f / 64.0f) + EPS);
#pragma unroll
    for (int ks = 0; ks < 4; ++ks) { const f32x4 g0 = *(const f32x4*)(g + ks * 16 + 8 * h), g1 = *(const f32x4*)(g + ks * 16 + 8 * h + 4);
        v[ks][0] *= r * g0.x; v[ks][1] *= r * g0.y; v[ks][2] *= r * g0.z; v[ks][3] *= r * g0.w; v[ks][4] *= r * g1.x; v[ks][5] *= r * g1.y; v[ks][6] *= r * g1.z; v[ks][7] *= r * g1.w; }
#pragma unroll
    for (int i = 0; i < 8; ++i) { const float other = __shfl_xor(v[0][i], 32);
        constexpr float INVF[8] = {1.0f, 0.1939227432012558f, 0.03760603070259094f, 0.007292664609849453f, 0.0014142135623842478f, 0.00027424818836152554f, 5.318296098266728e-05f, 1.0313386155758053e-05f};
        float rev = ((float)pos * INVF[i]) * 0.15915494309189535f; rev -= floorf(rev);
        const float sn = __builtin_amdgcn_sinf(rev), cs = __builtin_amdgcn_cosf(rev);
        v[0][i] = h ? (v[0][i] * cs + other * sn) : (v[0][i] * cs - other * sn); }
#pragma unroll
    for (int ks = 0; ks < 4; ++ks) { outp[ks].x = pk2(v[ks][0], v[ks][1]); outp[ks].y = pk2(v[ks][2], v[ks][3]); outp[ks].z = pk2(v[ks][4], v[ks][5]); outp[ks].w = pk2(v[ks][6], v[ks][7]); }
}

template <int L> __device__ __forceinline__ void ph_mixer(const Args& args, LAS unsigned char* lds) {
    const int tid = threadIdx.x, lane = tid & 63, wave = __builtin_amdgcn_readfirstlane(tid >> 6);
    const int c = lane & 31, hi = lane >> 5;
    unsigned char* ws = args.ws;
    const bf16* z = (const bf16*)(ws + WS_A); bf16* mix = (bf16*)(ws + WS_MIX);
    const int* positions = (const int*)args.in[2];
    const float* qg = args.in[8] + L * 64; const float* kg = args.in[9] + L * 64; const float* sink = args.in[10] + L * NQH;
    const float* conv_w = args.in[11] + L * 3 * 256; const float* pool_w = args.in[12] + (size_t)L * 4 * 64 * 64; const float* pool_scale = args.in[13] + L * 256;
    constexpr int KROW = 144, VROW = 776, K_OFF = 0, V_OFF = 384 * KROW, P_OFF = V_OFF + 64 * VROW, PROW = 68;
    constexpr int NQB = S / 128;
    for (int unit = blockIdx.x; unit < B * NKVH * NQB; unit += gridDim.x) {
        const int qb = unit % NQB, kvh = (unit / NQB) % NKVH, b = unit / (NQB * NKVH);
        const int tok0 = b * S, kbase = qb * 128 - 128;
        __syncthreads();
        for (int pass = wave; pass < 12; pass += NWAVES) { const int kr = pass * 32 + c, kp = kbase + kr;
            if (kp >= 0 && kp < S) {
                v4u o[4]; head_prep(z + (size_t)(tok0 + kp) * INW + OK_ + kvh * 64 + 8 * hi, kg, hi, positions[tok0 + kp], 1.0f, o);
#pragma unroll
                for (int ks = 0; ks < 4; ++ks) *(LAS v4u*)(lds + K_OFF + kr * KROW + (ks * 16 + 8 * hi) * 2) = o[ks]; } }
        for (int ch = tid; ch < 384 * 8; ch += NT) { const int kr = ch >> 3, dc = ch & 7, kp = kbase + kr;
            if (kp >= 0 && kp < S) { const v4u w = *(const GAS v4u*)(z + (size_t)(tok0 + kp) * INW + OV + kvh * 64 + dc * 8);
                const unsigned ww[4] = {w.x, w.y, w.z, w.w};
#pragma unroll
                for (int q = 0; q < 4; ++q) { *(LAS unsigned short*)(lds + V_OFF + (dc * 8 + 2 * q) * VROW + kr * 2) = (unsigned short)(ww[q] & 0xffffu);
                                              *(LAS unsigned short*)(lds + V_OFF + (dc * 8 + 2 * q + 1) * VROW + kr * 2) = (unsigned short)(ww[q] >> 16); } } }
        __syncthreads();
        {
            const int g = wave >> 1, qh = wave & 1, hq = kvh * GRP + g;
            const float sk = sink[hq];
#pragma unroll 1
            for (int qt = 0; qt < 2; ++qt) {
                const int a = qb * 128 + qh * 64 + qt * 32;
                const int tq = tok0 + a + c;
                v4u qf[4]; head_prep(z + (size_t)tq * INW + OQ + hq * 64 + 8 * hi, qg, hi, positions[tq], 0.125f, qf);
                bf16x8 bq[4];
#pragma unroll
                for (int ks = 0; ks < 4; ++ks) bq[ks] = __builtin_bit_cast(bf16x8, qf[ks]);
                float m = sk, lsum = hi ? 0.f : 1.f;
                f32x16 O0, O1;
#pragma unroll
                for (int r = 0; r < 16; ++r) { O0[r] = 0.f; O1[r] = 0.f; }
#pragma unroll 1
                for (int kt = 0; kt < 9; ++kt) {
                    const int kp0 = a - 128 + 32 * kt;
                    if (kp0 < 0 || kp0 >= S) continue;
                    const int kr0 = kp0 - kbase;
                    f32x16 sa;
#pragma unroll
                    for (int r = 0; r < 16; ++r) sa[r] = 0.f;
#pragma unroll
                    for (int ks = 0; ks < 4; ++ks) { const bf16x8 ka = *(const LAS bf16x8*)(lds + K_OFF + (kr0 + c) * KROW + (ks * 16 + 8 * hi) * 2);
                        sa = __builtin_amdgcn_mfma_f32_32x32x16_bf16(ka, bq[ks], sa, 0, 0, 0); }
                    if (kt == 0) {
#pragma unroll
                        for (int r = 0; r < 16; ++r) { const int i = (r & 3) + 8 * (r >> 2) + 4 * hi; if (i < c) sa[r] = -1e30f; }
                    } else if (kt == 8) {
#pragma unroll
                        for (int r = 0; r < 16; ++r) { const int i = (r & 3) + 8 * (r >> 2) + 4 * hi; if (i > c) sa[r] = -1e30f; }
                    }
                    float mx = sa[0];
#pragma unroll
                    for (int r = 1; r < 16; ++r) mx = fmaxf(mx, sa[r]);
                    mx = fmaxf(mx, __shfl_xor(mx, 32));
                    const float mn = fmaxf(m, mx), al = __expf(m - mn);
                    m = mn;
                    float p[16]; float rs = 0.f;
#pragma unroll
                    for (int r = 0; r < 16; ++r) { p[r] = __expf(sa[r] - mn); rs += p[r]; }
                    lsum = lsum * al + rs;
#pragma unroll
                    for (int r = 0; r < 16; ++r) { O0[r] *= al; O1[r] *= al; }
#pragma unroll
                    for (int s2 = 0; s2 < 2; ++s2) {
                        v4u pw; pw.x = cvt_pk_bf16(p[8 * s2 + 0], p[8 * s2 + 1]); pw.y = cvt_pk_bf16(p[8 * s2 + 2], p[8 * s2 + 3]); pw.z = cvt_pk_bf16(p[8 * s2 + 4], p[8 * s2 + 5]); pw.w = cvt_pk_bf16(p[8 * s2 + 6], p[8 * s2 + 7]);
                        const bf16x8 pb = __builtin_bit_cast(bf16x8, pw);
#pragma unroll
                        for (int mt = 0; mt < 2; ++mt) { const LAS unsigned char* vp = lds + V_OFF + (mt * 32 + c) * VROW + (kr0 + 16 * s2 + 4 * hi) * 2;
                            const v2u lo2 = *(const LAS v2u*)vp, hi2 = *(const LAS v2u*)(vp + 16);
                            v4u va; va.x = lo2.x; va.y = lo2.y; va.z = hi2.x; va.w = hi2.y;
                            if (mt == 0) O0 = __builtin_amdgcn_mfma_f32_32x32x16_bf16(__builtin_bit_cast(bf16x8, va), pb, O0, 0, 0, 0);
                            else         O1 = __builtin_amdgcn_mfma_f32_32x32x16_bf16(__builtin_bit_cast(bf16x8, va), pb, O1, 0, 0, 0); }
                    }
                }
                const float inv = 1.0f / (lsum + __shfl_xor(lsum, 32));
                bf16* orow = mix + (size_t)tq * D + hq * 64 + 4 * hi;
#pragma unroll
                for (int q = 0; q < 4; ++q) { v2u w0, w1;
                    w0.x = pk2(O0[4 * q] * inv, O0[4 * q + 1] * inv); w0.y = pk2(O0[4 * q + 2] * inv, O0[4 * q + 3] * inv);
                    w1.x = pk2(O1[4 * q] * inv, O1[4 * q + 1] * inv); w1.y = pk2(O1[4 * q + 2] * inv, O1[4 * q + 3] * inv);
                    *(GAS v2u*)(orow + 8 * q) = w0; *(GAS v2u*)(orow + 32 + 8 * q) = w1; }
            }
        }
        if (kvh == 0) {
            const int cp = tid & 127, tg = tid >> 7;
            const float w0a = conv_w[2 * cp], w0b = conv_w[2 * cp + 1], w1a = conv_w[256 + 2 * cp], w1b = conv_w[256 + 2 * cp + 1], w2a = conv_w[512 + 2 * cp], w2b = conv_w[512 + 2 * cp + 1];
            const int s0 = qb * 128 + tg * 32;
            float upa = 0.f, upb = 0.f, uca, ucb;
            { const bf16* zr = z + (size_t)(tok0 + s0) * INW;
              const unsigned cx = *(const GAS unsigned*)(zr + OCX + 2 * cp), cc = *(const GAS unsigned*)(zr + OCC + 2 * cp);
              uca = bf2f((unsigned short)(cx & 0xffffu)) * bf2f((unsigned short)(cc & 0xffffu)); ucb = bf2f((unsigned short)(cx >> 16)) * bf2f((unsigned short)(cc >> 16));
              if (s0 > 0) { const bf16* zp = zr - INW; const unsigned px = *(const GAS unsigned*)(zp + OCX + 2 * cp), pc = *(const GAS unsigned*)(zp + OCC + 2 * cp);
                  upa = bf2f((unsigned short)(px & 0xffffu)) * bf2f((unsigned short)(pc & 0xffffu)); upb = bf2f((unsigned short)(px >> 16)) * bf2f((unsigned short)(pc >> 16)); } }
            for (int i = 0; i < 32; ++i) { const int s = s0 + i; const bf16* zr = z + (size_t)(tok0 + s) * INW;
                float una = 0.f, unb = 0.f;
                if (s + 1 < S) { const unsigned nx = *(const GAS unsigned*)(zr + INW + OCX + 2 * cp), nc = *(const GAS unsigned*)(zr + INW + OCC + 2 * cp);
                    una = bf2f((unsigned short)(nx & 0xffffu)) * bf2f((unsigned short)(nc & 0xffffu)); unb = bf2f((unsigned short)(nx >> 16)) * bf2f((unsigned short)(nc >> 16)); }
                const unsigned cb = *(const GAS unsigned*)(zr + OCB + 2 * cp);
                const float oa = bf2f((unsigned short)(cb & 0xffffu)) * (w0a * upa + w1a * uca + w2a * una), ob = bf2f((unsigned short)(cb >> 16)) * (w0b * upb + w1b * ucb + w2b * unb);
                *(GAS unsigned*)(mix + (size_t)(tok0 + s) * D + 512 + 2 * cp) = pk2(oa, ob);
                upa = uca; upb = ucb; uca = una; ucb = unb; }
        }
#pragma unroll 1
        for (int gi = 0; gi < 2; ++gi) {
            const int gq = kvh * 2 + gi, half = 1 << gq;
            __syncthreads();
            { const int tt = tid >> 2, cq = tid & 3, s = qb * 128 + tt;
              int lo = s - half, hi2 = s + half; lo = lo < 0 ? 0 : lo; hi2 = hi2 > S ? S : hi2;
              float acc[16];
#pragma unroll
              for (int j = 0; j < 16; ++j) acc[j] = 0.f;
              for (int ss = lo; ss < hi2; ++ss) { const bf16* zp = z + (size_t)(tok0 + ss) * INW + OPX + gq * 64 + cq * 16;
                  const v4u w0 = *(const GAS v4u*)zp, w1 = *(const GAS v4u*)(zp + 8); const unsigned ww[8] = {w0.x, w0.y, w0.z, w0.w, w1.x, w1.y, w1.z, w1.w};
#pragma unroll
                  for (int q = 0; q < 8; ++q) { acc[2 * q] += __builtin_bit_cast(float, ww[q] << 16); acc[2 * q + 1] += __builtin_bit_cast(float, ww[q] & 0xffff0000u); } }
              const float icnt = 1.0f / (float)(hi2 - lo);
              const bf16* zc = z + (size_t)(tok0 + s) * INW + OPX + gq * 64 + cq * 16;
              const v4u w0 = *(const GAS v4u*)zc, w1 = *(const GAS v4u*)(zc + 8); const unsigned ww[8] = {w0.x, w0.y, w0.z, w0.w, w1.x, w1.y, w1.z, w1.w};
              LAS float* pr = (LAS float*)(lds + P_OFF) + tt * PROW + cq * 16;
#pragma unroll
              for (int q = 0; q < 8; ++q) { pr[2 * q] = acc[2 * q] * icnt - __builtin_bit_cast(float, ww[q] << 16); pr[2 * q + 1] = acc[2 * q + 1] * icnt - __builtin_bit_cast(float, ww[q] & 0xffff0000u); } }
            __syncthreads();
            { const int e = tid & 63, tq8 = tid >> 6;
              float acc[16];
#pragma unroll
              for (int j = 0; j < 16; ++j) acc[j] = 0.f;
              const float* pw = pool_w + (size_t)gq * 64 * 64 + e;
              for (int c4 = 0; c4 < 16; ++c4) { const float wa = pw[(4 * c4) * 64], wb = pw[(4 * c4 + 1) * 64], wc = pw[(4 * c4 + 2) * 64], wd = pw[(4 * c4 + 3) * 64];
#pragma unroll
                  for (int tt = 0; tt < 16; ++tt) { const f32x4 pv = *(const LAS f32x4*)((LAS float*)(lds + P_OFF) + (tq8 * 16 + tt) * PROW + 4 * c4);
                      acc[tt] += pv.x * wa + pv.y * wb + pv.z * wc + pv.w * wd; } }
              const float sc = pool_scale[gq * 64 + e];
#pragma unroll
              for (int tt = 0; tt < 16; ++tt) mix[(size_t)(tok0 + qb * 128 + tq8 * 16 + tt) * D + 768 + gq * 64 + e] = (bf16)f2bf(acc[tt] * sc); }
        }
    }
}
}


namespace mk {
typedef float f32x2v __attribute__((ext_vector_type(2)));
__device__ __forceinline__ float gelu_erf(float x) { return 0.5f * x * (1.0f + erff(x * 0.70710678118654752f)); }

template <int L> __device__ __forceinline__ void ph_peer(const Args& args) {
    const int lane = threadIdx.x & 63, wave = __builtin_amdgcn_readfirstlane(threadIdx.x >> 6);
    unsigned char* ws = args.ws;
    const unsigned char* U8 = ws + WS_U + (size_t)L * NE * D; const unsigned char* V8 = ws + WS_V + (size_t)L * NE * D;
    const float* SU = (const float*)(ws + WS_SU) + L * NE; const float* SV = (const float*)(ws + WS_SV) + L * NE;
    const bf16* Hb = (const bf16*)(ws + WS_H); const float* X1 = (const float*)(ws + WS_X1);
    const int* eidx = (const int*)(ws + WS_EIDX); const float* gate = (const float*)(ws + WS_GATE);
    const float* mod = (const float*)(ws + WS_MOD);
    float* outp = args.out;
    const int b5 = (lane >> 5) & 1, b4 = (lane >> 4) & 1, b3 = (lane >> 3) & 1, b2 = (lane >> 2) & 1, jl = 8 * b5 + 4 * b4 + 2 * b3 + b2;
    const int gw = MK_GW(wave), NGW = MK_NGW;
#pragma unroll 1
    for (int t = gw; t < T; t += NGW) {
        float hf[16];
        { const v4u h0 = *(const GAS v4u*)(Hb + (size_t)t * D + 16 * lane), h1 = *(const GAS v4u*)(Hb + (size_t)t * D + 16 * lane + 8);
          const unsigned hw[8] = {h0.x, h0.y, h0.z, h0.w, h1.x, h1.y, h1.z, h1.w};
#pragma unroll
          for (int q = 0; q < 8; ++q) { hf[2 * q] = __builtin_bit_cast(float, hw[q] << 16); hf[2 * q + 1] = __builtin_bit_cast(float, hw[q] & 0xffff0000u); } }
        const int e0 = eidx[(size_t)t * 128 + lane], e1 = eidx[(size_t)t * 128 + 64 + lane];
        const float su0 = SU[e0], su1 = SU[e1];
        const float c0 = gate[(size_t)t * 128 + lane] * SV[e0], c1 = gate[(size_t)t * 128 + 64 + lane] * SV[e1];
        float y[16];
#pragma unroll
        for (int i = 0; i < 16; ++i) y[i] = 0.f;
#pragma unroll 1
        for (int bt = 0; bt < 8; ++bt) {
            const int ev = (bt < 4) ? e0 : e1; const float suv = (bt < 4) ? su0 : su1, cv = (bt < 4) ? c0 : c1; const int lbase = (bt & 3) * 16;
            v4u ua[16], va[16];
#pragma unroll
            for (int j = 0; j < 16; ++j) { const int ek = __builtin_amdgcn_readlane(ev, lbase + j);
                ua[j] = *(const GAS v4u*)(U8 + (size_t)ek * D + 16 * lane); va[j] = *(const GAS v4u*)(V8 + (size_t)ek * D + 16 * lane); }
            float p[16];
#pragma unroll
            for (int j = 0; j < 16; ++j) { const unsigned uw[4] = {ua[j].x, ua[j].y, ua[j].z, ua[j].w}; float s = 0.f;
#pragma unroll
                for (int d = 0; d < 4; ++d) { const f32x2v lo = __builtin_amdgcn_cvt_pk_f32_fp8((int)uw[d], false), hi = __builtin_amdgcn_cvt_pk_f32_fp8((int)uw[d], true);
                    s += lo.x * hf[4 * d] + lo.y * hf[4 * d + 1] + hi.x * hf[4 * d + 2] + hi.y * hf[4 * d + 3]; }
                p[j] = s; }
            float q8[8], q4[4], q2[2], sd;
#pragma unroll
            for (int i = 0; i < 8; ++i) { const float snd = b5 ? p[i] : p[i + 8]; const float rcv = __shfl_xor(snd, 32); q8[i] = (b5 ? p[i + 8] : p[i]) + rcv; }
#pragma unroll
            for (int i = 0; i < 4; ++i) { const float snd = b4 ? q8[i] : q8[i + 4]; const float rcv = __shfl_xor(snd, 16); q4[i] = (b4 ? q8[i + 4] : q8[i]) + rcv; }
#pragma unroll
            for (int i = 0; i < 2; ++i) { const float snd = b3 ? q4[i] : q4[i + 2]; const float rcv = __shfl_xor(snd, 8); q2[i] = (b3 ? q4[i + 2] : q4[i]) + rcv; }
            { const float snd = b2 ? q2[0] : q2[1]; const float rcv = __shfl_xor(snd, 4); sd = (b2 ? q2[1] : q2[0]) + rcv; }
            sd += __shfl_xor(sd, 2); sd += __shfl_xor(sd, 1);
            const float w = __shfl(cv, lbase + jl) * gelu_erf(sd * __shfl(suv, lbase + jl));
#pragma unroll
            for (int j = 0; j < 16; ++j) { const float wj = __builtin_bit_cast(float, __builtin_amdgcn_readlane(__builtin_bit_cast(int, w), 32 * ((j >> 3) & 1) + 16 * ((j >> 2) & 1) + 8 * ((j >> 1) & 1) + 4 * (j & 1)));
                const unsigned vw[4] = {va[j].x, va[j].y, va[j].z, va[j].w};
#pragma unroll
                for (int d = 0; d < 4; ++d) { const f32x2v lo = __builtin_amdgcn_cvt_pk_f32_fp8((int)vw[d], false), hi = __builtin_amdgcn_cvt_pk_f32_fp8((int)vw[d], true);
                    y[4 * d] += wj * lo.x; y[4 * d + 1] += wj * lo.y; y[4 * d + 2] += wj * hi.x; y[4 * d + 3] += wj * hi.y; } }
        }
        const float* g2 = mod + ((size_t)L * B + t / S) * 6 * D + 5 * D;
        float xo[16]; float ssq = 0.f;
#pragma unroll
        for (int hf4 = 0; hf4 < 4; ++hf4) { const int col = 16 * lane + 4 * hf4;
            const f32x4 xv = *(const GAS f32x4*)(X1 + (size_t)t * D + col), gg = *(const f32x4*)(g2 + col);
            f32x4 o; o.x = xv.x + gg.x * y[4 * hf4 + 0]; o.y = xv.y + gg.y * y[4 * hf4 + 1]; o.z = xv.z + gg.z * y[4 * hf4 + 2]; o.w = xv.w + gg.w * y[4 * hf4 + 3];
            *(GAS f32x4*)(outp + (size_t)t * D + col) = o;
            xo[4 * hf4 + 0] = o.x; xo[4 * hf4 + 1] = o.y; xo[4 * hf4 + 2] = o.z; xo[4 * hf4 + 3] = o.w;
            ssq += (o.x * o.x + o.y * o.y) + (o.z * o.z + o.w * o.w); }
        if (L + 1 < DEPTH) {
            const float rstd = 1.0f / sqrtf(wave_sum(ssq) * (1.f / D) + EPS);
            const float* g = args.in[3] + (L + 1) * D; const float* mb = mod + ((size_t)(L + 1) * B + t / S) * 6 * D;
            float hv[16];
#pragma unroll
            for (int hf4 = 0; hf4 < 4; ++hf4) { const int col = 16 * lane + 4 * hf4;
                const f32x4 gg = *(const f32x4*)(g + col), sh = *(const f32x4*)(mb + col), sc = *(const f32x4*)(mb + D + col);
                hv[4 * hf4 + 0] = xo[4 * hf4 + 0] * rstd * gg.x * (1.0f + sc.x) + sh.x; hv[4 * hf4 + 1] = xo[4 * hf4 + 1] * rstd * gg.y * (1.0f + sc.y) + sh.y;
                hv[4 * hf4 + 2] = xo[4 * hf4 + 2] * rstd * gg.z * (1.0f + sc.z) + sh.z; hv[4 * hf4 + 3] = xo[4 * hf4 + 3] * rstd * gg.w * (1.0f + sc.w) + sh.w; }
#pragma unroll
            for (int pc = 0; pc < 2; ++pc) { v4u o; o.x = pk2(hv[8 * pc + 0], hv[8 * pc + 1]); o.y = pk2(hv[8 * pc + 2], hv[8 * pc + 3]); o.z = pk2(hv[8 * pc + 4], hv[8 * pc + 5]); o.w = pk2(hv[8 * pc + 6], hv[8 * pc + 7]);
                *(GAS v4u*)((bf16*)(ws + WS_H) + (size_t)t * D + 16 * lane + 8 * pc) = o; }
        }
    }
}
}

namespace mk {
constexpr int LDS_XB_OFF = LDS_BYTES - 64;
template <int L> __device__ __forceinline__ void layer_phases(const Args& args, LAS unsigned char* lds, const XcdBarrier& bar) {
    const int lo = args.ph_lo, hi = args.ph_hi;
#define IN(k) (lo <= (k) && (k) < hi)
#define SEAM(k) do { if (IN(k) && IN((k) + 1)) xcd_barrier(bar); } while (0)
    constexpr int pb = PH_L0 + L * PH_PER_LAYER;
    if (IN(pb + PH_G1)) ph_g1<L>(args, lds);
    SEAM(pb + PH_G1);
    if (IN(pb + PH_AT)) ph_mixer<L>(args, lds);
    SEAM(pb + PH_AT);
    if (IN(pb + PH_G2)) ph_g2<L>(args, lds);
    SEAM(pb + PH_G2);
    if (IN(pb + PH_N2)) ph_hmod<L, 1>(args);
    SEAM(pb + PH_N2);
    if (IN(pb + PH_G3)) ph_g3<L>(args, lds);
    SEAM(pb + PH_G3);
    if (IN(pb + PH_TK)) ph_topk<L>(args, lds);
    SEAM(pb + PH_TK);
    if (IN(pb + PH_PE)) ph_peer<L>(args);
    if (L + 1 < DEPTH) SEAM(pb + PH_PE);
#undef SEAM
#undef IN
}

__global__ void __launch_bounds__(NT, 2) mk_fwd(Args args) {
    extern __shared__ __attribute__((aligned(16))) unsigned char lds_raw[];
    LAS unsigned char* lds = (LAS unsigned char*)lds_raw;
    const int lo = args.ph_lo, hi = args.ph_hi;
    if (threadIdx.x < 16) ((LAS unsigned*)(lds + LDS_XB_OFF))[threadIdx.x] = 0u;
    __syncthreads();
    XcdBarrier bar; bar.bar = (unsigned*)(args.ws + WS_CTL) + CW_BAR; bar.x = 0; bar.st = nullptr;
    if (hi - lo > 1) bar = xcd_barrier_post((unsigned*)(args.ws + WS_CTL) + CW_BAR, (volatile LAS unsigned*)(lds + LDS_XB_OFF));
#define IN(k) (lo <= (k) && (k) < hi)
#define SEAM(k) do { if (IN(k) && IN((k) + 1)) xcd_barrier(bar); } while (0)
    if (IN(PH_PRO)) ph_prologue(args, lds);
    SEAM(PH_PRO);
    if (IN(PH_H0)) ph_hmod<0, 0>(args);
    SEAM(PH_H0);
    layer_phases<0>(args, lds, bar);
    layer_phases<1>(args, lds, bar);
#undef SEAM
#undef IN
}
}


extern "C" void kernel_launch(void* const* d_in, const int* in_sizes, int n_in, void* d_out, int out_size, void* d_ws, size_t ws_size, hipStream_t stream) {
    using namespace mk;
    static int grid = 0;
    if (grid == 0) {
        if (n_in != 19 || ws_size < WS_END || out_size != T * D) { fprintf(stderr, "kernel_launch: bad n_in %d / out_size %d / ws_size %zu\n", n_in, out_size, ws_size); grid = -1; return; }
        int dev = 0, cus = 0, per_cu = 0;
        if (hipGetDevice(&dev) != hipSuccess || hipDeviceGetAttribute(&cus, hipDeviceAttributeMultiprocessorCount, dev) != hipSuccess) { grid = -1; return; }
        if (hipFuncSetAttribute((const void*)mk_fwd, hipFuncAttributeMaxDynamicSharedMemorySize, LDS_BYTES) != hipSuccess) { fprintf(stderr, "hipFuncSetAttribute failed\n"); grid = -1; return; }
        if (hipOccupancyMaxActiveBlocksPerMultiprocessor(&per_cu, (const void*)mk_fwd, NT, LDS_BYTES) != hipSuccess) per_cu = 0;
        (void)hipGetLastError();
        grid = (per_cu >= 1) ? cus : -1;
        if (grid < 0) { fprintf(stderr, "kernel_launch: occupancy query says %d workgroups per CU; nothing launched\n", per_cu); return; }
    }
    if (grid < 0) return;
    unsigned char* ws = (unsigned char*)d_ws;
    (void)hipMemsetAsync(ws + WS_CTL, 0, CTL_ZERO_BYTES, stream);
    Args a{};
    for (int i = 0; i < 19; ++i) a.in[i] = (const float*)d_in[i];
    a.out = (float*)d_out; a.ws = ws;
#if MK_SPLIT
    for (int ph = 0; ph < PH_END; ++ph) { a.ph_lo = ph; a.ph_hi = ph + 1; hipLaunchKernelGGL(mk_fwd, dim3(grid), dim3(NT), LDS_BYTES, stream, a); }
#else
    a.ph_lo = 0; a.ph_hi = PH_END;
    hipLaunchKernelGGL(mk_fwd, dim3(grid), dim3(NT), LDS_BYTES, stream, a);
#endif
}
```

```cpp
#include <hip/hip_runtime.h>
#include <stdint.h>
#include <math.h>
#include <cstdio>

#ifndef BATCH
#define BATCH 8
#endif
#ifndef SEQ
#define SEQ 2048
#endif
#ifndef MK_SPLIT
#define MK_SPLIT 0
#endif
#define Z_F32 0
#ifndef HREP_GEMM
#define HREP_GEMM 1
#endif
#ifndef HREP_AT
#define HREP_AT 1
#endif
#ifndef HREP_TK
#define HREP_TK 1
#endif
#ifndef HREP_N2
#define HREP_N2 1
#endif
#ifndef HREP_PRO
#define HREP_PRO 1
#endif
#ifndef PE_SYNC
#define PE_SYNC 0
#endif
#ifndef PE_NTOK
#define PE_NTOK 1
#endif
#ifndef REP_PRO
#define REP_PRO 1
#endif
#ifndef REP_GEMM
#define REP_GEMM 1
#endif
#ifndef REP_AT
#define REP_AT 1
#endif
#ifndef REP_TK
#define REP_TK 1
#endif
#ifndef REP_PE1
#define REP_PE1 1
#endif
#ifndef REP_N2
#define REP_N2 1
#endif
#define QP_F32 0
#define DO_UV 1

namespace cfg {
constexpr int B = BATCH, S = SEQ, T = B * S, D = 1024, DEPTH = 2;
constexpr int HDIM = 64, NQH = 8, NKVH = 2, GRP = 4, WIN = 128;
constexpr int INW = 1792, OQ = 0, OK_ = 512, OV = 640, OCX = 768, OCB = 1024, OCC = 1280, OPX = 1536;
constexpr int PH = 8, NK = 128, NE = 16384, QD = 256, TOPK = 16, PW = 2048;
constexpr float EPS = 1e-6f;
}
using namespace cfg;

namespace pg8 {
#define PG8_LAS __attribute__((address_space(3)))
typedef unsigned short bf16_t;
typedef short bf16x8 __attribute__((ext_vector_type(8)));
typedef float f32x4 __attribute__((ext_vector_type(4)));
typedef unsigned u32x4 __attribute__((ext_vector_type(4)));
constexpr int BM = 256, BK = 64, HALF = 128, HTB = HALF * BK * 2  , STAGE_BYTES = 8 * HTB, NXCD = 8, WGM = 8;

__host__ __device__ __forceinline__ int lds_byte(int r, int c) { const int st = (r >> 4) * 2 + (c >> 5), rr = r & 15, cc = c & 31, ob = rr * 64 + cc * 2; return st * 1024 + (ob ^ (((ob >> 9) & 1) << 5)); }
__host__ __device__ __forceinline__ void stage_rc(int b, int& R, int& C) { const int st = b / 1024, sb = b % 1024, swz = sb ^ (((sb >> 9) & 1) << 5); R = (st >> 1) * 16 + swz / 64; C = (st & 1) * 32 + (swz % 64) / 2; }
__host__ __device__ __forceinline__ int perm32(int rho) { const int n = rho >> 4, i = rho & 15; return 8 * (i >> 2) + 4 * n + (i & 3); }

struct Unit { int pm, pn; };
struct Gemm { const bf16_t* A; const bf16_t* Bt; int M, N, K; };

struct StaticOrder {
    int nM, nN, nwg, G, c;
    __host__ __device__ void init(int M, int N, int G_, int c_) { nM = M / BM; nN = N / BM; nwg = nM * nN; G = G_; c = c_; }
    __host__ __device__ bool next(int i, Unit& u) const {
        const long L = (long)i * G + c; if (L >= nwg) return false;
        int wgid = (int)L; { const int q = nwg / NXCD, r = nwg % NXCD, xcd = wgid % NXCD, off = wgid / NXCD; wgid = (xcd < r ? xcd * (q + 1) : r * (q + 1) + (xcd - r) * q) + off; }
        const int nig = WGM * nN, gid = wgid / nig, fm = gid * WGM, gsz = (nM - fm) < WGM ? (nM - fm) : WGM;
        u.pm = fm + ((wgid % nig) % gsz); u.pn = (wgid % nig) / gsz; return true;
    }
    __device__ __forceinline__ void a_ready(const Unit&) const {}
    __device__ __forceinline__ void done(const Unit&) const {}
};

__device__ __forceinline__ unsigned cvt_pk_bf16(float lo, float hi) { unsigned r; asm volatile("v_cvt_pk_bf16_f32 %0, %1, %2" : "=v"(r) : "v"(lo), "v"(hi)); return r; }
typedef float f32x2 __attribute__((ext_vector_type(2)));
__device__ __forceinline__ f32x2 gelu_pk(f32x2 v) {
    const f32x2 av = __builtin_elementwise_abs(v), d = av * 0.2316418882f + 1.0f;
    f32x2 t; t.x = __builtin_amdgcn_rcpf(d.x); t.y = __builtin_amdgcn_rcpf(d.y);
    f32x2 q = t * 0.5307027145f + (-0.7265760135f); q = q * t + 0.7107068705f; q = q * t + (-0.142248368f); q = q * t + 0.127414796f; q = q * t;
    const f32x2 s = (v * v) * (-0.72134752044f);
    f32x2 e; e.x = __builtin_amdgcn_exp2f(s.x); e.y = __builtin_amdgcn_exp2f(s.y);
    const f32x2 m = v * (q * e), r = v - m;
    f32x2 o; o.x = v.x < 0.f ? m.x : r.x; o.y = v.y < 0.f ? m.y : r.y; return o;
}

template <int ACT  > struct EpiBf16 {
    static constexpr bool PERM = true, AFTER_DRAIN = false; static_assert(ACT == 0 || ACT == 1, "EpiBf16: ACT is 0 (none) or 1 (gelu_pk)");
    bf16_t* O; int ldc; const float* bias; int split_cols; size_t split_stride; float scale0;
    __device__ __forceinline__ void operator()(const f32x4 (&acc)[2][2][4][2], const Unit& u, int wr, int wc, int fr, int fq) const {
        const int row0 = u.pm * BM + wr * 64 + fr; int colt = u.pn * BM; bf16_t* base = O;
        float sc = 1.f; if (split_cols) { const int t = colt / split_cols; base += (size_t)t * split_stride; colt -= t * split_cols; if (t == 0) sc = scale0; }
        const int col0 = colt + wc * 32 + 8 * fq, bcol0 = u.pn * BM + wc * 32 + 8 * fq;
        f32x4 bv[2][2];
#pragma unroll
        for (int bj = 0; bj < 2; ++bj)
#pragma unroll
            for (int n = 0; n < 2; ++n) bv[bj][n] = bias ? *(const f32x4*)(bias + bcol0 + bj * HALF + 4 * n) : (f32x4){0.f, 0.f, 0.f, 0.f};
#pragma unroll
        for (int ai = 0; ai < 2; ++ai)
#pragma unroll
            for (int m = 0; m < 4; ++m) { bf16_t* rowp = base + (size_t)(row0 + ai * HALF + m * 16) * ldc + col0;
#pragma unroll
                for (int bj = 0; bj < 2; ++bj) { f32x4 v0 = acc[ai][bj][m][0] + bv[bj][0], v1 = acc[ai][bj][m][1] + bv[bj][1];
                    if (ACT == 1) { f32x2 a = gelu_pk((f32x2){v0[0], v0[1]}), b = gelu_pk((f32x2){v0[2], v0[3]}), c = gelu_pk((f32x2){v1[0], v1[1]}), d = gelu_pk((f32x2){v1[2], v1[3]});
                        v0 = (f32x4){a.x, a.y, b.x, b.y}; v1 = (f32x4){c.x, c.y, d.x, d.y}; }
                    v0 = v0 * sc; v1 = v1 * sc; u32x4 w; w.x = cvt_pk_bf16(v0[0], v0[1]); w.y = cvt_pk_bf16(v0[2], v0[3]); w.z = cvt_pk_bf16(v1[0], v1[1]); w.w = cvt_pk_bf16(v1[2], v1[3]);
                    *(u32x4*)(rowp + bj * HALF) = w; } }
    }
};

template <class Epi, class Sched, bool ALIGN_EPI = false, bool SP2 = false>
__device__ __forceinline__ void gemm_phase(PG8_LAS unsigned char* lds, const Gemm g, const Sched& S, const Epi& E) {
    const int tid = threadIdx.x, wid = __builtin_amdgcn_readfirstlane(tid >> 6), lane = tid & 63, wr = wid >> 2, wc = wid & 3, fr = lane & 15, fq = lane >> 4;
    const int K = g.K, nt = K / BK;
    unsigned voffA[2], voffB[2];
#pragma unroll
    for (int i = 0; i < 2; ++i) { int R, C; stage_rc(tid * 16 + i * 8192, R, C); const int Rb = Epi::PERM ? ((R & ~31) + perm32(R & 31)) : R;
        voffA[i] = (unsigned)(R * K + C) * 2u; voffB[i] = (unsigned)(Rb * K + C) * 2u; }
    const size_t kstep = (size_t)(BK * 2);
    const size_t hstep = (size_t)HALF * K * 2;
    const size_t tstep = 2 * hstep;
    const unsigned ldsw = (unsigned)wid * 1024u;
    const int aoff = lds_byte(wr * 64 + fr, fq * 8), boff = lds_byte(wc * 32 + fr, fq * 8);
#define PG8_SA(b, h) (((b) * 2 + (h)) * HTB)
#define PG8_SB(b, h) ((4 + (b) * 2 + (h)) * HTB)
#define PG8_STAGE(bufoff, gbase, voff) do { _Pragma("unroll") for (int _i = 0; _i < 2; ++_i) \
        __builtin_amdgcn_global_load_lds((const unsigned*)((const char*)(gbase) + (voff)[_i]), (PG8_LAS unsigned*)(lds + (bufoff) + ldsw + _i * 8192), 16, 0, 0); } while (0)
#define PG8_LDA(dst, b, h) do { _Pragma("unroll") for (int m = 0; m < 4; ++m) _Pragma("unroll") for (int k = 0; k < 2; ++k) dst[m][k] = *(const PG8_LAS bf16x8*)(lds + PG8_SA(b, h) + aoff + m * 2048 + k * 1024); } while (0)
#define PG8_LDB(dst, b, h) do { _Pragma("unroll") for (int n = 0; n < 2; ++n) _Pragma("unroll") for (int k = 0; k < 2; ++k) dst[n][k] = *(const PG8_LAS bf16x8*)(lds + PG8_SB(b, h) + boff + n * 2048 + k * 1024); } while (0)
#define PG8_MMA(ai, bj, At, Bt) do { __builtin_amdgcn_s_setprio(1); _Pragma("unroll") for (int m = 0; m < 4; ++m) _Pragma("unroll") for (int n = 0; n < 2; ++n) _Pragma("unroll") for (int k = 0; k < 2; ++k) \
        acc[ai][bj][m][n] = __builtin_amdgcn_mfma_f32_16x16x32_bf16(Bt[n][k], At[m][k], acc[ai][bj][m][n], 0, 0, 0); __builtin_amdgcn_s_setprio(0); } while (0)
#define PG8_WAIT_V(n) asm volatile("s_waitcnt vmcnt(" #n ")" ::: "memory")
#define PG8_WAIT_L(n) asm volatile("s_waitcnt lgkmcnt(" #n ")" ::: "memory")
#define PG8_BAR __builtin_amdgcn_s_barrier()
#define PG8_SCHED __builtin_amdgcn_sched_barrier(0)
    Unit cur, nxt; int ui = 0;
    if (!S.next(0, cur)) return;
    f32x4 acc[2][2][4][2];
#pragma unroll
    for (int a = 0; a < 2; ++a)
#pragma unroll
        for (int b = 0; b < 2; ++b)
#pragma unroll
            for (int m = 0; m < 4; ++m)
#pragma unroll
                for (int n = 0; n < 2; ++n) acc[a][b][m][n] = (f32x4){0.f, 0.f, 0.f, 0.f};
    bf16x8 At[4][2], B0[2][2], B1[2][2];
    const char* cA = (const char*)g.A + (size_t)cur.pm * tstep; const char* cB = (const char*)g.Bt + (size_t)cur.pn * tstep;
    S.a_ready(cur);
    if constexpr (SP2) {
        PG8_STAGE(PG8_SB(0, 0), cB, voffB); PG8_STAGE(PG8_SB(0, 1), cB + hstep, voffB); PG8_STAGE(PG8_SA(0, 0), cA, voffA); PG8_STAGE(PG8_SA(0, 1), cA + hstep, voffA);
        if (wr == 1) PG8_BAR;
        PG8_WAIT_V(2); PG8_BAR;
        PG8_STAGE(PG8_SB(1, 0), cB + kstep, voffB); PG8_STAGE(PG8_SA(1, 0), cA + kstep, voffA); PG8_STAGE(PG8_SB(1, 1), cB + hstep + kstep, voffB);
        PG8_WAIT_V(6); PG8_BAR;
    } else {
        PG8_STAGE(PG8_SB(0, 0), cB, voffB); PG8_STAGE(PG8_SA(0, 0), cA, voffA); PG8_STAGE(PG8_SB(0, 1), cB + hstep, voffB); PG8_STAGE(PG8_SA(0, 1), cA + hstep, voffA);
        if (wr == 1) PG8_BAR;
        PG8_WAIT_V(4); PG8_BAR;
        PG8_STAGE(PG8_SB(1, 0), cB + kstep, voffB); PG8_STAGE(PG8_SA(1, 0), cA + kstep, voffA); PG8_STAGE(PG8_SB(1, 1), cB + hstep + kstep, voffB);
        PG8_WAIT_V(6); PG8_BAR;
    }
    for (;;) {
        const bool has_next = S.next(ui + 1, nxt);
        const char* nA = has_next ? (const char*)g.A + (size_t)nxt.pm * tstep : cA; const char* nB = has_next ? (const char*)g.Bt + (size_t)nxt.pn * tstep : cB;
        for (int t = 0; t < nt; t += 2) {
            const bool last = (t == nt - 2);
            const char* a1 = cA + (size_t)(t + 1) * kstep;
            const char* a2 = last ? nA : cA + (size_t)(t + 2) * kstep; const char* b2 = last ? nB : cB + (size_t)(t + 2) * kstep;
            const char* a3 = a2 + kstep; const char* b3 = b2 + kstep;
            if (last && has_next) S.a_ready(nxt);
            if constexpr (SP2) {
            PG8_LDB(B0, 0, 0); PG8_LDB(B1, 0, 1); PG8_SCHED; PG8_LDA(At, 0, 0); PG8_STAGE(PG8_SA(1, 1), a1 + hstep, voffA);
            PG8_WAIT_V(8); PG8_WAIT_L(0); PG8_BAR; PG8_MMA(0, 0, At, B0); PG8_MMA(0, 1, At, B1); PG8_BAR; PG8_SCHED;
            PG8_LDA(At, 0, 1); PG8_STAGE(PG8_SB(0, 0), b2, voffB); PG8_STAGE(PG8_SB(0, 1), b2 + hstep, voffB); PG8_STAGE(PG8_SA(0, 0), a2, voffA);
            PG8_WAIT_V(8); PG8_WAIT_L(0); PG8_BAR; PG8_MMA(1, 0, At, B0); PG8_MMA(1, 1, At, B1); PG8_BAR; PG8_SCHED;
            PG8_LDB(B0, 1, 0); PG8_LDB(B1, 1, 1); PG8_SCHED; PG8_LDA(At, 1, 0); PG8_STAGE(PG8_SA(0, 1), a2 + hstep, voffA);
            PG8_WAIT_V(8); PG8_WAIT_L(0); PG8_BAR; PG8_MMA(0, 0, At, B0); PG8_MMA(0, 1, At, B1); PG8_BAR; PG8_SCHED;
            PG8_LDA(At, 1, 1); PG8_STAGE(PG8_SB(1, 0), b3, voffB); PG8_STAGE(PG8_SB(1, 1), b3 + hstep, voffB); PG8_STAGE(PG8_SA(1, 0), a3, voffA);
            PG8_WAIT_V(8); PG8_WAIT_L(0); PG8_BAR; PG8_MMA(1, 0, At, B0); PG8_MMA(1, 1, At, B1); PG8_BAR; PG8_SCHED;
            } else {
            PG8_LDB(B0, 0, 0); PG8_SCHED; PG8_LDA(At, 0, 0); PG8_STAGE(PG8_SA(1, 1), a1 + hstep, voffA);
            PG8_WAIT_L(8); PG8_BAR; PG8_WAIT_L(0); PG8_MMA(0, 0, At, B0); PG8_BAR; PG8_SCHED;
            PG8_LDB(B1, 0, 1); PG8_STAGE(PG8_SB(0, 0), b2, voffB);
            PG8_BAR; PG8_WAIT_L(0); PG8_MMA(0, 1, At, B1); PG8_BAR;
            PG8_LDA(At, 0, 1); PG8_STAGE(PG8_SA(0, 0), a2, voffA);
            PG8_BAR; PG8_WAIT_L(0); PG8_MMA(1, 0, At, B0); PG8_BAR; PG8_SCHED;
            PG8_STAGE(PG8_SB(0, 1), b2 + hstep, voffB);
            PG8_WAIT_V(6); PG8_BAR; PG8_MMA(1, 1, At, B1); PG8_BAR;
            PG8_LDB(B0, 1, 0); PG8_SCHED; PG8_LDA(At, 1, 0); PG8_STAGE(PG8_SA(0, 1), a2 + hstep, voffA);
            PG8_WAIT_L(8); PG8_BAR; PG8_WAIT_L(0); PG8_MMA(0, 0, At, B0); PG8_BAR; PG8_SCHED;
            PG8_LDB(B1, 1, 1); PG8_STAGE(PG8_SB(1, 0), b3, voffB);
            PG8_BAR; PG8_WAIT_L(0); PG8_MMA(0, 1, At, B1); PG8_BAR;
            PG8_LDA(At, 1, 1); PG8_STAGE(PG8_SA(1, 0), a3, voffA);
            PG8_BAR; PG8_WAIT_L(0); PG8_MMA(1, 0, At, B0); PG8_BAR; PG8_SCHED;
            PG8_STAGE(PG8_SB(1, 1), b3 + hstep, voffB);
            PG8_WAIT_V(6); PG8_BAR; PG8_MMA(1, 1, At, B1); PG8_BAR;
            }
        }
        if constexpr (ALIGN_EPI) { if (wr == 0) PG8_BAR; }
        if constexpr (!Epi::AFTER_DRAIN) { E(acc, cur, wr, wc, fr, fq); S.done(cur); }
        if (!has_next) break;
#pragma unroll
        for (int a = 0; a < 2; ++a)
#pragma unroll
            for (int b = 0; b < 2; ++b)
#pragma unroll
                for (int m = 0; m < 4; ++m)
#pragma unroll
                    for (int n = 0; n < 2; ++n) acc[a][b][m][n] = (f32x4){0.f, 0.f, 0.f, 0.f};
        cur = nxt; cA = nA; cB = nB; ++ui;
        if constexpr (ALIGN_EPI) { if (wr == 1) PG8_BAR; }
    }
    PG8_WAIT_V(0);
    if constexpr (!ALIGN_EPI) { if (wr == 0) PG8_BAR; }
    PG8_BAR;
    if constexpr (Epi::AFTER_DRAIN) { E.fused(acc, cur, wr, wc, fr, fq, lds, wid, lane); S.done(cur); }
#undef PG8_SA
#undef PG8_SB
#undef PG8_STAGE
#undef PG8_LDA
#undef PG8_LDB
#undef PG8_MMA
#undef PG8_WAIT_V
#undef PG8_WAIT_L
#undef PG8_BAR
#undef PG8_SCHED
}
}

namespace pg8 {
struct EpiF32 {
    static constexpr bool PERM = false, AFTER_DRAIN = false;
    float* C; int ldc;
    __device__ __forceinline__ void operator()(const f32x4 (&acc)[2][2][4][2], const Unit& u, int wr, int wc, int fr, int fq) const {
        const int row0 = u.pm * BM + wr * 64 + fr, col0 = u.pn * BM + wc * 32 + 4 * fq;
#pragma unroll
        for (int ai = 0; ai < 2; ++ai)
#pragma unroll
            for (int m = 0; m < 4; ++m) { float* rowp = C + (size_t)(row0 + ai * HALF + m * 16) * ldc + col0;
#pragma unroll
                for (int bj = 0; bj < 2; ++bj)
#pragma unroll
                    for (int n = 0; n < 2; ++n) *(f32x4*)(rowp + bj * HALF + n * 16) = acc[ai][bj][m][n]; }
    }
};
struct EpiResid {
    static constexpr bool PERM = false, AFTER_DRAIN = false;
    const float* base; float* out; int ldc; const float* gate0; int rows_per_b; int gstride;
    __device__ __forceinline__ void operator()(const f32x4 (&acc)[2][2][4][2], const Unit& u, int wr, int wc, int fr, int fq) const {
        const int row0 = u.pm * BM + wr * 64 + fr, col0 = u.pn * BM + wc * 32 + 4 * fq;
        const float* gp = gate0 + (size_t)((u.pm * BM) / rows_per_b) * gstride + col0;
        f32x4 gv[2][2];
#pragma unroll
        for (int bj = 0; bj < 2; ++bj)
#pragma unroll
            for (int n = 0; n < 2; ++n) gv[bj][n] = *(const f32x4*)(gp + bj * HALF + n * 16);
#pragma unroll
        for (int ai = 0; ai < 2; ++ai)
#pragma unroll
            for (int m = 0; m < 4; ++m) { const size_t off = (size_t)(row0 + ai * HALF + m * 16) * ldc + col0;
#pragma unroll
                for (int bj = 0; bj < 2; ++bj)
#pragma unroll
                    for (int n = 0; n < 2; ++n) { const f32x4 bs = *(const f32x4*)(base + off + bj * HALF + n * 16);
                        *(f32x4*)(out + off + bj * HALF + n * 16) = bs + gv[bj][n] * acc[ai][bj][m][n]; }
                if (m & 1) asm volatile("" ::: "memory"); }
    }
};
}

namespace mk {
#define GAS __attribute__((address_space(1)))
#define LAS __attribute__((address_space(3)))
typedef unsigned short bf16;
typedef unsigned v4u __attribute__((ext_vector_type(4)));
typedef unsigned v2u __attribute__((ext_vector_type(2)));
typedef float f32x4 __attribute__((ext_vector_type(4)));
#define LDS_WAIT() asm volatile("s_waitcnt lgkmcnt(0)" ::: "memory")
#define VM_WAIT() asm volatile("s_waitcnt vmcnt(0)" ::: "memory")
__device__ __forceinline__ unsigned f2bf(float f) { unsigned u = __builtin_bit_cast(unsigned, f); return (u + 0x7fffu + ((u >> 16) & 1u)) >> 16; }
__device__ __forceinline__ unsigned pk2(float lo, float hi) { return f2bf(lo) | (f2bf(hi) << 16); }
__device__ __forceinline__ float bf2f(unsigned short h) { return __builtin_bit_cast(float, (unsigned)h << 16); }

constexpr int NWAVES = 8, NT = 512;
constexpr int RING_BYTES = 131072, LDSCTL_OFF = RING_BYTES, LDS_BYTES = 147456;
constexpr size_t MiB = 1u << 20;
constexpr size_t WS_CTL = 0, CTL_ZERO_BYTES = 1 * MiB;
constexpr size_t WS_MOD = 1 * MiB, WS_KEYS = 2 * MiB, WS_WIN = 4 * MiB, WS_WOUT = 12 * MiB, WS_WQ = 16 * MiB, WS_H = 24 * MiB, WS_X1 = 56 * MiB;
constexpr size_t WS_EIDX = 120 * MiB, WS_GATE = 128 * MiB, WS_A = 136 * MiB, WS_MIX = 200 * MiB, WS_U = 232 * MiB, WS_V = 264 * MiB, WS_END = 296 * MiB;
constexpr size_t WS_SU = 3 * MiB, WS_SV = 3 * MiB + 512 * 1024;
constexpr size_t WS_T1 = 232 * MiB, WS_T2 = 360 * MiB, WS_TEND = 488 * MiB;
constexpr int CW_BAR = 4096;

enum { PH_PRO = 0, PH_H0 = 1, PH_L0 = 2, PH_PER_LAYER = 7, PH_G1 = 0, PH_AT = 1, PH_G2 = 2, PH_N2 = 3, PH_G3 = 4, PH_TK = 5, PH_PE = 6, PH_END = PH_L0 + 2 * PH_PER_LAYER, PH_H1 = 100 };

struct Args { const float* in[19]; float* out; unsigned char* ws; int ph_lo, ph_hi; };

__device__ __forceinline__ void p0_transpose_item(const float* W, int K, int N, bf16* WT, LAS float* scr, int item, int lane) {
    const int nblk = N / 32, kb = item / nblk, nb = item % nblk, k0 = 64 * kb, n0 = 32 * nb;
#pragma unroll 8
    for (int i = 0; i < 32; ++i) { const int kk = 2 * i + (lane >> 5); scr[kk * 33 + (lane & 31)] = W[(size_t)(k0 + kk) * N + n0 + (lane & 31)]; }
    LDS_WAIT(); asm volatile("" ::: "memory");
    const int c = lane & 7;
#pragma unroll
    for (int j = 0; j < 4; ++j) { const int n = (lane >> 3) + 8 * j; const LAS float* s = scr + (8 * c) * 33 + n;
        v4u o; o.x = pk2(s[0 * 33], s[1 * 33]); o.y = pk2(s[2 * 33], s[3 * 33]); o.z = pk2(s[4 * 33], s[5 * 33]); o.w = pk2(s[6 * 33], s[7 * 33]);
        *(GAS v4u*)(WT + (size_t)(n0 + n) * K + k0 + 8 * c) = o; }
    LDS_WAIT(); asm volatile("" ::: "memory");
}
__device__ __forceinline__ float wave_sum(float v) {
#pragma unroll
    for (int o = 1; o < 64; o <<= 1) v += __shfl_xor(v, o);
    return v;
}
__device__ __forceinline__ void hmod_row(const float* xrow, const float* g, const float* mod_b, int which, bf16* orow, int lane) {
    const GAS f32x4* xr = (const GAS f32x4*)xrow + lane;
    f32x4 v[4]; float s = 0.f;
#pragma unroll
    for (int j = 0; j < 4; ++j) { v[j] = xr[64 * j]; s += (v[j].x * v[j].x + v[j].y * v[j].y) + (v[j].z * v[j].z + v[j].w * v[j].w); }
    const float rstd = 1.0f / sqrtf(wave_sum(s) * (1.f / D) + EPS);
    const float* shp = mod_b + (which * 3 + 0) * D; const float* scp = mod_b + (which * 3 + 1) * D;
    GAS unsigned long long* o8 = (GAS unsigned long long*)orow + lane;
#pragma unroll
    for (int j = 0; j < 4; ++j) { const int k = 4 * lane + 256 * j;
        const f32x4 gg = *(const f32x4*)(g + k), sh = *(const f32x4*)(shp + k), sc = *(const f32x4*)(scp + k);
        const f32x4 hv = v[j] * rstd * gg * (sc + 1.0f) + sh;
        o8[64 * j] = (unsigned long long)pk2(hv.x, hv.y) | ((unsigned long long)pk2(hv.z, hv.w) << 32); }
}


#define MK_GW(wave) (((gridDim.x % 8 == 0) ? (blockIdx.x % 8) * (gridDim.x / 8) + blockIdx.x / 8 : blockIdx.x) * NWAVES + (wave))
#define MK_NGW (gridDim.x * NWAVES)

__device__ __forceinline__ void ph_prologue(const Args& args, LAS unsigned char* lds) {
    const int tid = threadIdx.x, lane = tid & 63, wave = __builtin_amdgcn_readfirstlane(tid >> 6);
    const int G = gridDim.x, bx = blockIdx.x;
    unsigned char* ws = args.ws;
    {
        const float* c = args.in[1]; const float* w_ada = args.in[5]; const float* b_ada = args.in[6]; float* mod = (float*)(ws + WS_MOD);
        LAS float* sact = (LAS float*)lds; LAS float* red = (LAS float*)(lds + 32768);
        for (int i = tid; i < B * D; i += NT) { const float cv = c[i]; sact[i] = cv / (1.0f + __expf(-cv)); }
        __syncthreads();
        for (int item = bx; item < DEPTH * (6 * D / 32); item += G) {
            const int l = item / (6 * D / 32), n0 = (item % (6 * D / 32)) * 32, cc = tid & 31, kg = tid >> 5;
            float acc[B];
#pragma unroll
            for (int b = 0; b < B; ++b) acc[b] = 0.f;
            const float* w = w_ada + (size_t)l * D * 6 * D + n0 + cc;
            for (int kk = 0; kk < 64; ++kk) { const int k = kg * 64 + kk; const float wv = w[(size_t)k * 6 * D];
#pragma unroll
                for (int b = 0; b < B; ++b) acc[b] += sact[b * D + k] * wv; }
#pragma unroll
            for (int b = 0; b < B; ++b) red[(kg * 32 + cc) * B + b] = acc[b];
            __syncthreads();
            if (tid < 32 * B) { const int c2 = tid & 31, b = tid >> 5; float s = 0.f;
                for (int k2 = 0; k2 < 16; ++k2) s += red[(k2 * 32 + c2) * B + b];
                mod[((size_t)l * B + b) * 6 * D + n0 + c2] = s + b_ada[(size_t)l * 6 * D + n0 + c2]; }
            __syncthreads();
        }
    }
    const int gw = MK_GW(wave), NGW = MK_NGW;
    {
        const float* w_in = args.in[7]; const float* w_out = args.in[14]; const float* peer_wq = args.in[15];
        bf16* WinT = (bf16*)(ws + WS_WIN); bf16* WoutT = (bf16*)(ws + WS_WOUT); bf16* WqT = (bf16*)(ws + WS_WQ);
        LAS float* scr = (LAS float*)(lds + wave * 16384);
        constexpr int I_IN = (D / 64) * (INW / 32), I_OUT = (D / 64) * (D / 32), I_Q = (D / 64) * (PW / 32), I_L = I_IN + I_OUT + I_Q;
        for (int it = gw; it < DEPTH * I_L; it += NGW) {
            const int l = it / I_L; int r = it % I_L;
            if (r < I_IN) { p0_transpose_item(w_in + (size_t)l * D * INW, D, INW, WinT + (size_t)l * INW * D, scr, r, lane); continue; } r -= I_IN;
            if (r < I_OUT) { p0_transpose_item(w_out + (size_t)l * D * D, D, D, WoutT + (size_t)l * D * D, scr, r, lane); continue; } r -= I_OUT;
            p0_transpose_item(peer_wq + (size_t)l * D * PW, D, PW, WqT + (size_t)l * PW * D, scr, r, lane);
        }
    }
    {
        const float* peer_keys = args.in[16]; bf16* keysb = (bf16*)(ws + WS_KEYS);
        for (int i = gw * 64 + lane; i < DEPTH * 2 * NK * 128 / 2; i += NGW * 64) ((GAS unsigned*)keysb)[i] = pk2(peer_keys[2 * i], peer_keys[2 * i + 1]);
    }
    {
        const float* peer_u = args.in[17]; const float* peer_v = args.in[18];
        unsigned char* U8 = ws + WS_U; unsigned char* V8 = ws + WS_V; float* SU = (float*)(ws + WS_SU); float* SV = (float*)(ws + WS_SV);
        for (int r = gw; r < 2 * DEPTH * NE; r += NGW) {
            const int tb = r / (DEPTH * NE), row = r % (DEPTH * NE);
            const GAS f32x4* src = (const GAS f32x4*)((tb ? peer_v : peer_u) + (size_t)row * D) + lane;
            f32x4 v[4]; float am = 0.f;
#pragma unroll
            for (int j = 0; j < 4; ++j) { v[j] = src[64 * j]; am = fmaxf(am, fmaxf(fmaxf(fabsf(v[j].x), fabsf(v[j].y)), fmaxf(fabsf(v[j].z), fabsf(v[j].w)))); }
#pragma unroll
            for (int o = 1; o < 64; o <<= 1) am = fmaxf(am, __shfl_xor(am, o));
            const float sc = am > 0.f ? am * (1.0f / 448.0f) : 1.0f, inv = 1.0f / sc;
            GAS unsigned* dst = (GAS unsigned*)((tb ? V8 : U8) + (size_t)row * D) + lane;
#pragma unroll
            for (int j = 0; j < 4; ++j) { int p = 0; p = __builtin_amdgcn_cvt_pk_fp8_f32(v[j].x * inv, v[j].y * inv, p, false); p = __builtin_amdgcn_cvt_pk_fp8_f32(v[j].z * inv, v[j].w * inv, p, true); dst[64 * j] = (unsigned)p; }
            if (lane == 0) (tb ? SV : SU)[row] = sc;
        }
    }
}
template <int L, int WHICH> __device__ __forceinline__ void ph_hmod(const Args& args) {
    const int lane = threadIdx.x & 63, wave = __builtin_amdgcn_readfirstlane(threadIdx.x >> 6);
    unsigned char* ws = args.ws;
    const float* src = WHICH ? (const float*)(ws + WS_X1) : (L == 0 ? args.in[0] : args.out);
    const float* g = args.in[WHICH ? 4 : 3] + L * D; const float* mod_l = (const float*)(ws + WS_MOD) + (size_t)L * B * 6 * D; bf16* Hb = (bf16*)(ws + WS_H);
    const int gw = MK_GW(wave), NGW = MK_NGW;
    for (int m = gw; m < T; m += NGW) hmod_row(src + (size_t)m * D, g, mod_l + (size_t)(m / S) * 6 * D, WHICH, Hb + (size_t)m * D, lane);
}
template <int L> __device__ __forceinline__ void ph_g1(const Args& args, LAS unsigned char* lds) {
    unsigned char* ws = args.ws;
    pg8::Gemm g{(const bf16*)(ws + WS_H), (const bf16*)(ws + WS_WIN) + (size_t)L * INW * D, T, INW, D}; pg8::StaticOrder SO; SO.init(T, INW, gridDim.x, blockIdx.x);
#if Z_F32
    pg8::EpiF32 E{(float*)(ws + WS_T1), INW};
    pg8::gemm_phase<pg8::EpiF32, pg8::StaticOrder, true, true>(lds, g, SO, E);
#else
    pg8::EpiBf16<0> E{(bf16*)(ws + WS_A), INW, nullptr, 0, 0, 1.f};
    pg8::gemm_phase<pg8::EpiBf16<0>, pg8::StaticOrder, true, true>(lds, g, SO, E);
#endif
}
template <int L> __device__ __forceinline__ void ph_g2(const Args& args, LAS unsigned char* lds) {
    unsigned char* ws = args.ws;
    pg8::Gemm g{(const bf16*)(ws + WS_MIX), (const bf16*)(ws + WS_WOUT) + (size_t)L * D * D, T, D, D}; pg8::StaticOrder SO; SO.init(T, D, gridDim.x, blockIdx.x);
    pg8::EpiResid E{L == 0 ? args.in[0] : args.out, (float*)(ws + WS_X1), D, (const float*)(ws + WS_MOD) + (size_t)L * B * 6 * D + 2 * D, S, 6 * D};
    pg8::gemm_phase<pg8::EpiResid, pg8::StaticOrder, true, true>(lds, g, SO, E);
}
template <int L> __device__ __forceinline__ void ph_g3(const Args& args, LAS unsigned char* lds) {
    unsigned char* ws = args.ws;
    pg8::Gemm g{(const bf16*)(ws + WS_H), (const bf16*)(ws + WS_WQ) + (size_t)L * PW * D, T, PW, D}; pg8::StaticOrder SO; SO.init(T, PW, gridDim.x, blockIdx.x);
#if QP_F32
    pg8::EpiF32 E{(float*)(ws + WS_T1), PW};
    pg8::gemm_phase<pg8::EpiF32, pg8::StaticOrder, true, true>(lds, g, SO, E);
#else
    pg8::EpiBf16<0> E{(bf16*)(ws + WS_A), PW, nullptr, 0, 0, 1.f};
    pg8::gemm_phase<pg8::EpiBf16<0>, pg8::StaticOrder, true, true>(lds, g, SO, E);
#endif
}
}

namespace mk {
#define XB_TMO      128
#define XB_XCNT(j)  (256  + 64 * (j))
#define XB_XSUB(j)  (1280 + 64 * (j))
#define XB_XGEN(j)  (2304 + 64 * (j))
#define XB_TOP      3328
#define XB_TOPGEN   3392
#define XCD_BAR_WORDS 3456
#define XB_SPIN_CAP (1u << 18)

__device__ __forceinline__ unsigned xb_ld(unsigned* p)              { return __hip_atomic_load(p, __ATOMIC_RELAXED, __HIP_MEMORY_SCOPE_AGENT); }
__device__ __forceinline__ unsigned xb_add(unsigned* p, unsigned v) { return __hip_atomic_fetch_add(p, v, __ATOMIC_RELAXED, __HIP_MEMORY_SCOPE_AGENT); }
__device__ __forceinline__ unsigned xb_xcc_id() { return (unsigned)__builtin_amdgcn_s_getreg((3 << 11) | 20) & 0xFu; }
#define XB_SPIN(cond, bar) do { unsigned _sp = 0; while (cond) { __builtin_amdgcn_s_sleep(1); \
    if ((++_sp & 255u) == 0u) { if (xb_ld(&(bar)[XB_TMO])) break; if (_sp > XB_SPIN_CAP) { atomicAdd(&(bar)[XB_TMO], 1u); break; } } } } while (0)

struct XcdBarrier {
    unsigned* bar; unsigned x;
    volatile LAS unsigned* st;
};

__device__ __forceinline__ XcdBarrier xcd_barrier_post(unsigned* bar, volatile LAS unsigned* st) {
    XcdBarrier b; b.bar = bar; b.x = xb_xcc_id(); b.st = st;
    if (threadIdx.x == 0) (void)xb_add(&bar[XB_XCNT(b.x)], 1u);
    return b;
}
__device__ __forceinline__ void xcd_barrier_complete(unsigned* bar, unsigned x, unsigned& nloc, unsigned& nx) {
    const unsigned G = gridDim.x * gridDim.y * gridDim.z;
    unsigned sum, cnt, mine, sp = 0u;
    for (;;) {
        sum = 0u; cnt = 0u; mine = 0u;
#pragma unroll
        for (unsigned j = 0; j < 16; ++j) { const unsigned c = xb_ld(&bar[XB_XCNT(j)]); sum += c; cnt += (c > 0u) ? 1u : 0u; mine = (j == x) ? c : mine; }
        if (sum == G) break;
        __builtin_amdgcn_s_sleep(1);
        if ((++sp & 255u) == 0u) { if (xb_ld(&bar[XB_TMO])) break; if (sp > XB_SPIN_CAP) { atomicAdd(&bar[XB_TMO], 1u); break; } }
    }
    nloc = mine > 0u ? mine : 1u; nx = cnt > 0u ? cnt : 1u;
}

__device__ __forceinline__ void xcd_barrier(const XcdBarrier& b) {
    asm volatile("s_waitcnt vmcnt(0)" ::: "memory");
    __syncthreads();
    if (threadIdx.x == 0) {
        unsigned* bar = b.bar;
        __builtin_amdgcn_s_waitcnt(0);
        unsigned nloc = b.st[0], nx = b.st[1];
        if (nloc == 0u) { xcd_barrier_complete(bar, b.x, nloc, nx); b.st[0] = nloc; b.st[1] = nx; }
        const unsigned old = xb_add(&bar[XB_XSUB(b.x)], 1u);
        const unsigned gen = old / nloc;
        if (old + 1u == (gen + 1u) * nloc) {
            __builtin_amdgcn_fence(__ATOMIC_RELEASE, "agent");
            asm volatile("s_waitcnt vmcnt(0)" ::: "memory");
            const unsigned og = xb_add(&bar[XB_TOP], 1u);
            const unsigned tg = og / nx;
            if (og + 1u == (tg + 1u) * nx) xb_add(&bar[XB_TOPGEN], 1u);
            else XB_SPIN(xb_ld(&bar[XB_TOPGEN]) == tg, bar);
            __builtin_amdgcn_fence(__ATOMIC_ACQUIRE, "agent");
            xb_add(&bar[XB_XGEN(b.x)], 1u);
            asm volatile("s_waitcnt vmcnt(0)" ::: "memory");
        } else {
            XB_SPIN(xb_ld(&bar[XB_XGEN(b.x)]) == gen, bar);
            __builtin_amdgcn_fence(__ATOMIC_ACQUIRE, "agent");
            asm volatile("s_waitcnt vmcnt(0)" ::: "memory");
        }
    }
    __syncthreads();
}

}


namespace mk {
typedef short bf16x8 __attribute__((ext_vector_type(8)));
typedef float f32x16 __attribute__((ext_vector_type(16)));
__device__ __forceinline__ unsigned f2sort(float f) { const unsigned u = __builtin_bit_cast(unsigned, f); return u ^ ((unsigned)((int)u >> 31) | 0x80000000u); }
__device__ __forceinline__ float sort2f(unsigned s) { const unsigned m = (unsigned)((int)s >> 31); return __builtin_bit_cast(float, s ^ (~m | 0x80000000u)); }
__device__ __forceinline__ unsigned umax_(unsigned a, unsigned b) { return a > b ? a : b; }
__device__ __forceinline__ unsigned umin_(unsigned a, unsigned b) { return a < b ? a : b; }
__device__ __forceinline__ void sort16_desc(unsigned (&v)[16]) {
#pragma unroll
    for (int k = 2; k <= 16; k <<= 1)
#pragma unroll
        for (int j = k >> 1; j > 0; j >>= 1)
#pragma unroll
            for (int i = 0; i < 16; ++i) { const int l = i ^ j; if (l > i) { const unsigned a = v[i], b = v[l], mx = umax_(a, b), mn = umin_(a, b);
                if ((i & k) == 0) { v[i] = mx; v[l] = mn; } else { v[i] = mn; v[l] = mx; } } }
}
__device__ __forceinline__ void merge16_desc(unsigned (&a)[16], const unsigned (&b)[16]) {
#pragma unroll
    for (int i = 0; i < 16; ++i) a[i] = umax_(a[i], b[15 - i]);
#pragma unroll
    for (int j = 8; j > 0; j >>= 1)
#pragma unroll
        for (int i = 0; i < 16; ++i) { const int l = i ^ j; if (l > i) { const unsigned x = a[i], y = a[l]; a[i] = umax_(x, y); a[l] = umin_(x, y); } }
}
__device__ __forceinline__ void xmerge16_desc(unsigned (&a)[16]) {
    unsigned p[16];
#pragma unroll
    for (int i = 0; i < 16; ++i) p[i] = (unsigned)__shfl_xor((int)a[i], 32);
    merge16_desc(a, p);
}
#define TK_CANDS \
    TKC(0, 0, 0, 2, 1) \
    TKC(1, 0, 1, 2, 2) \
    TKC(2, 0, 2, 2, 3) \
    TKC(3, 0, 3, 2, 4) \
    TKC(4, 0, 4, 3, 0) \
    TKC(5, 0, 5, 3, 1) \
    TKC(6, 0, 6, 3, 2) \
    TKC(7, 0, 7, 3, 3) \
    TKC(8, 0, 8, 4, 0) \
    TKC(9, 0, 9, 4, 1) \
    TKC(10, 0, 10, 4, 2) \
    TKC(11, 0, 11, 5, 0) \
    TKC(12, 0, 12, 5, 1) \
    TKC(13, 0, 13, 6, 0) \
    TKC(14, 0, 14, 6, 1) \
    TKC(15, 0, 15, 7, 0) \
    TKC(16, 1, 0, 7, 1) \
    TKC(17, 1, 1, 8, 0) \
    TKC(18, 1, 2, 9, 0) \
    TKC(19, 1, 3, 10, 0) \
    TKC(20, 1, 4, 11, 0) \
    TKC(21, 1, 5, 12, 0) \
    TKC(22, 1, 6, 13, 0) \
    TKC(23, 1, 7, 14, 0) \
    TKC(24, 2, 0, 15, 0)

template <int L> __device__ __forceinline__ void ph_topk(const Args& args, LAS unsigned char* lds) {
    const int tid = threadIdx.x, lane = tid & 63, wave = __builtin_amdgcn_readfirstlane(tid >> 6);
    const int c = lane & 31, hi = lane >> 5;
    unsigned char* ws = args.ws;
    const bf16* keysb = (const bf16*)(ws + WS_KEYS) + (size_t)L * 2 * NK * 128;
    const bf16* qp = (const bf16*)(ws + WS_A);
    int* eidx = (int*)(ws + WS_EIDX); float* gate = (float*)(ws + WS_GATE);
    constexpr int KROW = 272;
    for (int ch = tid; ch < 256 * 16; ch += NT) { const int r = ch >> 4, cc = ch & 15; *(LAS v4u*)(lds + r * KROW + cc * 16) = *(const GAS v4u*)(keysb + r * 128 + cc * 8); }
    __syncthreads();
    LAS unsigned* wl = (LAS unsigned*)(lds + 256 * KROW + wave * 4096) + c * 32;
    const int gw = MK_GW(wave), NGW = MK_NGW;
    const unsigned h4 = 4u * (unsigned)hi;
    for (int pass = gw; pass < T * PH / 32; pass += NGW) {
        const int row = pass * 32 + c;
        const bf16* qrow = qp + (size_t)row * 256 + hi * 8;
        unsigned top[2][16];
#pragma unroll
        for (int half = 0; half < 2; ++half) {
            bf16x8 bq[8];
#pragma unroll
            for (int ks = 0; ks < 8; ++ks) bq[ks] = *(const GAS bf16x8*)(qrow + half * 128 + ks * 16);
            f32x16 acc[4];
#pragma unroll
            for (int mt = 0; mt < 4; ++mt)
#pragma unroll
                for (int r = 0; r < 16; ++r) acc[mt][r] = 0.f;
#pragma unroll
            for (int ks = 0; ks < 8; ++ks)
#pragma unroll
                for (int mt = 0; mt < 4; ++mt) { const bf16x8 a = *(const LAS bf16x8*)(lds + (half * 128 + mt * 32 + c) * KROW + (ks * 16 + hi * 8) * 2);
                    acc[mt] = __builtin_amdgcn_mfma_f32_32x32x16_bf16(a, bq[ks], acc[mt], 0, 0, 0); }
            unsigned g[4][16];
#pragma unroll
            for (int mt = 0; mt < 4; ++mt)
#pragma unroll
                for (int r = 0; r < 16; ++r) { const unsigned code = (unsigned)(127 - mt * 32 - (r & 3) - 8 * (r >> 2)) - h4;
                    g[mt][r] = (f2sort(acc[mt][r]) & ~127u) | code; }
#pragma unroll
            for (int mt = 0; mt < 4; ++mt) sort16_desc(g[mt]);
            merge16_desc(g[0], g[1]); merge16_desc(g[2], g[3]); merge16_desc(g[0], g[2]);
            xmerge16_desc(g[0]);
#pragma unroll
            for (int i = 0; i < 16; ++i) top[half][i] = g[0][i];
        }
#pragma unroll
        for (int q = 0; q < 4; ++q) { v4u w;
            w.x = hi ? top[1][4 * q + 0] : top[0][4 * q + 0]; w.y = hi ? top[1][4 * q + 1] : top[0][4 * q + 1];
            w.z = hi ? top[1][4 * q + 2] : top[0][4 * q + 2]; w.w = hi ? top[1][4 * q + 3] : top[0][4 * q + 3];
            *(LAS v4u*)(wl + hi * 16 + 4 * q) = w; }
        float v1[16], v2[16];
#pragma unroll
        for (int i = 0; i < 16; ++i) { v1[i] = sort2f(top[0][i] & ~127u); v2[i] = sort2f(top[1][i] & ~127u); }
        unsigned cd[2][16];
#pragma unroll
        for (int i = 0; i < 16; ++i) { cd[0][i] = 0u; cd[1][i] = 0u; }
#define TKC(q, i0, j0, i1, j1) { const float sm = hi ? (v1[i1] + v2[j1]) : (v1[i0] + v2[j0]); const unsigned code = hi ? (unsigned)(255 - ((i1) * 16 + (j1))) : (unsigned)(255 - ((i0) * 16 + (j0))); \
            cd[(q) >> 4][(q) & 15] = (f2sort(sm) & ~255u) | code; }
        TK_CANDS
#undef TKC
        sort16_desc(cd[0]); sort16_desc(cd[1]); merge16_desc(cd[0], cd[1]); xmerge16_desc(cd[0]);
        float ev[16]; int ex[16]; float den = 0.f;
        const float vmax = sort2f(cd[0][0] & ~255u);
#pragma unroll
        for (int r = 0; r < 16; ++r) { const unsigned key = cd[0][r], pos = 255u - (key & 255u);
            const unsigned k1 = wl[pos >> 4], k2 = wl[16 + (pos & 15u)];
            ex[r] = (int)((127u - (k1 & 127u)) * 128u + (127u - (k2 & 127u)));
            ev[r] = __expf(sort2f(key & ~255u) - vmax); den += ev[r]; }
        const float inv = 1.0f / den;
        if (hi == 0) {
#pragma unroll
            for (int q = 0; q < 4; ++q) { v4u w; w.x = (unsigned)ex[4 * q]; w.y = (unsigned)ex[4 * q + 1]; w.z = (unsigned)ex[4 * q + 2]; w.w = (unsigned)ex[4 * q + 3]; *(GAS v4u*)(eidx + (size_t)row * 16 + 4 * q) = w; }
        } else {
#pragma unroll
            for (int q = 0; q < 4; ++q) { f32x4 w; w.x = ev[4 * q] * inv; w.y = ev[4 * q + 1] * inv; w.z = ev[4 * q + 2] * inv; w.w = ev[4 * q + 3] * inv; *(GAS f32x4*)(gate + (size_t)row * 16 + 4 * q) = w; }
        }
    }
}
}


namespace mk {
typedef short bf16x4v __attribute__((ext_vector_type(4)));
__device__ __forceinline__ unsigned cvt_pk_bf16(float lo, float hi) { unsigned r; asm volatile("v_cvt_pk_bf16_f32 %0, %1, %2" : "=v"(r) : "v"(lo), "v"(hi)); return r; }
__device__ __forceinline__ void head_prep(const bf16* src  , const float* g, int h, int pos, float scl, v4u (&outp)[4]) {
    float v[4][8]; float ss = 0.f;
#pragma unroll
    for (int ks = 0; ks < 4; ++ks) { const v4u w = *(const GAS v4u*)(src + ks * 16);
        const unsigned ww[4] = {w.x, w.y, w.z, w.w};
#pragma unroll
        for (int q = 0; q < 4; ++q) { v[ks][2 * q] = __builtin_bit_cast(float, ww[q] << 16); v[ks][2 * q + 1] = __builtin_bit_cast(float, ww[q] & 0xffff0000u); }
#pragma unroll
        for (int j = 0; j < 8; ++j) ss += v[ks][j] * v[ks][j]; }
    ss += __shfl_xor(ss, 32);
    const float r = scl / sqrtf(ss * (1.0f / 64.0f) + EPS);
#pragma unroll
    for (int ks = 0; ks < 4; ++ks) { const f32x4 g0 = *(const f32x4*)(g + ks * 16 + 8 * h), g1 = *(const f32x4*)(g + ks * 16 + 8 * h + 4);
        v[ks][0] *= r * g0.x; v[ks][1] *= r * g0.y; v[ks][2] *= r * g0.z; v[ks][3] *= r * g0.w; v[ks][4] *= r * g1.x; v[ks][5] *= r * g1.y; v[ks][6] *= r * g1.z; v[ks][7] *= r * g1.w; }
#pragma unroll
    for (int i = 0; i < 8; ++i) { const float other = __shfl_xor(v[0][i], 32);
        constexpr float INVF[8] = {1.0f, 0.1939227432012558f, 0.03760603070259094f, 0.007292664609849453f, 0.0014142135623842478f, 0.00027424818836152554f, 5.318296098266728e-05f, 1.0313386155758053e-05f};
        float rev = ((float)pos * INVF[i]) * 0.15915494309189535f; rev -= floorf(rev);
        const float sn = __builtin_amdgcn_sinf(rev), cs = __builtin_amdgcn_cosf(rev);
        v[0][i] = h ? (v[0][i] * cs + other * sn) : (v[0][i] * cs - other * sn); }
#pragma unroll
    for (int ks = 0; ks < 4; ++ks) { outp[ks].x = pk2(v[ks][0], v[ks][1]); outp[ks].y = pk2(v[ks][2], v[ks][3]); outp[ks].z = pk2(v[ks][4], v[ks][5]); outp[ks].w = pk2(v[ks][6], v[ks][7]); }
}

template <int L> __device__ __forceinline__ void ph_mixer(const Args& args, LAS unsigned char* lds) {
    const int tid = threadIdx.x, lane = tid & 63, wave = __builtin_amdgcn_readfirstlane(tid >> 6);
    const int c = lane & 31, hi = lane >> 5;
    unsigned char* ws = args.ws;
    const bf16* z = (const bf16*)(ws + WS_A); bf16* mix = (bf16*)(ws + WS_MIX);
    const int* positions = (const int*)args.in[2];
    const float* qg = args.in[8] + L * 64; const float* kg = args.in[9] + L * 64; const float* sink = args.in[10] + L * NQH;
    const float* conv_w = args.in[11] + L * 3 * 256; const float* pool_w = args.in[12] + (size_t)L * 4 * 64 * 64; const float* pool_scale = args.in[13] + L * 256;
    constexpr int KROW = 144, VROW = 776, K_OFF = 0, V_OFF = 384 * KROW, P_OFF = V_OFF + 64 * VROW, PROW = 68;
    constexpr int NQB = S / 128;
    for (int unit = blockIdx.x; unit < B * NKVH * NQB; unit += gridDim.x) {
        const int qb = unit % NQB, kvh = (unit / NQB) % NKVH, b = unit / (NQB * NKVH);
        const int tok0 = b * S, kbase = qb * 128 - 128;
        __syncthreads();
        for (int pass = wave; pass < 12; pass += NWAVES) { const int kr = pass * 32 + c, kp = kbase + kr;
            if (kp >= 0 && kp < S) {
                v4u o[4]; head_prep(z + (size_t)(tok0 + kp) * INW + OK_ + kvh * 64 + 8 * hi, kg, hi, positions[tok0 + kp], 1.0f, o);
#pragma unroll
                for (int ks = 0; ks < 4; ++ks) *(LAS v4u*)(lds + K_OFF + kr * KROW + (ks * 16 + 8 * hi) * 2) = o[ks]; } }
        for (int ch = tid; ch < 384 * 8; ch += NT) { const int kr = ch >> 3, dc = ch & 7, kp = kbase + kr;
            if (kp >= 0 && kp < S) { const v4u w = *(const GAS v4u*)(z + (size_t)(tok0 + kp) * INW + OV + kvh * 64 + dc * 8);
                const unsigned ww[4] = {w.x, w.y, w.z, w.w};
#pragma unroll
                for (int q = 0; q < 4; ++q) { *(LAS unsigned short*)(lds + V_OFF + (dc * 8 + 2 * q) * VROW + kr * 2) = (unsigned short)(ww[q] & 0xffffu);
                                              *(LAS unsigned short*)(lds + V_OFF + (dc * 8 + 2 * q + 1) * VROW + kr * 2) = (unsigned short)(ww[q] >> 16); } } }
        __syncthreads();
        {
            const int g = wave >> 1, qh = wave & 1, hq = kvh * GRP + g;
            const float sk = sink[hq];
#pragma unroll 1
            for (int qt = 0; qt < 2; ++qt) {
                const int a = qb * 128 + qh * 64 + qt * 32;
                const int tq = tok0 + a + c;
                v4u qf[4]; head_prep(z + (size_t)tq * INW + OQ + hq * 64 + 8 * hi, qg, hi, positions[tq], 0.125f, qf);
                bf16x8 bq[4];
#pragma unroll
                for (int ks = 0; ks < 4; ++ks) bq[ks] = __builtin_bit_cast(bf16x8, qf[ks]);
                float m = sk, lsum = hi ? 0.f : 1.f;
                f32x16 O0, O1;
#pragma unroll
                for (int r = 0; r < 16; ++r) { O0[r] = 0.f; O1[r] = 0.f; }
#pragma unroll 1
                for (int kt = 0; kt < 9; ++kt) {
                    const int kp0 = a - 128 + 32 * kt;
                    if (kp0 < 0 || kp0 >= S) continue;
                    const int kr0 = kp0 - kbase;
                    f32x16 sa;
#pragma unroll
                    for (int r = 0; r < 16; ++r) sa[r] = 0.f;
#pragma unroll
                    for (int ks = 0; ks < 4; ++ks) { const bf16x8 ka = *(const LAS bf16x8*)(lds + K_OFF + (kr0 + c) * KROW + (ks * 16 + 8 * hi) * 2);
                        sa = __builtin_amdgcn_mfma_f32_32x32x16_bf16(ka, bq[ks], sa, 0, 0, 0); }
                    if (kt == 0) {
#pragma unroll
                        for (int r = 0; r < 16; ++r) { const int i = (r & 3) + 8 * (r >> 2) + 4 * hi; if (i < c) sa[r] = -1e30f; }
                    } else if (kt == 8) {
#pragma unroll
                        for (int r = 0; r < 16; ++r) { const int i = (r & 3) + 8 * (r >> 2) + 4 * hi; if (i > c) sa[r] = -1e30f; }
                    }
                    float mx = sa[0];
#pragma unroll
                    for (int r = 1; r < 16; ++r) mx = fmaxf(mx, sa[r]);
                    mx = fmaxf(mx, __shfl_xor(mx, 32));
                    const float mn = fmaxf(m, mx), al = __expf(m - mn);
                    m = mn;
                    float p[16]; float rs = 0.f;
#pragma unroll
                    for (int r = 0; r < 16; ++r) { p[r] = __expf(sa[r] - mn); rs += p[r]; }
                    lsum = lsum * al + rs;
#pragma unroll
                    for (int r = 0; r < 16; ++r) { O0[r] *= al; O1[r] *= al; }
#pragma unroll
                    for (int s2 = 0; s2 < 2; ++s2) {
                        v4u pw; pw.x = cvt_pk_bf16(p[8 * s2 + 0], p[8 * s2 + 1]); pw.y = cvt_pk_bf16(p[8 * s2 + 2], p[8 * s2 + 3]); pw.z = cvt_pk_bf16(p[8 * s2 + 4], p[8 * s2 + 5]); pw.w = cvt_pk_bf16(p[8 * s2 + 6], p[8 * s2 + 7]);
                        const bf16x8 pb = __builtin_bit_cast(bf16x8, pw);
#pragma unroll
                        for (int mt = 0; mt < 2; ++mt) { const LAS unsigned char* vp = lds + V_OFF + (mt * 32 + c) * VROW + (kr0 + 16 * s2 + 4 * hi) * 2;
                            const v2u lo2 = *(const LAS v2u*)vp, hi2 = *(const LAS v2u*)(vp + 16);
                            v4u va; va.x = lo2.x; va.y = lo2.y; va.z = hi2.x; va.w = hi2.y;
                            if (mt == 0) O0 = __builtin_amdgcn_mfma_f32_32x32x16_bf16(__builtin_bit_cast(bf16x8, va), pb, O0, 0, 0, 0);
                            else         O1 = __builtin_amdgcn_mfma_f32_32x32x16_bf16(__builtin_bit_cast(bf16x8, va), pb, O1, 0, 0, 0); }
                    }
                }
                const float inv = 1.0f / (lsum + __shfl_xor(lsum, 32));
                bf16* orow = mix + (size_t)tq * D + hq * 64 + 4 * hi;
#pragma unroll
                for (int q = 0; q < 4; ++q) { v2u w0, w1;
                    w0.x = pk2(O0[4 * q] * inv, O0[4 * q + 1] * inv); w0.y = pk2(O0[4 * q + 2] * inv, O0[4 * q + 3] * inv);
                    w1.x = pk2(O1[4 * q] * inv, O1[4 * q + 1] * inv); w1.y = pk2(O1[4 * q + 2] * inv, O1[4 * q + 3] * inv);
                    *(GAS v2u*)(orow + 8 * q) = w0; *(GAS v2u*)(orow + 32 + 8 * q) = w1; }
            }
        }
        if (kvh == 0) {
            const int cp = tid & 127, tg = tid >> 7;
            const float w0a = conv_w[2 * cp], w0b = conv_w[2 * cp + 1], w1a = conv_w[256 + 2 * cp], w1b = conv_w[256 + 2 * cp + 1], w2a = conv_w[512 + 2 * cp], w2b = conv_w[512 + 2 * cp + 1];
            const int s0 = qb * 128 + tg * 32;
            float upa = 0.f, upb = 0.f, uca, ucb;
            { const bf16* zr = z + (size_t)(tok0 + s0) * INW;
              const unsigned cx = *(const GAS unsigned*)(zr + OCX + 2 * cp), cc = *(const GAS unsigned*)(zr + OCC + 2 * cp);
              uca = bf2f((unsigned short)(cx & 0xffffu)) * bf2f((unsigned short)(cc & 0xffffu)); ucb = bf2f((unsigned short)(cx >> 16)) * bf2f((unsigned short)(cc >> 16));
              if (s0 > 0) { const bf16* zp = zr - INW; const unsigned px = *(const GAS unsigned*)(zp + OCX + 2 * cp), pc = *(const GAS unsigned*)(zp + OCC + 2 * cp);
                  upa = bf2f((unsigned short)(px & 0xffffu)) * bf2f((unsigned short)(pc & 0xffffu)); upb = bf2f((unsigned short)(px >> 16)) * bf2f((unsigned short)(pc >> 16)); } }
            for (int i = 0; i < 32; ++i) { const int s = s0 + i; const bf16* zr = z + (size_t)(tok0 + s) * INW;
                float una = 0.f, unb = 0.f;
                if (s + 1 < S) { const unsigned nx = *(const GAS unsigned*)(zr + INW + OCX + 2 * cp), nc = *(const GAS unsigned*)(zr + INW + OCC + 2 * cp);
                    una = bf2f((unsigned short)(nx & 0xffffu)) * bf2f((unsigned short)(nc & 0xffffu)); unb = bf2f((unsigned short)(nx >> 16)) * bf2f((unsigned short)(nc >> 16)); }
                const unsigned cb = *(const GAS unsigned*)(zr + OCB + 2 * cp);
                const float oa = bf2f((unsigned short)(cb & 0xffffu)) * (w0a * upa + w1a * uca + w2a * una), ob = bf2f((unsigned short)(cb >> 16)) * (w0b * upb + w1b * ucb + w2b * unb);
                *(GAS unsigned*)(mix + (size_t)(tok0 + s) * D + 512 + 2 * cp) = pk2(oa, ob);
                upa = uca; upb = ucb; uca = una; ucb = unb; }
        }
#pragma unroll 1
        for (int gi = 0; gi < 2; ++gi) {
            const int gq = kvh * 2 + gi, half = 1 << gq;
            __syncthreads();
            { const int tt = tid >> 2, cq = tid & 3, s = qb * 128 + tt;
              int lo = s - half, hi2 = s + half; lo = lo < 0 ? 0 : lo; hi2 = hi2 > S ? S : hi2;
              float acc[16];
#pragma unroll
              for (int j = 0; j < 16; ++j) acc[j] = 0.f;
              for (int ss = lo; ss < hi2; ++ss) { const bf16* zp = z + (size_t)(tok0 + ss) * INW + OPX + gq * 64 + cq * 16;
                  const v4u w0 = *(const GAS v4u*)zp, w1 = *(const GAS v4u*)(zp + 8); const unsigned ww[8] = {w0.x, w0.y, w0.z, w0.w, w1.x, w1.y, w1.z, w1.w};
#pragma unroll
                  for (int q = 0; q < 8; ++q) { acc[2 * q] += __builtin_bit_cast(float, ww[q] << 16); acc[2 * q + 1] += __builtin_bit_cast(float, ww[q] & 0xffff0000u); } }
              const float icnt = 1.0f / (float)(hi2 - lo);
              const bf16* zc = z + (size_t)(tok0 + s) * INW + OPX + gq * 64 + cq * 16;
              const v4u w0 = *(const GAS v4u*)zc, w1 = *(const GAS v4u*)(zc + 8); const unsigned ww[8] = {w0.x, w0.y, w0.z, w0.w, w1.x, w1.y, w1.z, w1.w};
              LAS float* pr = (LAS float*)(lds + P_OFF) + tt * PROW + cq * 16;
#pragma unroll
              for (int q = 0; q < 8; ++q) { pr[2 * q] = acc[2 * q] * icnt - __builtin_bit_cast(float, ww[q] << 16); pr[2 * q + 1] = acc[2 * q + 1] * icnt - __builtin_bit_cast(float, ww[q] & 0xffff0000u); } }
            __syncthreads();
            { const int e = tid & 63, tq8 = tid >> 6;
              float acc[16];
#pragma unroll
              for (int j = 0; j < 16; ++j) acc[j] = 0.f;
              const float* pw = pool_w + (size_t)gq * 64 * 64 + e;
              for (int c4 = 0; c4 < 16; ++c4) { const float wa = pw[(4 * c4) * 64], wb = pw[(4 * c4 + 1) * 64], wc = pw[(4 * c4 + 2) * 64], wd = pw[(4 * c4 + 3) * 64];
#pragma unroll
                  for (int tt = 0; tt < 16; ++tt) { const f32x4 pv = *(const LAS f32x4*)((LAS float*)(lds + P_OFF) + (tq8 * 16 + tt) * PROW + 4 * c4);
                      acc[tt] += pv.x * wa + pv.y * wb + pv.z * wc + pv.w * wd; } }
              const float sc = pool_scale[gq * 64 + e];
#pragma unroll
              for (int tt = 0; tt < 16; ++tt) mix[(size_t)(tok0 + qb * 128 + tq8 * 16 + tt) * D + 768 + gq * 64 + e] = (bf16)f2bf(acc[tt] * sc); }
        }
    }
}
}


namespace mk {
typedef float f32x2v __attribute__((ext_vector_type(2)));
__device__ __forceinline__ float gelu_erf(float x) { return 0.5f * x * (1.0f + erff(x * 0.70710678118654752f)); }


#define XP_SUB(j) (3456 + 64 * (j))
#define XP_GEN(j) (3456 + 1024 + 64 * (j))
__device__ __forceinline__ void xcd_local_sync(const XcdBarrier& b) {
    __syncthreads();
    if (threadIdx.x == 0) {
        const unsigned nloc = b.st[0] ? b.st[0] : 1u;
        const unsigned old = xb_add(&b.bar[XP_SUB(b.x)], 1u), gen = old / nloc;
        if (old + 1u == (gen + 1u) * nloc) xb_add(&b.bar[XP_GEN(b.x)], 1u);
        else XB_SPIN(xb_ld(&b.bar[XP_GEN(b.x)]) == gen, b.bar);
    }
    __syncthreads();
}


__device__ __forceinline__ void sort128(unsigned& k0, unsigned& k1, int lane_in) {
    int ln = lane_in; asm volatile("" : "+v"(ln));
#pragma unroll
    for (int lk = 1; lk <= 7; ++lk)
#pragma unroll
        for (int lj = lk - 1; lj >= 0; --lj) {
            if (lj == 6) { const unsigned mn = umin_(k0, k1), mx = umax_(k0, k1); k0 = mn; k1 = mx; }
            else { const unsigned bj = (unsigned)__builtin_amdgcn_sbfe(ln, lj, 1);
                const unsigned bk0 = (lk >= 7) ? 0u : (lk == 6 ? 0u : (unsigned)__builtin_amdgcn_sbfe(ln, lk, 1));
                const unsigned bk1 = (lk >= 7) ? 0u : (lk == 6 ? ~0u : (unsigned)__builtin_amdgcn_sbfe(ln, lk, 1));
                const unsigned f0 = bj ^ bk0, f1 = bj ^ bk1;
                const unsigned p0 = (unsigned)__shfl_xor((int)k0, 1 << lj), p1 = (unsigned)__shfl_xor((int)k1, 1 << lj);
                k0 = umin_(k0 ^ f0, p0 ^ f0) ^ f0; k1 = umin_(k1 ^ f1, p1 ^ f1) ^ f1; } }
}

__device__ __forceinline__ void peer_batch8(__amdgpu_buffer_rsrc_t U8, __amdgpu_buffer_rsrc_t V8, const unsigned (&hp)[8], int ev, float suv, float cv, int lbase, float (&y)[16], int lane, int b5, int b4, int b3) {
    asm volatile("" ::: "memory");
    v4u ua[8], va[8];
#pragma unroll
    for (int j = 0; j < 8; ++j) { const int ek = __builtin_amdgcn_readlane(ev, lbase + j);
        ua[j] = __builtin_amdgcn_raw_buffer_load_b128(U8, 16 * lane, ek * D, 0); va[j] = __builtin_amdgcn_raw_buffer_load_b128(V8, 16 * lane, ek * D, 0); }
    float hf[16];
#pragma unroll
    for (int q = 0; q < 8; ++q) { hf[2 * q] = __builtin_bit_cast(float, hp[q] << 16); hf[2 * q + 1] = __builtin_bit_cast(float, hp[q] & 0xffff0000u); }
    float p[8];
#pragma unroll
    for (int j = 0; j < 8; ++j) { unsigned uw[4] = {ua[j].x, ua[j].y, ua[j].z, ua[j].w}; float s = 0.f;
        if (j >= 2) asm volatile("" : "+v"(uw[0]), "+v"(uw[1]), "+v"(uw[2]), "+v"(uw[3]) : "v"(p[j - 2]));
#pragma unroll
        for (int d = 0; d < 4; ++d) { const f32x2v lo = __builtin_amdgcn_cvt_pk_f32_fp8((int)uw[d], false), hi = __builtin_amdgcn_cvt_pk_f32_fp8((int)uw[d], true);
            s += lo.x * hf[4 * d] + lo.y * hf[4 * d + 1] + hi.x * hf[4 * d + 2] + hi.y * hf[4 * d + 3]; }
        p[j] = s; }
    float q4[4], q2[2], sd;
#pragma unroll
    for (int i = 0; i < 4; ++i) { const float snd = b5 ? p[i] : p[i + 4]; const float rcv = __shfl_xor(snd, 32); q4[i] = (b5 ? p[i + 4] : p[i]) + rcv; }
#pragma unroll
    for (int i = 0; i < 2; ++i) { const float snd = b4 ? q4[i] : q4[i + 2]; const float rcv = __shfl_xor(snd, 16); q2[i] = (b4 ? q4[i + 2] : q4[i]) + rcv; }
    { const float snd = b3 ? q2[0] : q2[1]; const float rcv = __shfl_xor(snd, 8); sd = (b3 ? q2[1] : q2[0]) + rcv; }
    sd += __shfl_xor(sd, 4); sd += __shfl_xor(sd, 2); sd += __shfl_xor(sd, 1);
    const int jl = 4 * b5 + 2 * b4 + b3;
    const float w = __shfl(cv, lbase + jl) * gelu_erf(sd * __shfl(suv, lbase + jl));
#pragma unroll
    for (int j = 0; j < 8; ++j) { const float wj = __builtin_bit_cast(float, __builtin_amdgcn_readlane(__builtin_bit_cast(int, w), 32 * ((j >> 2) & 1) + 16 * ((j >> 1) & 1) + 8 * (j & 1)));
        unsigned vw[4] = {va[j].x, va[j].y, va[j].z, va[j].w};
        asm volatile("" : "+v"(vw[0]), "+v"(vw[1]), "+v"(vw[2]), "+v"(vw[3]) : "s"(wj));
#pragma unroll
        for (int d = 0; d < 4; ++d) { const f32x2v lo = __builtin_amdgcn_cvt_pk_f32_fp8((int)vw[d], false), hi = __builtin_amdgcn_cvt_pk_f32_fp8((int)vw[d], true);
            y[4 * d] += wj * lo.x; y[4 * d + 1] += wj * lo.y; y[4 * d + 2] += wj * hi.x; y[4 * d + 3] += wj * hi.y; } }
}

template <int L> __device__ __forceinline__ void ph_peer(const Args& args, const XcdBarrier& bar) {
    const int lane = threadIdx.x & 63, wave = __builtin_amdgcn_readfirstlane(threadIdx.x >> 6);
    unsigned char* ws = args.ws;
    const __amdgpu_buffer_rsrc_t U8 = __builtin_amdgcn_make_buffer_rsrc(ws + WS_U + (size_t)L * NE * D, 0, NE * D, 0x00020000);
    const __amdgpu_buffer_rsrc_t V8 = __builtin_amdgcn_make_buffer_rsrc(ws + WS_V + (size_t)L * NE * D, 0, NE * D, 0x00020000);
    const float* SU = (const float*)(ws + WS_SU) + L * NE; const float* SV = (const float*)(ws + WS_SV) + L * NE;
    const bf16* Hb = (const bf16*)(ws + WS_H); const float* X1 = (const float*)(ws + WS_X1);
    const int* eidx = (const int*)(ws + WS_EIDX); const float* gate = (const float*)(ws + WS_GATE);
    const float* mod = (const float*)(ws + WS_MOD);
    float* outp = args.out;
    const int b5 = (lane >> 5) & 1, b4 = (lane >> 4) & 1, b3 = (lane >> 3) & 1;
    const int gw = MK_GW(wave), NGW = MK_NGW;
    constexpr int NTOK = PE_NTOK;
#pragma unroll 1
    for (int sw = 0; sw < T / NTOK; sw += NGW) {
        unsigned hp[NTOK][8]; int e0[NTOK], e1[NTOK]; float su0[NTOK], su1[NTOK], c0[NTOK], c1[NTOK]; float y[NTOK][16];
#pragma unroll
        for (int q = 0; q < NTOK; ++q) { const int t = (sw + gw) * NTOK + q;
            const v4u h0 = *(const GAS v4u*)(Hb + (size_t)t * D + 16 * lane), h1 = *(const GAS v4u*)(Hb + (size_t)t * D + 16 * lane + 8);
            hp[q][0] = h0.x; hp[q][1] = h0.y; hp[q][2] = h0.z; hp[q][3] = h0.w; hp[q][4] = h1.x; hp[q][5] = h1.y; hp[q][6] = h1.z; hp[q][7] = h1.w;
            unsigned k0 = ((unsigned)eidx[(size_t)t * 128 + lane] << 7) | (unsigned)lane, k1 = ((unsigned)eidx[(size_t)t * 128 + 64 + lane] << 7) | (unsigned)(64 + lane);
            sort128(k0, k1, lane);
            e0[q] = (int)(k0 >> 7); e1[q] = (int)(k1 >> 7);
            su0[q] = SU[e0[q]]; su1[q] = SU[e1[q]];
            c0[q] = gate[(size_t)t * 128 + (k0 & 127u)] * SV[e0[q]]; c1[q] = gate[(size_t)t * 128 + (k1 & 127u)] * SV[e1[q]];
#pragma unroll
            for (int i = 0; i < 16; ++i) y[q][i] = 0.f;
            asm volatile("" ::: "memory"); }
#pragma unroll 1
        for (int bt = 0; bt < 16; ++bt) {
#if PE_SYNC
            if ((bt % PE_SYNC) == 0) xcd_local_sync(bar);
#endif
            const int lbase = (bt & 7) * 8;
#pragma unroll
            for (int q = 0; q < NTOK; ++q)
                peer_batch8(U8, V8, hp[q], (bt < 8) ? e0[q] : e1[q], (bt < 8) ? su0[q] : su1[q], (bt < 8) ? c0[q] : c1[q], lbase, y[q], lane, b5, b4, b3);
        }
#pragma unroll
        for (int q = 0; q < NTOK; ++q) { const int t = (sw + gw) * NTOK + q;
            asm volatile("" ::: "memory");
            const float* g2 = mod + ((size_t)L * B + t / S) * 6 * D + 5 * D;
            float xo[16]; float ssq = 0.f;
#pragma unroll
            for (int hf4 = 0; hf4 < 4; ++hf4) { const int col = 16 * lane + 4 * hf4;
                const f32x4 xv = *(const GAS f32x4*)(X1 + (size_t)t * D + col), gg = *(const f32x4*)(g2 + col);
                f32x4 o; o.x = xv.x + gg.x * y[q][4 * hf4 + 0]; o.y = xv.y + gg.y * y[q][4 * hf4 + 1]; o.z = xv.z + gg.z * y[q][4 * hf4 + 2]; o.w = xv.w + gg.w * y[q][4 * hf4 + 3];
                *(GAS f32x4*)(outp + (size_t)t * D + col) = o;
                xo[4 * hf4 + 0] = o.x; xo[4 * hf4 + 1] = o.y; xo[4 * hf4 + 2] = o.z; xo[4 * hf4 + 3] = o.w;
                ssq += (o.x * o.x + o.y * o.y) + (o.z * o.z + o.w * o.w); }
            if (L + 1 < DEPTH) {
                const float rstd = 1.0f / sqrtf(wave_sum(ssq) * (1.f / D) + EPS);
                const float* g = args.in[3] + (L + 1) * D; const float* mb = mod + ((size_t)(L + 1) * B + t / S) * 6 * D;
                float hv[16];
#pragma unroll
                for (int hf4 = 0; hf4 < 4; ++hf4) { const int col = 16 * lane + 4 * hf4;
                    const f32x4 gg = *(const f32x4*)(g + col), sh = *(const f32x4*)(mb + col), sc = *(const f32x4*)(mb + D + col);
                    hv[4 * hf4 + 0] = xo[4 * hf4 + 0] * rstd * gg.x * (1.0f + sc.x) + sh.x; hv[4 * hf4 + 1] = xo[4 * hf4 + 1] * rstd * gg.y * (1.0f + sc.y) + sh.y;
                    hv[4 * hf4 + 2] = xo[4 * hf4 + 2] * rstd * gg.z * (1.0f + sc.z) + sh.z; hv[4 * hf4 + 3] = xo[4 * hf4 + 3] * rstd * gg.w * (1.0f + sc.w) + sh.w; }
#pragma unroll
                for (int pc = 0; pc < 2; ++pc) { v4u o; o.x = pk2(hv[8 * pc + 0], hv[8 * pc + 1]); o.y = pk2(hv[8 * pc + 2], hv[8 * pc + 3]); o.z = pk2(hv[8 * pc + 4], hv[8 * pc + 5]); o.w = pk2(hv[8 * pc + 6], hv[8 * pc + 7]);
                    *(GAS v4u*)((bf16*)(ws + WS_H) + (size_t)t * D + 16 * lane + 8 * pc) = o; }
            }
        }
    }
}
}

namespace mk {
constexpr int LDS_XB_OFF = LDS_BYTES - 64;
template <int L> __device__ __forceinline__ void layer_phases(const Args& args, LAS unsigned char* lds, const XcdBarrier& bar) {
    const int lo = args.ph_lo, hi = args.ph_hi;
#define IN(k) (lo <= (k) && (k) < hi)
#define SEAM(k) do { if (IN(k) && IN((k) + 1)) xcd_barrier(bar); } while (0)
    constexpr int pb = PH_L0 + L * PH_PER_LAYER;
    if (IN(pb + PH_G1)) for (int rep = 0; rep < REP_GEMM; ++rep) ph_g1<L>(args, lds);
    SEAM(pb + PH_G1);
    if (IN(pb + PH_AT)) for (int rep = 0; rep < REP_AT; ++rep) ph_mixer<L>(args, lds);
    SEAM(pb + PH_AT);
    if (IN(pb + PH_G2)) for (int rep = 0; rep < REP_GEMM; ++rep) ph_g2<L>(args, lds);
    SEAM(pb + PH_G2);
    if (IN(pb + PH_N2)) for (int rep = 0; rep < REP_N2; ++rep) ph_hmod<L, 1>(args);
    SEAM(pb + PH_N2);
    if (IN(pb + PH_G3)) for (int rep = 0; rep < REP_GEMM; ++rep) ph_g3<L>(args, lds);
    SEAM(pb + PH_G3);
    if (IN(pb + PH_TK)) for (int rep = 0; rep < REP_TK; ++rep) ph_topk<L>(args, lds);
    SEAM(pb + PH_TK);
    if (IN(pb + PH_PE)) for (int rep = 0; rep < (L == 1 ? REP_PE1 : 1); ++rep) ph_peer<L>(args, bar);
    if (L + 1 < DEPTH) SEAM(pb + PH_PE);
#undef SEAM
#undef IN
}

__global__ void __launch_bounds__(NT, 2) mk_fwd(Args args) {
    extern __shared__ __attribute__((aligned(16))) unsigned char lds_raw[];
    LAS unsigned char* lds = (LAS unsigned char*)lds_raw;
    const int lo = args.ph_lo, hi = args.ph_hi;
    if (threadIdx.x < 16) ((LAS unsigned*)(lds + LDS_XB_OFF))[threadIdx.x] = 0u;
    __syncthreads();
    XcdBarrier bar; bar.bar = (unsigned*)(args.ws + WS_CTL) + CW_BAR; bar.x = 0; bar.st = nullptr;
    if (hi - lo > 1) bar = xcd_barrier_post((unsigned*)(args.ws + WS_CTL) + CW_BAR, (volatile LAS unsigned*)(lds + LDS_XB_OFF));
#define IN(k) (lo <= (k) && (k) < hi)
#define SEAM(k) do { if (IN(k) && IN((k) + 1)) xcd_barrier(bar); } while (0)
    if (IN(PH_PRO)) for (int rep = 0; rep < REP_PRO; ++rep) ph_prologue(args, lds);
    SEAM(PH_PRO);
    if (IN(PH_H0)) ph_hmod<0, 0>(args);
    SEAM(PH_H0);
    layer_phases<0>(args, lds, bar);
    layer_phases<1>(args, lds, bar);
#undef SEAM
#undef IN
}
}


extern "C" void kernel_launch(void* const* d_in, const int* in_sizes, int n_in, void* d_out, int out_size, void* d_ws, size_t ws_size, hipStream_t stream) {
    using namespace mk;
    static int grid = 0;
    if (grid == 0) {
        if (n_in != 19 || ws_size < WS_END || out_size != T * D) { fprintf(stderr, "kernel_launch: bad n_in %d / out_size %d / ws_size %zu\n", n_in, out_size, ws_size); grid = -1; return; }
        int dev = 0, cus = 0, per_cu = 0;
        if (hipGetDevice(&dev) != hipSuccess || hipDeviceGetAttribute(&cus, hipDeviceAttributeMultiprocessorCount, dev) != hipSuccess) { grid = -1; return; }
        if (hipFuncSetAttribute((const void*)mk_fwd, hipFuncAttributeMaxDynamicSharedMemorySize, LDS_BYTES) != hipSuccess) { fprintf(stderr, "hipFuncSetAttribute failed\n"); grid = -1; return; }
        if (hipOccupancyMaxActiveBlocksPerMultiprocessor(&per_cu, (const void*)mk_fwd, NT, LDS_BYTES) != hipSuccess) per_cu = 0;
        (void)hipGetLastError();
        grid = (per_cu >= 1) ? cus : -1;
        if (grid < 0) { fprintf(stderr, "kernel_launch: occupancy query says %d workgroups per CU; nothing launched\n", per_cu); return; }
    }
    if (grid < 0) return;
    unsigned char* ws = (unsigned char*)d_ws;
    (void)hipMemsetAsync(ws + WS_CTL, 0, CTL_ZERO_BYTES, stream);
    Args a{};
    for (int i = 0; i < 19; ++i) a.in[i] = (const float*)d_in[i];
    a.out = (float*)d_out; a.ws = ws;
#if MK_SPLIT
    for (int ph = 0; ph < PH_END; ++ph) { a.ph_lo = ph; a.ph_hi = ph + 1;
        const int pl = ph >= PH_L0 ? (ph - PH_L0) % PH_PER_LAYER : -1;
        const int reps = (pl == PH_G1 || pl == PH_G2 || pl == PH_G3) ? HREP_GEMM : (pl == PH_AT) ? HREP_AT : (pl == PH_TK) ? HREP_TK : (pl == PH_N2 || ph == PH_H0) ? HREP_N2 : (ph == PH_PRO) ? HREP_PRO : 1;
        for (int rep = 0; rep < reps; ++rep) hipLaunchKernelGGL(mk_fwd, dim3(grid), dim3(NT), LDS_BYTES, stream, a); }
#else
    a.ph_lo = 0; a.ph_hi = PH_END;
    hipLaunchKernelGGL(mk_fwd, dim3(grid), dim3(NT), LDS_BYTES, stream, a);
#endif
}
```

```cpp
#include <hip/hip_runtime.h>
#include <stdint.h>
#include <math.h>
#include <cstdio>

#ifndef BATCH
#define BATCH 8
#endif
#ifndef SEQ
#define SEQ 2048
#endif
#ifndef MK_SPLIT
#define MK_SPLIT 0
#endif
#define Z_F32 0
#ifndef HREP_GEMM
#define HREP_GEMM 1
#endif
#ifndef HREP_AT
#define HREP_AT 1
#endif
#ifndef HREP_TK
#define HREP_TK 1
#endif
#ifndef HREP_N2
#define HREP_N2 1
#endif
#ifndef HREP_PRO
#define HREP_PRO 1
#endif
#ifndef PE_SYNC
#define PE_SYNC 0
#endif
#ifndef PE_NTOK
#define PE_NTOK 1
#endif
#ifndef REP_PRO
#define REP_PRO 1
#endif
#ifndef REP_GEMM
#define REP_GEMM 1
#endif
#ifndef REP_AT
#define REP_AT 1
#endif
#ifndef REP_TK
#define REP_TK 1
#endif
#ifndef REP_PE1
#define REP_PE1 1
#endif
#ifndef REP_N2
#define REP_N2 1
#endif
#define QP_F32 0
#define DO_UV 1

namespace cfg {
constexpr int B = BATCH, S = SEQ, T = B * S, D = 1024, DEPTH = 2;
constexpr int HDIM = 64, NQH = 8, NKVH = 2, GRP = 4, WIN = 128;
constexpr int INW = 1792, OQ = 0, OK_ = 512, OV = 640, OCX = 768, OCB = 1024, OCC = 1280, OPX = 1536;
constexpr int PH = 8, NK = 128, NE = 16384, QD = 256, TOPK = 16, PW = 2048;
constexpr float EPS = 1e-6f;
}
using namespace cfg;

namespace pg8 {
#define PG8_LAS __attribute__((address_space(3)))
typedef unsigned short bf16_t;
typedef short bf16x8 __attribute__((ext_vector_type(8)));
typedef float f32x4 __attribute__((ext_vector_type(4)));
typedef unsigned u32x4 __attribute__((ext_vector_type(4)));
constexpr int BM = 256, BK = 64, HALF = 128, HTB = HALF * BK * 2  , STAGE_BYTES = 8 * HTB, NXCD = 8, WGM = 8;

__host__ __device__ __forceinline__ int lds_byte(int r, int c) { const int st = (r >> 4) * 2 + (c >> 5), rr = r & 15, cc = c & 31, ob = rr * 64 + cc * 2; return st * 1024 + (ob ^ (((ob >> 9) & 1) << 5)); }
__host__ __device__ __forceinline__ void stage_rc(int b, int& R, int& C) { const int st = b / 1024, sb = b % 1024, swz = sb ^ (((sb >> 9) & 1) << 5); R = (st >> 1) * 16 + swz / 64; C = (st & 1) * 32 + (swz % 64) / 2; }
__host__ __device__ __forceinline__ int perm32(int rho) { const int n = rho >> 4, i = rho & 15; return 8 * (i >> 2) + 4 * n + (i & 3); }

struct Unit { int pm, pn; };
struct Gemm { const bf16_t* A; const bf16_t* Bt; int M, N, K; };

struct StaticOrder {
    int nM, nN, nwg, G, c;
    __host__ __device__ void init(int M, int N, int G_, int c_) { nM = M / BM; nN = N / BM; nwg = nM * nN; G = G_; c = c_; }
    __host__ __device__ bool next(int i, Unit& u) const {
        const long L = (long)i * G + c; if (L >= nwg) return false;
        int wgid = (int)L; { const int q = nwg / NXCD, r = nwg % NXCD, xcd = wgid % NXCD, off = wgid / NXCD; wgid = (xcd < r ? xcd * (q + 1) : r * (q + 1) + (xcd - r) * q) + off; }
        const int nig = WGM * nN, gid = wgid / nig, fm = gid * WGM, gsz = (nM - fm) < WGM ? (nM - fm) : WGM;
        u.pm = fm + ((wgid % nig) % gsz); u.pn = (wgid % nig) / gsz; return true;
    }
    __device__ __forceinline__ void a_ready(const Unit&) const {}
    __device__ __forceinline__ void done(const Unit&) const {}
};

__device__ __forceinline__ unsigned cvt_pk_bf16(float lo, float hi) { unsigned r; asm volatile("v_cvt_pk_bf16_f32 %0, %1, %2" : "=v"(r) : "v"(lo), "v"(hi)); return r; }
typedef float f32x2 __attribute__((ext_vector_type(2)));
__device__ __forceinline__ f32x2 gelu_pk(f32x2 v) {
    const f32x2 av = __builtin_elementwise_abs(v), d = av * 0.2316418882f + 1.0f;
    f32x2 t; t.x = __builtin_amdgcn_rcpf(d.x); t.y = __builtin_amdgcn_rcpf(d.y);
    f32x2 q = t * 0.5307027145f + (-0.7265760135f); q = q * t + 0.7107068705f; q = q * t + (-0.142248368f); q = q * t + 0.127414796f; q = q * t;
    const f32x2 s = (v * v) * (-0.72134752044f);
    f32x2 e; e.x = __builtin_amdgcn_exp2f(s.x); e.y = __builtin_amdgcn_exp2f(s.y);
    const f32x2 m = v * (q * e), r = v - m;
    f32x2 o; o.x = v.x < 0.f ? m.x : r.x; o.y = v.y < 0.f ? m.y : r.y; return o;
}

template <int ACT  > struct EpiBf16 {
    static constexpr bool PERM = true, AFTER_DRAIN = false; static_assert(ACT == 0 || ACT == 1, "EpiBf16: ACT is 0 (none) or 1 (gelu_pk)");
    bf16_t* O; int ldc; const float* bias; int split_cols; size_t split_stride; float scale0;
    __device__ __forceinline__ void operator()(const f32x4 (&acc)[2][2][4][2], const Unit& u, int wr, int wc, int fr, int fq) const {
        const int row0 = u.pm * BM + wr * 64 + fr; int colt = u.pn * BM; bf16_t* base = O;
        float sc = 1.f; if (split_cols) { const int t = colt / split_cols; base += (size_t)t * split_stride; colt -= t * split_cols; if (t == 0) sc = scale0; }
        const int col0 = colt + wc * 32 + 8 * fq, bcol0 = u.pn * BM + wc * 32 + 8 * fq;
        f32x4 bv[2][2];
#pragma unroll
        for (int bj = 0; bj < 2; ++bj)
#pragma unroll
            for (int n = 0; n < 2; ++n) bv[bj][n] = bias ? *(const f32x4*)(bias + bcol0 + bj * HALF + 4 * n) : (f32x4){0.f, 0.f, 0.f, 0.f};
#pragma unroll
        for (int ai = 0; ai < 2; ++ai)
#pragma unroll
            for (int m = 0; m < 4; ++m) { bf16_t* rowp = base + (size_t)(row0 + ai * HALF + m * 16) * ldc + col0;
#pragma unroll
                for (int bj = 0; bj < 2; ++bj) { f32x4 v0 = acc[ai][bj][m][0] + bv[bj][0], v1 = acc[ai][bj][m][1] + bv[bj][1];
                    if (ACT == 1) { f32x2 a = gelu_pk((f32x2){v0[0], v0[1]}), b = gelu_pk((f32x2){v0[2], v0[3]}), c = gelu_pk((f32x2){v1[0], v1[1]}), d = gelu_pk((f32x2){v1[2], v1[3]});
                        v0 = (f32x4){a.x, a.y, b.x, b.y}; v1 = (f32x4){c.x, c.y, d.x, d.y}; }
                    v0 = v0 * sc; v1 = v1 * sc; u32x4 w; w.x = cvt_pk_bf16(v0[0], v0[1]); w.y = cvt_pk_bf16(v0[2], v0[3]); w.z = cvt_pk_bf16(v1[0], v1[1]); w.w = cvt_pk_bf16(v1[2], v1[3]);
                    *(u32x4*)(rowp + bj * HALF) = w; } }
    }
};

template <class Epi, class Sched, bool ALIGN_EPI = false, bool SP2 = false>
__device__ __forceinline__ void gemm_phase(PG8_LAS unsigned char* lds, const Gemm g, const Sched& S, const Epi& E) {
    const int tid = threadIdx.x, wid = __builtin_amdgcn_readfirstlane(tid >> 6), lane = tid & 63, wr = wid >> 2, wc = wid & 3, fr = lane & 15, fq = lane >> 4;
    const int K = g.K, nt = K / BK;
    unsigned voffA[2], voffB[2];
#pragma unroll
    for (int i = 0; i < 2; ++i) { int R, C; stage_rc(tid * 16 + i * 8192, R, C); const int Rb = Epi::PERM ? ((R & ~31) + perm32(R & 31)) : R;
        voffA[i] = (unsigned)(R * K + C) * 2u; voffB[i] = (unsigned)(Rb * K + C) * 2u; }
    const size_t kstep = (size_t)(BK * 2);
    const size_t hstep = (size_t)HALF * K * 2;
    const size_t tstep = 2 * hstep;
    const unsigned ldsw = (unsigned)wid * 1024u;
    const int aoff = lds_byte(wr * 64 + fr, fq * 8), boff = lds_byte(wc * 32 + fr, fq * 8);
#define PG8_SA(b, h) (((b) * 2 + (h)) * HTB)
#define PG8_SB(b, h) ((4 + (b) * 2 + (h)) * HTB)
#define PG8_STAGE(bufoff, gbase, voff) do { _Pragma("unroll") for (int _i = 0; _i < 2; ++_i) \
        __builtin_amdgcn_global_load_lds((const unsigned*)((const char*)(gbase) + (voff)[_i]), (PG8_LAS unsigned*)(lds + (bufoff) + ldsw + _i * 8192), 16, 0, 0); } while (0)
#define PG8_LDA(dst, b, h) do { _Pragma("unroll") for (int m = 0; m < 4; ++m) _Pragma("unroll") for (int k = 0; k < 2; ++k) dst[m][k] = *(const PG8_LAS bf16x8*)(lds + PG8_SA(b, h) + aoff + m * 2048 + k * 1024); } while (0)
#define PG8_LDB(dst, b, h) do { _Pragma("unroll") for (int n = 0; n < 2; ++n) _Pragma("unroll") for (int k = 0; k < 2; ++k) dst[n][k] = *(const PG8_LAS bf16x8*)(lds + PG8_SB(b, h) + boff + n * 2048 + k * 1024); } while (0)
#define PG8_MMA(ai, bj, At, Bt) do { __builtin_amdgcn_s_setprio(1); _Pragma("unroll") for (int m = 0; m < 4; ++m) _Pragma("unroll") for (int n = 0; n < 2; ++n) _Pragma("unroll") for (int k = 0; k < 2; ++k) \
        acc[ai][bj][m][n] = __builtin_amdgcn_mfma_f32_16x16x32_bf16(Bt[n][k], At[m][k], acc[ai][bj][m][n], 0, 0, 0); __builtin_amdgcn_s_setprio(0); } while (0)
#define PG8_WAIT_V(n) asm volatile("s_waitcnt vmcnt(" #n ")" ::: "memory")
#define PG8_WAIT_L(n) asm volatile("s_waitcnt lgkmcnt(" #n ")" ::: "memory")
#define PG8_BAR __builtin_amdgcn_s_barrier()
#define PG8_SCHED __builtin_amdgcn_sched_barrier(0)
    Unit cur, nxt; int ui = 0;
    if (!S.next(0, cur)) return;
    f32x4 acc[2][2][4][2];
#pragma unroll
    for (int a = 0; a < 2; ++a)
#pragma unroll
        for (int b = 0; b < 2; ++b)
#pragma unroll
            for (int m = 0; m < 4; ++m)
#pragma unroll
                for (int n = 0; n < 2; ++n) acc[a][b][m][n] = (f32x4){0.f, 0.f, 0.f, 0.f};
    bf16x8 At[4][2], B0[2][2], B1[2][2];
    const char* cA = (const char*)g.A + (size_t)cur.pm * tstep; const char* cB = (const char*)g.Bt + (size_t)cur.pn * tstep;
    S.a_ready(cur);
    if constexpr (SP2) {
        PG8_STAGE(PG8_SB(0, 0), cB, voffB); PG8_STAGE(PG8_SB(0, 1), cB + hstep, voffB); PG8_STAGE(PG8_SA(0, 0), cA, voffA); PG8_STAGE(PG8_SA(0, 1), cA + hstep, voffA);
        if (wr == 1) PG8_BAR;
        PG8_WAIT_V(2); PG8_BAR;
        PG8_STAGE(PG8_SB(1, 0), cB + kstep, voffB); PG8_STAGE(PG8_SA(1, 0), cA + kstep, voffA); PG8_STAGE(PG8_SB(1, 1), cB + hstep + kstep, voffB);
        PG8_WAIT_V(6); PG8_BAR;
    } else {
        PG8_STAGE(PG8_SB(0, 0), cB, voffB); PG8_STAGE(PG8_SA(0, 0), cA, voffA); PG8_STAGE(PG8_SB(0, 1), cB + hstep, voffB); PG8_STAGE(PG8_SA(0, 1), cA + hstep, voffA);
        if (wr == 1) PG8_BAR;
        PG8_WAIT_V(4); PG8_BAR;
        PG8_STAGE(PG8_SB(1, 0), cB + kstep, voffB); PG8_STAGE(PG8_SA(1, 0), cA + kstep, voffA); PG8_STAGE(PG8_SB(1, 1), cB + hstep + kstep, voffB);
        PG8_WAIT_V(6); PG8_BAR;
    }
    for (;;) {
        const bool has_next = S.next(ui + 1, nxt);
        const char* nA = has_next ? (const char*)g.A + (size_t)nxt.pm * tstep : cA; const char* nB = has_next ? (const char*)g.Bt + (size_t)nxt.pn * tstep : cB;
        for (int t = 0; t < nt; t += 2) {
            const bool last = (t == nt - 2);
            const char* a1 = cA + (size_t)(t + 1) * kstep;
            const char* a2 = last ? nA : cA + (size_t)(t + 2) * kstep; const char* b2 = last ? nB : cB + (size_t)(t + 2) * kstep;
            const char* a3 = a2 + kstep; const char* b3 = b2 + kstep;
            if (last && has_next) S.a_ready(nxt);
            if constexpr (SP2) {
            PG8_LDB(B0, 0, 0); PG8_LDB(B1, 0, 1); PG8_SCHED; PG8_LDA(At, 0, 0); PG8_STAGE(PG8_SA(1, 1), a1 + hstep, voffA);
            PG8_WAIT_V(8); PG8_WAIT_L(0); PG8_BAR; PG8_MMA(0, 0, At, B0); PG8_MMA(0, 1, At, B1); PG8_BAR; PG8_SCHED;
            PG8_LDA(At, 0, 1); PG8_STAGE(PG8_SB(0, 0), b2, voffB); PG8_STAGE(PG8_SB(0, 1), b2 + hstep, voffB); PG8_STAGE(PG8_SA(0, 0), a2, voffA);
            PG8_WAIT_V(8); PG8_WAIT_L(0); PG8_BAR; PG8_MMA(1, 0, At, B0); PG8_MMA(1, 1, At, B1); PG8_BAR; PG8_SCHED;
            PG8_LDB(B0, 1, 0); PG8_LDB(B1, 1, 1); PG8_SCHED; PG8_LDA(At, 1, 0); PG8_STAGE(PG8_SA(0, 1), a2 + hstep, voffA);
            PG8_WAIT_V(8); PG8_WAIT_L(0); PG8_BAR; PG8_MMA(0, 0, At, B0); PG8_MMA(0, 1, At, B1); PG8_BAR; PG8_SCHED;
            PG8_LDA(At, 1, 1); PG8_STAGE(PG8_SB(1, 0), b3, voffB); PG8_STAGE(PG8_SB(1, 1), b3 + hstep, voffB); PG8_STAGE(PG8_SA(1, 0), a3, voffA);
            PG8_WAIT_V(8); PG8_WAIT_L(0); PG8_BAR; PG8_MMA(1, 0, At, B0); PG8_MMA(1, 1, At, B1); PG8_BAR; PG8_SCHED;
            } else {
            PG8_LDB(B0, 0, 0); PG8_SCHED; PG8_LDA(At, 0, 0); PG8_STAGE(PG8_SA(1, 1), a1 + hstep, voffA);
            PG8_WAIT_L(8); PG8_BAR; PG8_WAIT_L(0); PG8_MMA(0, 0, At, B0); PG8_BAR; PG8_SCHED;
            PG8_LDB(B1, 0, 1); PG8_STAGE(PG8_SB(0, 0), b2, voffB);
            PG8_BAR; PG8_WAIT_L(0); PG8_MMA(0, 1, At, B1); PG8_BAR;
            PG8_LDA(At, 0, 1); PG8_STAGE(PG8_SA(0, 0), a2, voffA);
            PG8_BAR; PG8_WAIT_L(0); PG8_MMA(1, 0, At, B0); PG8_BAR; PG8_SCHED;
            PG8_STAGE(PG8_SB(0, 1), b2 + hstep, voffB);
            PG8_WAIT_V(6); PG8_BAR; PG8_MMA(1, 1, At, B1); PG8_BAR;
            PG8_LDB(B0, 1, 0); PG8_SCHED; PG8_LDA(At, 1, 0); PG8_STAGE(PG8_SA(0, 1), a2 + hstep, voffA);
            PG8_WAIT_L(8); PG8_BAR; PG8_WAIT_L(0); PG8_MMA(0, 0, At, B0); PG8_BAR; PG8_SCHED;
            PG8_LDB(B1, 1, 1); PG8_STAGE(PG8_SB(1, 0), b3, voffB);
            PG8_BAR; PG8_WAIT_L(0); PG8_MMA(0, 1, At, B1); PG8_BAR;
            PG8_LDA(At, 1, 1); PG8_STAGE(PG8_SA(1, 0), a3, voffA);
            PG8_BAR; PG8_WAIT_L(0); PG8_MMA(1, 0, At, B0); PG8_BAR; PG8_SCHED;
            PG8_STAGE(PG8_SB(1, 1), b3 + hstep, voffB);
            PG8_WAIT_V(6); PG8_BAR; PG8_MMA(1, 1, At, B1); PG8_BAR;
            }
        }
        if constexpr (ALIGN_EPI) { if (wr == 0) PG8_BAR; }
        if constexpr (!Epi::AFTER_DRAIN) { E(acc, cur, wr, wc, fr, fq); S.done(cur); }
        if (!has_next) break;
#pragma unroll
        for (int a = 0; a < 2; ++a)
#pragma unroll
            for (int b = 0; b < 2; ++b)
#pragma unroll
                for (int m = 0; m < 4; ++m)
#pragma unroll
                    for (int n = 0; n < 2; ++n) acc[a][b][m][n] = (f32x4){0.f, 0.f, 0.f, 0.f};
        cur = nxt; cA = nA; cB = nB; ++ui;
        if constexpr (ALIGN_EPI) { if (wr == 1) PG8_BAR; }
    }
    PG8_WAIT_V(0);
    if constexpr (!ALIGN_EPI) { if (wr == 0) PG8_BAR; }
    PG8_BAR;
    if constexpr (Epi::AFTER_DRAIN) { E.fused(acc, cur, wr, wc, fr, fq, lds, wid, lane); S.done(cur); }
#undef PG8_SA
#undef PG8_SB
#undef PG8_STAGE
#undef PG8_LDA
#undef PG8_LDB
#undef PG8_MMA
#undef PG8_WAIT_V
#undef PG8_WAIT_L
#undef PG8_BAR
#undef PG8_SCHED
}
}

namespace pg8 {
struct EpiF32 {
    static constexpr bool PERM = false, AFTER_DRAIN = false;
    float* C; int ldc;
    __device__ __forceinline__ void operator()(const f32x4 (&acc)[2][2][4][2], const Unit& u, int wr, int wc, int fr, int fq) const {
        const int row0 = u.pm * BM + wr * 64 + fr, col0 = u.pn * BM + wc * 32 + 4 * fq;
#pragma unroll
        for (int ai = 0; ai < 2; ++ai)
#pragma unroll
            for (int m = 0; m < 4; ++m) { float* rowp = C + (size_t)(row0 + ai * HALF + m * 16) * ldc + col0;
#pragma unroll
                for (int bj = 0; bj < 2; ++bj)
#pragma unroll
                    for (int n = 0; n < 2; ++n) *(f32x4*)(rowp + bj * HALF + n * 16) = acc[ai][bj][m][n]; }
    }
};
struct EpiResid {
    static constexpr bool PERM = false, AFTER_DRAIN = false;
    const float* base; float* out; int ldc; const float* gate0; int rows_per_b; int gstride;
    __device__ __forceinline__ void operator()(const f32x4 (&acc)[2][2][4][2], const Unit& u, int wr, int wc, int fr, int fq) const {
        const int row0 = u.pm * BM + wr * 64 + fr, col0 = u.pn * BM + wc * 32 + 4 * fq;
        const float* gp = gate0 + (size_t)((u.pm * BM) / rows_per_b) * gstride + col0;
        f32x4 gv[2][2];
#pragma unroll
        for (int bj = 0; bj < 2; ++bj)
#pragma unroll
            for (int n = 0; n < 2; ++n) gv[bj][n] = *(const f32x4*)(gp + bj * HALF + n * 16);
#pragma unroll
        for (int ai = 0; ai < 2; ++ai)
#pragma unroll
            for (int m = 0; m < 4; ++m) { const size_t off = (size_t)(row0 + ai * HALF + m * 16) * ldc + col0;
#pragma unroll
                for (int bj = 0; bj < 2; ++bj)
#pragma unroll
                    for (int n = 0; n < 2; ++n) { const f32x4 bs = *(const f32x4*)(base + off + bj * HALF + n * 16);
                        *(f32x4*)(out + off + bj * HALF + n * 16) = bs + gv[bj][n] * acc[ai][bj][m][n]; }
                if (m & 1) asm volatile("" ::: "memory"); }
    }
};
}

namespace mk {
#define GAS __attribute__((address_space(1)))
#define LAS __attribute__((address_space(3)))
typedef unsigned short bf16;
typedef unsigned v4u __attribute__((ext_vector_type(4)));
typedef unsigned v2u __attribute__((ext_vector_type(2)));
typedef float f32x4 __attribute__((ext_vector_type(4)));
#define LDS_WAIT() asm volatile("s_waitcnt lgkmcnt(0)" ::: "memory")
#define VM_WAIT() asm volatile("s_waitcnt vmcnt(0)" ::: "memory")
__device__ __forceinline__ unsigned f2bf(float f) { unsigned u = __builtin_bit_cast(unsigned, f); return (u + 0x7fffu + ((u >> 16) & 1u)) >> 16; }
__device__ __forceinline__ unsigned pk2(float lo, float hi) { return f2bf(lo) | (f2bf(hi) << 16); }
__device__ __forceinline__ float bf2f(unsigned short h) { return __builtin_bit_cast(float, (unsigned)h << 16); }

constexpr int NWAVES = 8, NT = 512;
constexpr int RING_BYTES = 131072, LDSCTL_OFF = RING_BYTES, LDS_BYTES = 147456;
constexpr size_t MiB = 1u << 20;
constexpr size_t WS_CTL = 0, CTL_ZERO_BYTES = 1 * MiB;
constexpr size_t WS_MOD = 1 * MiB, WS_KEYS = 2 * MiB, WS_WIN = 4 * MiB, WS_WOUT = 12 * MiB, WS_WQ = 16 * MiB, WS_H = 24 * MiB, WS_X1 = 56 * MiB;
constexpr size_t WS_EIDX = 120 * MiB, WS_GATE = 128 * MiB, WS_A = 136 * MiB, WS_MIX = 200 * MiB, WS_U = 232 * MiB, WS_V = 264 * MiB, WS_END = 296 * MiB;
constexpr size_t WS_SU = 3 * MiB, WS_SV = 3 * MiB + 512 * 1024;
constexpr size_t WS_T1 = 232 * MiB, WS_T2 = 360 * MiB, WS_TEND = 488 * MiB;
constexpr int CW_BAR = 4096, CW_FP6 = 64;

enum { PH_PRO = 0, PH_H0 = 1, PH_L0 = 2, PH_PER_LAYER = 7, PH_G1 = 0, PH_AT = 1, PH_G2 = 2, PH_N2 = 3, PH_G3 = 4, PH_TK = 5, PH_PE = 6, PH_END = PH_L0 + 2 * PH_PER_LAYER, PH_H1 = 100 };

struct Args { const float* in[19]; float* out; unsigned char* ws; int ph_lo, ph_hi; };

__device__ __forceinline__ void p0_transpose_item(const float* W, int K, int N, bf16* WT, LAS float* scr, int item, int lane) {
    const int nblk = N / 32, kb = item / nblk, nb = item % nblk, k0 = 64 * kb, n0 = 32 * nb;
#pragma unroll 8
    for (int i = 0; i < 32; ++i) { const int kk = 2 * i + (lane >> 5); scr[kk * 33 + (lane & 31)] = W[(size_t)(k0 + kk) * N + n0 + (lane & 31)]; }
    LDS_WAIT(); asm volatile("" ::: "memory");
    const int c = lane & 7;
#pragma unroll
    for (int j = 0; j < 4; ++j) { const int n = (lane >> 3) + 8 * j; const LAS float* s = scr + (8 * c) * 33 + n;
        v4u o; o.x = pk2(s[0 * 33], s[1 * 33]); o.y = pk2(s[2 * 33], s[3 * 33]); o.z = pk2(s[4 * 33], s[5 * 33]); o.w = pk2(s[6 * 33], s[7 * 33]);
        *(GAS v4u*)(WT + (size_t)(n0 + n) * K + k0 + 8 * c) = o; }
    LDS_WAIT(); asm volatile("" ::: "memory");
}
__device__ __forceinline__ float wave_sum(float v) {
#pragma unroll
    for (int o = 1; o < 64; o <<= 1) v += __shfl_xor(v, o);
    return v;
}
__device__ __forceinline__ void hmod_row(const float* xrow, const float* g, const float* mod_b, int which, bf16* orow, int lane) {
    const GAS f32x4* xr = (const GAS f32x4*)xrow + lane;
    f32x4 v[4]; float s = 0.f;
#pragma unroll
    for (int j = 0; j < 4; ++j) { v[j] = xr[64 * j]; s += (v[j].x * v[j].x + v[j].y * v[j].y) + (v[j].z * v[j].z + v[j].w * v[j].w); }
    const float rstd = 1.0f / sqrtf(wave_sum(s) * (1.f / D) + EPS);
    const float* shp = mod_b + (which * 3 + 0) * D; const float* scp = mod_b + (which * 3 + 1) * D;
    GAS unsigned long long* o8 = (GAS unsigned long long*)orow + lane;
#pragma unroll
    for (int j = 0; j < 4; ++j) { const int k = 4 * lane + 256 * j;
        const f32x4 gg = *(const f32x4*)(g + k), sh = *(const f32x4*)(shp + k), sc = *(const f32x4*)(scp + k);
        const f32x4 hv = v[j] * rstd * gg * (sc + 1.0f) + sh;
        o8[64 * j] = (unsigned long long)pk2(hv.x, hv.y) | ((unsigned long long)pk2(hv.z, hv.w) << 32); }
}


#define MK_GW(wave) (((gridDim.x % 8 == 0) ? (blockIdx.x % 8) * (gridDim.x / 8) + blockIdx.x / 8 : blockIdx.x) * NWAVES + (wave))
#define MK_NGW (gridDim.x * NWAVES)


typedef float v16f __attribute__((ext_vector_type(16)));
typedef float v32f __attribute__((ext_vector_type(32)));
typedef unsigned v6u __attribute__((ext_vector_type(6)));
__device__ __forceinline__ float fp6_val(int k) { return k < 8 ? 0.125f * (float)k : 0.125f * (float)(8 + (k & 7)) * (float)(1 << ((k >> 3) - 1)); }
__device__ __forceinline__ int fp6_arrangement() {
    float zero = 0.f; asm volatile("" : "+v"(zero));
    v16f a, b;
#pragma unroll
    for (int i = 0; i < 16; ++i) { a[i] = fp6_val(i) + zero; b[i] = fp6_val(16 + i) + zero; }
    const v6u p = __builtin_amdgcn_cvt_scalef32_2xpk16_fp6_f32(a, b, 1.0f);
    const v32f f = __builtin_amdgcn_cvt_scalef32_pk32_f32_fp6(p, 1.0f);
    bool seq = true, il = true;
#pragma unroll
    for (int k = 0; k < 32; ++k) seq = seq && (f[k] == fp6_val(k));
#pragma unroll
    for (int i = 0; i < 16; ++i) il = il && (f[2 * i] == fp6_val(i)) && (f[2 * i + 1] == fp6_val(16 + i));
    return seq ? 1 : (il ? 2 : 0);
}

__device__ __forceinline__ void ph_prologue(const Args& args, LAS unsigned char* lds) {
    const int tid = threadIdx.x, lane = tid & 63, wave = __builtin_amdgcn_readfirstlane(tid >> 6);
    const int G = gridDim.x, bx = blockIdx.x;
    unsigned char* ws = args.ws;
    {
        const float* c = args.in[1]; const float* w_ada = args.in[5]; const float* b_ada = args.in[6]; float* mod = (float*)(ws + WS_MOD);
        LAS float* sact = (LAS float*)lds; LAS float* red = (LAS float*)(lds + 32768);
        for (int i = tid; i < B * D; i += NT) { const float cv = c[i]; sact[i] = cv / (1.0f + __expf(-cv)); }
        __syncthreads();
        for (int item = bx; item < DEPTH * (6 * D / 32); item += G) {
            const int l = item / (6 * D / 32), n0 = (item % (6 * D / 32)) * 32, cc = tid & 31, kg = tid >> 5;
            float acc[B];
#pragma unroll
            for (int b = 0; b < B; ++b) acc[b] = 0.f;
            const float* w = w_ada + (size_t)l * D * 6 * D + n0 + cc;
            for (int kk = 0; kk < 64; ++kk) { const int k = kg * 64 + kk; const float wv = w[(size_t)k * 6 * D];
#pragma unroll
                for (int b = 0; b < B; ++b) acc[b] += sact[b * D + k] * wv; }
#pragma unroll
            for (int b = 0; b < B; ++b) red[(kg * 32 + cc) * B + b] = acc[b];
            __syncthreads();
            if (tid < 32 * B) { const int c2 = tid & 31, b = tid >> 5; float s = 0.f;
                for (int k2 = 0; k2 < 16; ++k2) s += red[(k2 * 32 + c2) * B + b];
                mod[((size_t)l * B + b) * 6 * D + n0 + c2] = s + b_ada[(size_t)l * 6 * D + n0 + c2]; }
            __syncthreads();
        }
    }
    const int gw = MK_GW(wave), NGW = MK_NGW;
    {
        const float* w_in = args.in[7]; const float* w_out = args.in[14]; const float* peer_wq = args.in[15];
        bf16* WinT = (bf16*)(ws + WS_WIN); bf16* WoutT = (bf16*)(ws + WS_WOUT); bf16* WqT = (bf16*)(ws + WS_WQ);
        LAS float* scr = (LAS float*)(lds + wave * 16384);
        constexpr int I_IN = (D / 64) * (INW / 32), I_OUT = (D / 64) * (D / 32), I_Q = (D / 64) * (PW / 32), I_L = I_IN + I_OUT + I_Q;
        for (int it = gw; it < DEPTH * I_L; it += NGW) {
            const int l = it / I_L; int r = it % I_L;
            if (r < I_IN) { p0_transpose_item(w_in + (size_t)l * D * INW, D, INW, WinT + (size_t)l * INW * D, scr, r, lane); continue; } r -= I_IN;
            if (r < I_OUT) { p0_transpose_item(w_out + (size_t)l * D * D, D, D, WoutT + (size_t)l * D * D, scr, r, lane); continue; } r -= I_OUT;
            p0_transpose_item(peer_wq + (size_t)l * D * PW, D, PW, WqT + (size_t)l * PW * D, scr, r, lane);
        }
    }
    {
        const float* peer_keys = args.in[16]; bf16* keysb = (bf16*)(ws + WS_KEYS);
        for (int i = gw * 64 + lane; i < DEPTH * 2 * NK * 128 / 2; i += NGW * 64) ((GAS unsigned*)keysb)[i] = pk2(peer_keys[2 * i], peer_keys[2 * i + 1]);
    }
    {
        const float* peer_u = args.in[17]; const float* peer_v = args.in[18];
        unsigned char* U6 = ws + WS_U; unsigned char* V6 = ws + WS_V; float* SU = (float*)(ws + WS_SU); float* SV = (float*)(ws + WS_SV);
        const int arr = fp6_arrangement();
        if (threadIdx.x == 0) __hip_atomic_store((unsigned*)(ws + WS_CTL) + CW_FP6, (unsigned)arr, __ATOMIC_RELAXED, __HIP_MEMORY_SCOPE_AGENT);
        LAS unsigned char* scr = lds + wave * 16384;
        const int rh = lane >> 5, l5 = lane & 31;
        for (int rp = gw; rp < DEPTH * NE / 2; rp += NGW) {
            for (int tb = 0; tb < 2; ++tb) {
                const float* srcb = (tb ? peer_v : peer_u) + (size_t)(2 * rp) * D;
#pragma unroll
                for (int rr = 0; rr < 2; ++rr)
#pragma unroll
                    for (int j = 0; j < 4; ++j) { const f32x4 v = ((const GAS f32x4*)(srcb + (size_t)rr * D))[64 * j + lane];
                        *(LAS f32x4*)(scr + rr * 4608 + (8 * j + (lane >> 3)) * 144 + 16 * (lane & 7)) = v; }
                LDS_WAIT(); asm volatile("" ::: "memory");
                float x[32]; float am = 0.f;
#pragma unroll
                for (int q = 0; q < 8; ++q) { const f32x4 v = *(const LAS f32x4*)(scr + rh * 4608 + l5 * 144 + 16 * q); x[4 * q] = v.x; x[4 * q + 1] = v.y; x[4 * q + 2] = v.z; x[4 * q + 3] = v.w;
                    am = fmaxf(am, fmaxf(fmaxf(fabsf(v.x), fabsf(v.y)), fmaxf(fabsf(v.z), fabsf(v.w)))); }
                LDS_WAIT(); asm volatile("" ::: "memory");
#pragma unroll
                for (int o = 1; o < 32; o <<= 1) am = fmaxf(am, __shfl_xor(am, o));
                const float sc = am > 0.f ? am * (1.0f / 7.5f) : 1.0f, inv = 1.0f / sc;
                v16f a, b;
#pragma unroll
                for (int i = 0; i < 16; ++i) { a[i] = (arr == 2 ? x[2 * i] : x[i]) * inv; b[i] = (arr == 2 ? x[2 * i + 1] : x[16 + i]) * inv; }
                const v6u p = __builtin_amdgcn_cvt_scalef32_2xpk16_fp6_f32(a, b, 1.0f);
                unsigned char* drow = (tb ? V6 : U6) + (size_t)(2 * rp + rh) * 768;
                v4u p4; p4.x = p[0]; p4.y = p[1]; p4.z = p[2]; p4.w = p[3]; v2u p2; p2.x = p[4]; p2.y = p[5];
                *(GAS v4u*)(drow + 16 * l5) = p4; *(GAS v2u*)(drow + 512 + 8 * l5) = p2;
                if (l5 == 0) (tb ? SV : SU)[2 * rp + rh] = sc;
            }
        }
    }
}
template <int L, int WHICH> __device__ __forceinline__ void ph_hmod(const Args& args) {
    const int lane = threadIdx.x & 63, wave = __builtin_amdgcn_readfirstlane(threadIdx.x >> 6);
    unsigned char* ws = args.ws;
    const float* src = WHICH ? (const float*)(ws + WS_X1) : (L == 0 ? args.in[0] : args.out);
    const float* g = args.in[WHICH ? 4 : 3] + L * D; const float* mod_l = (const float*)(ws + WS_MOD) + (size_t)L * B * 6 * D; bf16* Hb = (bf16*)(ws + WS_H);
    const int gw = MK_GW(wave), NGW = MK_NGW;
    for (int m = gw; m < T; m += NGW) hmod_row(src + (size_t)m * D, g, mod_l + (size_t)(m / S) * 6 * D, WHICH, Hb + (size_t)m * D, lane);
}
template <int L> __device__ __forceinline__ void ph_g1(const Args& args, LAS unsigned char* lds) {
    unsigned char* ws = args.ws;
    pg8::Gemm g{(const bf16*)(ws + WS_H), (const bf16*)(ws + WS_WIN) + (size_t)L * INW * D, T, INW, D}; pg8::StaticOrder SO; SO.init(T, INW, gridDim.x, blockIdx.x);
#if Z_F32
    pg8::EpiF32 E{(float*)(ws + WS_T1), INW};
    pg8::gemm_phase<pg8::EpiF32, pg8::StaticOrder, true, true>(lds, g, SO, E);
#else
    pg8::EpiBf16<0> E{(bf16*)(ws + WS_A), INW, nullptr, 0, 0, 1.f};
    pg8::gemm_phase<pg8::EpiBf16<0>, pg8::StaticOrder, true, true>(lds, g, SO, E);
#endif
}
template <int L> __device__ __forceinline__ void ph_g2(const Args& args, LAS unsigned char* lds) {
    unsigned char* ws = args.ws;
    pg8::Gemm g{(const bf16*)(ws + WS_MIX), (const bf16*)(ws + WS_WOUT) + (size_t)L * D * D, T, D, D}; pg8::StaticOrder SO; SO.init(T, D, gridDim.x, blockIdx.x);
    pg8::EpiResid E{L == 0 ? args.in[0] : args.out, (float*)(ws + WS_X1), D, (const float*)(ws + WS_MOD) + (size_t)L * B * 6 * D + 2 * D, S, 6 * D};
    pg8::gemm_phase<pg8::EpiResid, pg8::StaticOrder, true, true>(lds, g, SO, E);
}
template <int L> __device__ __forceinline__ void ph_g3(const Args& args, LAS unsigned char* lds) {
    unsigned char* ws = args.ws;
    pg8::Gemm g{(const bf16*)(ws + WS_H), (const bf16*)(ws + WS_WQ) + (size_t)L * PW * D, T, PW, D}; pg8::StaticOrder SO; SO.init(T, PW, gridDim.x, blockIdx.x);
#if QP_F32
    pg8::EpiF32 E{(float*)(ws + WS_T1), PW};
    pg8::gemm_phase<pg8::EpiF32, pg8::StaticOrder, true, true>(lds, g, SO, E);
#else
    pg8::EpiBf16<0> E{(bf16*)(ws + WS_A), PW, nullptr, 0, 0, 1.f};
    pg8::gemm_phase<pg8::EpiBf16<0>, pg8::StaticOrder, true, true>(lds, g, SO, E);
#endif
}
}

namespace mk {
#define XB_TMO      128
#define XB_XCNT(j)  (256  + 64 * (j))
#define XB_XSUB(j)  (1280 + 64 * (j))
#define XB_XGEN(j)  (2304 + 64 * (j))
#define XB_TOP      3328
#define XB_TOPGEN   3392
#define XCD_BAR_WORDS 3456
#define XB_SPIN_CAP (1u << 18)

__device__ __forceinline__ unsigned xb_ld(unsigned* p)              { return __hip_atomic_load(p, __ATOMIC_RELAXED, __HIP_MEMORY_SCOPE_AGENT); }
__device__ __forceinline__ unsigned xb_add(unsigned* p, unsigned v) { return __hip_atomic_fetch_add(p, v, __ATOMIC_RELAXED, __HIP_MEMORY_SCOPE_AGENT); }
__device__ __forceinline__ unsigned xb_xcc_id() { return (unsigned)__builtin_amdgcn_s_getreg((3 << 11) | 20) & 0xFu; }
#define XB_SPIN(cond, bar) do { unsigned _sp = 0; while (cond) { __builtin_amdgcn_s_sleep(1); \
    if ((++_sp & 255u) == 0u) { if (xb_ld(&(bar)[XB_TMO])) break; if (_sp > XB_SPIN_CAP) { atomicAdd(&(bar)[XB_TMO], 1u); break; } } } } while (0)

struct XcdBarrier {
    unsigned* bar; unsigned x;
    volatile LAS unsigned* st;
};

__device__ __forceinline__ XcdBarrier xcd_barrier_post(unsigned* bar, volatile LAS unsigned* st) {
    XcdBarrier b; b.bar = bar; b.x = xb_xcc_id(); b.st = st;
    if (threadIdx.x == 0) (void)xb_add(&bar[XB_XCNT(b.x)], 1u);
    return b;
}
__device__ __forceinline__ void xcd_barrier_complete(unsigned* bar, unsigned x, unsigned& nloc, unsigned& nx) {
    const unsigned G = gridDim.x * gridDim.y * gridDim.z;
    unsigned sum, cnt, mine, sp = 0u;
    for (;;) {
        sum = 0u; cnt = 0u; mine = 0u;
#pragma unroll
        for (unsigned j = 0; j < 16; ++j) { const unsigned c = xb_ld(&bar[XB_XCNT(j)]); sum += c; cnt += (c > 0u) ? 1u : 0u; mine = (j == x) ? c : mine; }
        if (sum == G) break;
        __builtin_amdgcn_s_sleep(1);
        if ((++sp & 255u) == 0u) { if (xb_ld(&bar[XB_TMO])) break; if (sp > XB_SPIN_CAP) { atomicAdd(&bar[XB_TMO], 1u); break; } }
    }
    nloc = mine > 0u ? mine : 1u; nx = cnt > 0u ? cnt : 1u;
}

__device__ __forceinline__ void xcd_barrier(const XcdBarrier& b) {
    asm volatile("s_waitcnt vmcnt(0)" ::: "memory");
    __syncthreads();
    if (threadIdx.x == 0) {
        unsigned* bar = b.bar;
        __builtin_amdgcn_s_waitcnt(0);
        unsigned nloc = b.st[0], nx = b.st[1];
        if (nloc == 0u) { xcd_barrier_complete(bar, b.x, nloc, nx); b.st[0] = nloc; b.st[1] = nx; }
        const unsigned old = xb_add(&bar[XB_XSUB(b.x)], 1u);
        const unsigned gen = old / nloc;
        if (old + 1u == (gen + 1u) * nloc) {
            __builtin_amdgcn_fence(__ATOMIC_RELEASE, "agent");
            asm volatile("s_waitcnt vmcnt(0)" ::: "memory");
            const unsigned og = xb_add(&bar[XB_TOP], 1u);
            const unsigned tg = og / nx;
            if (og + 1u == (tg + 1u) * nx) xb_add(&bar[XB_TOPGEN], 1u);
            else XB_SPIN(xb_ld(&bar[XB_TOPGEN]) == tg, bar);
            __builtin_amdgcn_fence(__ATOMIC_ACQUIRE, "agent");
            xb_add(&bar[XB_XGEN(b.x)], 1u);
            asm volatile("s_waitcnt vmcnt(0)" ::: "memory");
        } else {
            XB_SPIN(xb_ld(&bar[XB_XGEN(b.x)]) == gen, bar);
            __builtin_amdgcn_fence(__ATOMIC_ACQUIRE, "agent");
            asm volatile("s_waitcnt vmcnt(0)" ::: "memory");
        }
    }
    __syncthreads();
}

}


namespace mk {
typedef short bf16x8 __attribute__((ext_vector_type(8)));
typedef float f32x16 __attribute__((ext_vector_type(16)));
__device__ __forceinline__ unsigned f2sort(float f) { const unsigned u = __builtin_bit_cast(unsigned, f); return u ^ ((unsigned)((int)u >> 31) | 0x80000000u); }
__device__ __forceinline__ float sort2f(unsigned s) { const unsigned m = (unsigned)((int)s >> 31); return __builtin_bit_cast(float, s ^ (~m | 0x80000000u)); }
__device__ __forceinline__ unsigned umax_(unsigned a, unsigned b) { return a > b ? a : b; }
__device__ __forceinline__ unsigned umin_(unsigned a, unsigned b) { return a < b ? a : b; }
__device__ __forceinline__ void sort16_desc(unsigned (&v)[16]) {
#pragma unroll
    for (int k = 2; k <= 16; k <<= 1)
#pragma unroll
        for (int j = k >> 1; j > 0; j >>= 1)
#pragma unroll
            for (int i = 0; i < 16; ++i) { const int l = i ^ j; if (l > i) { const unsigned a = v[i], b = v[l], mx = umax_(a, b), mn = umin_(a, b);
                if ((i & k) == 0) { v[i] = mx; v[l] = mn; } else { v[i] = mn; v[l] = mx; } } }
}
__device__ __forceinline__ void merge16_desc(unsigned (&a)[16], const unsigned (&b)[16]) {
#pragma unroll
    for (int i = 0; i < 16; ++i) a[i] = umax_(a[i], b[15 - i]);
#pragma unroll
    for (int j = 8; j > 0; j >>= 1)
#pragma unroll
        for (int i = 0; i < 16; ++i) { const int l = i ^ j; if (l > i) { const unsigned x = a[i], y = a[l]; a[i] = umax_(x, y); a[l] = umin_(x, y); } }
}
__device__ __forceinline__ void xmerge16_desc(unsigned (&a)[16]) {
    unsigned p[16];
#pragma unroll
    for (int i = 0; i < 16; ++i) p[i] = (unsigned)__shfl_xor((int)a[i], 32);
    merge16_desc(a, p);
}
#define TK_CANDS \
    TKC(0, 0, 0, 2, 1) \
    TKC(1, 0, 1, 2, 2) \
    TKC(2, 0, 2, 2, 3) \
    TKC(3, 0, 3, 2, 4) \
    TKC(4, 0, 4, 3, 0) \
    TKC(5, 0, 5, 3, 1) \
    TKC(6, 0, 6, 3, 2) \
    TKC(7, 0, 7, 3, 3) \
    TKC(8, 0, 8, 4, 0) \
    TKC(9, 0, 9, 4, 1) \
    TKC(10, 0, 10, 4, 2) \
    TKC(11, 0, 11, 5, 0) \
    TKC(12, 0, 12, 5, 1) \
    TKC(13, 0, 13, 6, 0) \
    TKC(14, 0, 14, 6, 1) \
    TKC(15, 0, 15, 7, 0) \
    TKC(16, 1, 0, 7, 1) \
    TKC(17, 1, 1, 8, 0) \
    TKC(18, 1, 2, 9, 0) \
    TKC(19, 1, 3, 10, 0) \
    TKC(20, 1, 4, 11, 0) \
    TKC(21, 1, 5, 12, 0) \
    TKC(22, 1, 6, 13, 0) \
    TKC(23, 1, 7, 14, 0) \
    TKC(24, 2, 0, 15, 0)

template <int L> __device__ __forceinline__ void ph_topk(const Args& args, LAS unsigned char* lds) {
    const int tid = threadIdx.x, lane = tid & 63, wave = __builtin_amdgcn_readfirstlane(tid >> 6);
    const int c = lane & 31, hi = lane >> 5;
    unsigned char* ws = args.ws;
    const bf16* keysb = (const bf16*)(ws + WS_KEYS) + (size_t)L * 2 * NK * 128;
    const bf16* qp = (const bf16*)(ws + WS_A);
    int* eidx = (int*)(ws + WS_EIDX); float* gate = (float*)(ws + WS_GATE);
    constexpr int KROW = 272;
    for (int ch = tid; ch < 256 * 16; ch += NT) { const int r = ch >> 4, cc = ch & 15; *(LAS v4u*)(lds + r * KROW + cc * 16) = *(const GAS v4u*)(keysb + r * 128 + cc * 8); }
    __syncthreads();
    LAS unsigned* wl = (LAS unsigned*)(lds + 256 * KROW + wave * 4096) + c * 32;
    const int gw = MK_GW(wave), NGW = MK_NGW;
    const unsigned h4 = 4u * (unsigned)hi;
    for (int pass = gw; pass < T * PH / 32; pass += NGW) {
        const int row = pass * 32 + c;
        const bf16* qrow = qp + (size_t)row * 256 + hi * 8;
        unsigned top[2][16];
#pragma unroll
        for (int half = 0; half < 2; ++half) {
            bf16x8 bq[8];
#pragma unroll
            for (int ks = 0; ks < 8; ++ks) bq[ks] = *(const GAS bf16x8*)(qrow + half * 128 + ks * 16);
            f32x16 acc[4];
#pragma unroll
            for (int mt = 0; mt < 4; ++mt)
#pragma unroll
                for (int r = 0; r < 16; ++r) acc[mt][r] = 0.f;
#pragma unroll
            for (int ks = 0; ks < 8; ++ks)
#pragma unroll
                for (int mt = 0; mt < 4; ++mt) { const bf16x8 a = *(const LAS bf16x8*)(lds + (half * 128 + mt * 32 + c) * KROW + (ks * 16 + hi * 8) * 2);
                    acc[mt] = __builtin_amdgcn_mfma_f32_32x32x16_bf16(a, bq[ks], acc[mt], 0, 0, 0); }
            unsigned g[4][16];
#pragma unroll
            for (int mt = 0; mt < 4; ++mt)
#pragma unroll
                for (int r = 0; r < 16; ++r) { const unsigned code = (unsigned)(127 - mt * 32 - (r & 3) - 8 * (r >> 2)) - h4;
                    g[mt][r] = (f2sort(acc[mt][r]) & ~127u) | code; }
#pragma unroll
            for (int mt = 0; mt < 4; ++mt) sort16_desc(g[mt]);
            merge16_desc(g[0], g[1]); merge16_desc(g[2], g[3]); merge16_desc(g[0], g[2]);
            xmerge16_desc(g[0]);
#pragma unroll
            for (int i = 0; i < 16; ++i) top[half][i] = g[0][i];
        }
#pragma unroll
        for (int q = 0; q < 4; ++q) { v4u w;
            w.x = hi ? top[1][4 * q + 0] : top[0][4 * q + 0]; w.y = hi ? top[1][4 * q + 1] : top[0][4 * q + 1];
            w.z = hi ? top[1][4 * q + 2] : top[0][4 * q + 2]; w.w = hi ? top[1][4 * q + 3] : top[0][4 * q + 3];
            *(LAS v4u*)(wl + hi * 16 + 4 * q) = w; }
        float v1[16], v2[16];
#pragma unroll
        for (int i = 0; i < 16; ++i) { v1[i] = sort2f(top[0][i] & ~127u); v2[i] = sort2f(top[1][i] & ~127u); }
        unsigned cd[2][16];
#pragma unroll
        for (int i = 0; i < 16; ++i) { cd[0][i] = 0u; cd[1][i] = 0u; }
#define TKC(q, i0, j0, i1, j1) { const float sm = hi ? (v1[i1] + v2[j1]) : (v1[i0] + v2[j0]); const unsigned code = hi ? (unsigned)(255 - ((i1) * 16 + (j1))) : (unsigned)(255 - ((i0) * 16 + (j0))); \
            cd[(q) >> 4][(q) & 15] = (f2sort(sm) & ~255u) | code; }
        TK_CANDS
#undef TKC
        sort16_desc(cd[0]); sort16_desc(cd[1]); merge16_desc(cd[0], cd[1]); xmerge16_desc(cd[0]);
        float ev[16]; int ex[16]; float den = 0.f;
        const float vmax = sort2f(cd[0][0] & ~255u);
#pragma unroll
        for (int r = 0; r < 16; ++r) { const unsigned key = cd[0][r], pos = 255u - (key & 255u);
            const unsigned k1 = wl[pos >> 4], k2 = wl[16 + (pos & 15u)];
            ex[r] = (int)((127u - (k1 & 127u)) * 128u + (127u - (k2 & 127u)));
            ev[r] = __expf(sort2f(key & ~255u) - vmax); den += ev[r]; }
        const float inv = 1.0f / den;
        if (hi == 0) {
#pragma unroll
            for (int q = 0; q < 4; ++q) { v4u w; w.x = (unsigned)ex[4 * q]; w.y = (unsigned)ex[4 * q + 1]; w.z = (unsigned)ex[4 * q + 2]; w.w = (unsigned)ex[4 * q + 3]; *(GAS v4u*)(eidx + (size_t)row * 16 + 4 * q) = w; }
        } else {
#pragma unroll
            for (int q = 0; q < 4; ++q) { f32x4 w; w.x = ev[4 * q] * inv; w.y = ev[4 * q + 1] * inv; w.z = ev[4 * q + 2] * inv; w.w = ev[4 * q + 3] * inv; *(GAS f32x4*)(gate + (size_t)row * 16 + 4 * q) = w; }
        }
    }
}
}


namespace mk {
typedef short bf16x4v __attribute__((ext_vector_type(4)));
__device__ __forceinline__ unsigned cvt_pk_bf16(float lo, float hi) { unsigned r; asm volatile("v_cvt_pk_bf16_f32 %0, %1, %2" : "=v"(r) : "v"(lo), "v"(hi)); return r; }
__device__ __forceinline__ void head_prep(const bf16* src  , const float* g, int h, int pos, float scl, v4u (&outp)[4]) {
    float v[4][8]; float ss = 0.f;
#pragma unroll
    for (int ks = 0; ks < 4; ++ks) { const v4u w = *(const GAS v4u*)(src + ks * 16);
        const unsigned ww[4] = {w.x, w.y, w.z, w.w};
#pragma unroll
        for (int q = 0; q < 4; ++q) { v[ks][2 * q] = __builtin_bit_cast(float, ww[q] << 16); v[ks][2 * q + 1] = __builtin_bit_cast(float, ww[q] & 0xffff0000u); }
#pragma unroll
        for (int j = 0; j < 8; ++j) ss += v[ks][j] * v[ks][j]; }
    ss += __shfl_xor(ss, 32);
    const float r = scl / sqrtf(ss * (1.0f / 64.0f) + EPS);
#pragma unroll
    for (int ks = 0; ks < 4; ++ks) { const f32x4 g0 = *(const f32x4*)(g + ks * 16 + 8 * h), g1 = *(const f32x4*)(g + ks * 16 + 8 * h + 4);
        v[ks][0] *= r * g0.x; v[ks][1] *= r * g0.y; v[ks][2] *= r * g0.z; v[ks][3] *= r * g0.w; v[ks][4] *= r * g1.x; v[ks][5] *= r * g1.y; v[ks][6] *= r * g1.z; v[ks][7] *= r * g1.w; }
#pragma unroll
    for (int i = 0; i < 8; ++i) { const float other = __shfl_xor(v[0][i], 32);
        constexpr float INVF[8] = {1.0f, 0.1939227432012558f, 0.03760603070259094f, 0.007292664609849453f, 0.0014142135623842478f, 0.00027424818836152554f, 5.318296098266728e-05f, 1.0313386155758053e-05f};
        float rev = ((float)pos * INVF[i]) * 0.15915494309189535f; rev -= floorf(rev);
        const float sn = __builtin_amdgcn_sinf(rev), cs = __builtin_amdgcn_cosf(rev);
        v[0][i] = h ? (v[0][i] * cs + other * sn) : (v[0][i] * cs - other * sn); }
#pragma unroll
    for (int ks = 0; ks < 4; ++ks) { outp[ks].x = pk2(v[ks][0], v[ks][1]); outp[ks].y = pk2(v[ks][2], v[ks][3]); outp[ks].z = pk2(v[ks][4], v[ks][5]); outp[ks].w = pk2(v[ks][6], v[ks][7]); }
}

template <int L> __device__ __forceinline__ void ph_mixer(const Args& args, LAS unsigned char* lds) {
    const int tid = threadIdx.x, lane = tid & 63, wave = __builtin_amdgcn_readfirstlane(tid >> 6);
    const int c = lane & 31, hi = lane >> 5;
    unsigned char* ws = args.ws;
    const bf16* z = (const bf16*)(ws + WS_A); bf16* mix = (bf16*)(ws + WS_MIX);
    const int* positions = (const int*)args.in[2];
    const float* qg = args.in[8] + L * 64; const float* kg = args.in[9] + L * 64; const float* sink = args.in[10] + L * NQH;
    const float* conv_w = args.in[11] + L * 3 * 256; const float* pool_w = args.in[12] + (size_t)L * 4 * 64 * 64; const float* pool_scale = args.in[13] + L * 256;
    constexpr int KROW = 144, VROW = 776, K_OFF = 0, V_OFF = 384 * KROW, P_OFF = V_OFF + 64 * VROW, PROW = 68;
    constexpr int NQB = S / 128;
    for (int unit = blockIdx.x; unit < B * NKVH * NQB; unit += gridDim.x) {
        const int qb = unit % NQB, kvh = (unit / NQB) % NKVH, b = unit / (NQB * NKVH);
        const int tok0 = b * S, kbase = qb * 128 - 128;
        __syncthreads();
        for (int pass = wave; pass < 12; pass += NWAVES) { const int kr = pass * 32 + c, kp = kbase + kr;
            if (kp >= 0 && kp < S) {
                v4u o[4]; head_prep(z + (size_t)(tok0 + kp) * INW + OK_ + kvh * 64 + 8 * hi, kg, hi, positions[tok0 + kp], 1.0f, o);
#pragma unroll
                for (int ks = 0; ks < 4; ++ks) *(LAS v4u*)(lds + K_OFF + kr * KROW + (ks * 16 + 8 * hi) * 2) = o[ks]; } }
        for (int ch = tid; ch < 384 * 8; ch += NT) { const int kr = ch >> 3, dc = ch & 7, kp = kbase + kr;
            if (kp >= 0 && kp < S) { const v4u w = *(const GAS v4u*)(z + (size_t)(tok0 + kp) * INW + OV + kvh * 64 + dc * 8);
                const unsigned ww[4] = {w.x, w.y, w.z, w.w};
#pragma unroll
                for (int q = 0; q < 4; ++q) { *(LAS unsigned short*)(lds + V_OFF + (dc * 8 + 2 * q) * VROW + kr * 2) = (unsigned short)(ww[q] & 0xffffu);
                                              *(LAS unsigned short*)(lds + V_OFF + (dc * 8 + 2 * q + 1) * VROW + kr * 2) = (unsigned short)(ww[q] >> 16); } } }
        __syncthreads();
        {
            const int g = wave >> 1, qh = wave & 1, hq = kvh * GRP + g;
            const float sk = sink[hq] * 1.4426950408889634f;
#pragma unroll 1
            for (int qt = 0; qt < 2; ++qt) {
                const int a = qb * 128 + qh * 64 + qt * 32;
                const int tq = tok0 + a + c;
                v4u qf[4]; head_prep(z + (size_t)tq * INW + OQ + hq * 64 + 8 * hi, qg, hi, positions[tq], 0.125f * 1.4426950408889634f, qf);
                bf16x8 bq[4];
#pragma unroll
                for (int ks = 0; ks < 4; ++ks) bq[ks] = __builtin_bit_cast(bf16x8, qf[ks]);
                float m = sk, lsum = hi ? 0.f : 1.f;
                f32x16 O0, O1;
#pragma unroll
                for (int r = 0; r < 16; ++r) { O0[r] = 0.f; O1[r] = 0.f; }
#pragma unroll 1
                for (int kt = 0; kt < 9; ++kt) {
                    const int kp0 = a - 128 + 32 * kt;
                    if (kp0 < 0 || kp0 >= S) continue;
                    const int kr0 = kp0 - kbase;
                    f32x16 sa;
#pragma unroll
                    for (int r = 0; r < 16; ++r) sa[r] = 0.f;
#pragma unroll
                    for (int ks = 0; ks < 4; ++ks) { const bf16x8 ka = *(const LAS bf16x8*)(lds + K_OFF + (kr0 + c) * KROW + (ks * 16 + 8 * hi) * 2);
                        sa = __builtin_amdgcn_mfma_f32_32x32x16_bf16(ka, bq[ks], sa, 0, 0, 0); }
                    if (kt == 0) {
#pragma unroll
                        for (int r = 0; r < 16; ++r) { const int i = (r & 3) + 8 * (r >> 2) + 4 * hi; if (i < c) sa[r] = -1e30f; }
                    } else if (kt == 8) {
#pragma unroll
                        for (int r = 0; r < 16; ++r) { const int i = (r & 3) + 8 * (r >> 2) + 4 * hi; if (i > c) sa[r] = -1e30f; }
                    }
                    float mx = sa[0];
#pragma unroll
                    for (int r = 1; r < 16; ++r) mx = fmaxf(mx, sa[r]);
                    mx = fmaxf(mx, __shfl_xor(mx, 32));
                    if (__any(mx > m + 11.0f)) {
                        const float mn = fmaxf(m, mx), al = __builtin_amdgcn_exp2f(m - mn);
                        m = mn; lsum *= al;
#pragma unroll
                        for (int r = 0; r < 16; ++r) { O0[r] *= al; O1[r] *= al; }
                    }
                    float p[16]; float rs = 0.f;
#pragma unroll
                    for (int r = 0; r < 16; ++r) { p[r] = __builtin_amdgcn_exp2f(sa[r] - m); rs += p[r]; }
                    lsum += rs;
#pragma unroll
                    for (int s2 = 0; s2 < 2; ++s2) {
                        v4u pw; pw.x = cvt_pk_bf16(p[8 * s2 + 0], p[8 * s2 + 1]); pw.y = cvt_pk_bf16(p[8 * s2 + 2], p[8 * s2 + 3]); pw.z = cvt_pk_bf16(p[8 * s2 + 4], p[8 * s2 + 5]); pw.w = cvt_pk_bf16(p[8 * s2 + 6], p[8 * s2 + 7]);
                        const bf16x8 pb = __builtin_bit_cast(bf16x8, pw);
#pragma unroll
                        for (int mt = 0; mt < 2; ++mt) { const LAS unsigned char* vp = lds + V_OFF + (mt * 32 + c) * VROW + (kr0 + 16 * s2 + 4 * hi) * 2;
                            const v2u lo2 = *(const LAS v2u*)vp, hi2 = *(const LAS v2u*)(vp + 16);
                            v4u va; va.x = lo2.x; va.y = lo2.y; va.z = hi2.x; va.w = hi2.y;
                            if (mt == 0) O0 = __builtin_amdgcn_mfma_f32_32x32x16_bf16(__builtin_bit_cast(bf16x8, va), pb, O0, 0, 0, 0);
                            else         O1 = __builtin_amdgcn_mfma_f32_32x32x16_bf16(__builtin_bit_cast(bf16x8, va), pb, O1, 0, 0, 0); }
                    }
                }
                const float inv = 1.0f / (lsum + __shfl_xor(lsum, 32));
                bf16* orow = mix + (size_t)tq * D + hq * 64 + 4 * hi;
#pragma unroll
                for (int q = 0; q < 4; ++q) { v2u w0, w1;
                    w0.x = pk2(O0[4 * q] * inv, O0[4 * q + 1] * inv); w0.y = pk2(O0[4 * q + 2] * inv, O0[4 * q + 3] * inv);
                    w1.x = pk2(O1[4 * q] * inv, O1[4 * q + 1] * inv); w1.y = pk2(O1[4 * q + 2] * inv, O1[4 * q + 3] * inv);
                    *(GAS v2u*)(orow + 8 * q) = w0; *(GAS v2u*)(orow + 32 + 8 * q) = w1; }
            }
        }
        if (kvh == 0) {
            const int chunk = tid & 31, tg = tid >> 5, c8 = chunk * 8;
            float w0[8], w1[8], w2[8];
#pragma unroll
            for (int j = 0; j < 8; ++j) { w0[j] = conv_w[c8 + j]; w1[j] = conv_w[256 + c8 + j]; w2[j] = conv_w[512 + c8 + j]; }
#pragma unroll 2
            for (int r = 0; r < 8; ++r) { const int sq = qb * 128 + r * 16 + tg; const bf16* zr = z + (size_t)(tok0 + sq) * INW + c8;
                const bool hp = sq > 0, hn = sq + 1 < S;
                const bf16* zp = hp ? zr - INW : zr; const bf16* zn = hn ? zr + INW : zr;
                const v4u xp = *(const GAS v4u*)(zp + OCX), cp = *(const GAS v4u*)(zp + OCC), xc = *(const GAS v4u*)(zr + OCX), cc = *(const GAS v4u*)(zr + OCC),
                          xn = *(const GAS v4u*)(zn + OCX), cn = *(const GAS v4u*)(zn + OCC), cb = *(const GAS v4u*)(zr + OCB);
                const unsigned axp[4] = {xp.x, xp.y, xp.z, xp.w}, acp[4] = {cp.x, cp.y, cp.z, cp.w}, axc[4] = {xc.x, xc.y, xc.z, xc.w}, acc_[4] = {cc.x, cc.y, cc.z, cc.w},
                               axn[4] = {xn.x, xn.y, xn.z, xn.w}, acn[4] = {cn.x, cn.y, cn.z, cn.w}, acb[4] = {cb.x, cb.y, cb.z, cb.w};
                const float fp = hp ? 1.f : 0.f, fn = hn ? 1.f : 0.f;
                unsigned ow[4];
#pragma unroll
                for (int q = 0; q < 4; ++q) {
                    const float upa = fp * __builtin_bit_cast(float, axp[q] << 16) * __builtin_bit_cast(float, acp[q] << 16), upb = fp * __builtin_bit_cast(float, axp[q] & 0xffff0000u) * __builtin_bit_cast(float, acp[q] & 0xffff0000u);
                    const float uca = __builtin_bit_cast(float, axc[q] << 16) * __builtin_bit_cast(float, acc_[q] << 16), ucb = __builtin_bit_cast(float, axc[q] & 0xffff0000u) * __builtin_bit_cast(float, acc_[q] & 0xffff0000u);
                    const float una = fn * __builtin_bit_cast(float, axn[q] << 16) * __builtin_bit_cast(float, acn[q] << 16), unb = fn * __builtin_bit_cast(float, axn[q] & 0xffff0000u) * __builtin_bit_cast(float, acn[q] & 0xffff0000u);
                    const float oa = __builtin_bit_cast(float, acb[q] << 16) * (w0[2 * q] * upa + w1[2 * q] * uca + w2[2 * q] * una);
                    const float ob = __builtin_bit_cast(float, acb[q] & 0xffff0000u) * (w0[2 * q + 1] * upb + w1[2 * q + 1] * ucb + w2[2 * q + 1] * unb);
                    ow[q] = pk2(oa, ob); }
                v4u o; o.x = ow[0]; o.y = ow[1]; o.z = ow[2]; o.w = ow[3];
                *(GAS v4u*)(mix + (size_t)(tok0 + sq) * D + 512 + c8) = o; }
        }
#pragma unroll 1
        for (int gi = 0; gi < 2; ++gi) {
            const int gq = kvh * 2 + gi, half = 1 << gq;
            __syncthreads();
            { const int tt = tid >> 2, cq = tid & 3, sq = qb * 128 + tt;
              const int lo = sq - half < 0 ? 0 : sq - half, hi2 = sq + half > S ? S : sq + half;
              float acc[16];
#pragma unroll
              for (int j = 0; j < 16; ++j) acc[j] = 0.f;
              const bf16* zb = z + (size_t)tok0 * INW + OPX + gq * 64 + cq * 16;
#pragma unroll 1
              for (int i0 = 0; i0 < 2 * half; i0 += 4) {
                  v4u wa[4], wb[4]; float vf[4];
#pragma unroll
                  for (int i = 0; i < 4; ++i) { const int ss = sq - half + i0 + i; const bool ok = (i0 + i < 2 * half) && ss >= lo && ss < hi2; const int sc_ = ok ? ss : sq;
                      wa[i] = *(const GAS v4u*)(zb + (size_t)sc_ * INW); wb[i] = *(const GAS v4u*)(zb + (size_t)sc_ * INW + 8); vf[i] = ok ? 1.f : 0.f; }
#pragma unroll
                  for (int i = 0; i < 4; ++i) { const unsigned ww[8] = {wa[i].x, wa[i].y, wa[i].z, wa[i].w, wb[i].x, wb[i].y, wb[i].z, wb[i].w};
#pragma unroll
                      for (int q = 0; q < 8; ++q) { acc[2 * q] += vf[i] * __builtin_bit_cast(float, ww[q] << 16); acc[2 * q + 1] += vf[i] * __builtin_bit_cast(float, ww[q] & 0xffff0000u); } } }
              const float icnt = 1.0f / (float)(hi2 - lo);
              const bf16* zc = zb + (size_t)sq * INW;
              const v4u w0 = *(const GAS v4u*)zc, w1 = *(const GAS v4u*)(zc + 8); const unsigned ww[8] = {w0.x, w0.y, w0.z, w0.w, w1.x, w1.y, w1.z, w1.w};
              LAS float* pr = (LAS float*)(lds + P_OFF) + tt * PROW + cq * 16;
#pragma unroll
              for (int q = 0; q < 8; ++q) { pr[2 * q] = acc[2 * q] * icnt - __builtin_bit_cast(float, ww[q] << 16); pr[2 * q + 1] = acc[2 * q + 1] * icnt - __builtin_bit_cast(float, ww[q] & 0xffff0000u); } }
            __syncthreads();
            { const int e = tid & 63, tq8 = tid >> 6;
              float acc[16];
#pragma unroll
              for (int j = 0; j < 16; ++j) acc[j] = 0.f;
              const float* pw = pool_w + (size_t)gq * 64 * 64 + e;
#pragma unroll 4
              for (int c4 = 0; c4 < 16; ++c4) { const float wa = pw[(4 * c4) * 64], wb = pw[(4 * c4 + 1) * 64], wc = pw[(4 * c4 + 2) * 64], wd = pw[(4 * c4 + 3) * 64];
#pragma unroll
                  for (int tt = 0; tt < 16; ++tt) { const f32x4 pv = *(const LAS f32x4*)((LAS float*)(lds + P_OFF) + (tq8 * 16 + tt) * PROW + 4 * c4);
                      acc[tt] += pv.x * wa + pv.y * wb + pv.z * wc + pv.w * wd; } }
              const float sc = pool_scale[gq * 64 + e];
#pragma unroll
              for (int tt = 0; tt < 16; ++tt) mix[(size_t)(tok0 + qb * 128 + tq8 * 16 + tt) * D + 768 + gq * 64 + e] = (bf16)f2bf(acc[tt] * sc); }
        }
    }
}
}


namespace mk {
typedef float f32x2v __attribute__((ext_vector_type(2)));
__device__ __forceinline__ float gelu_erf(float x) { return 0.5f * x * (1.0f + erff(x * 0.70710678118654752f)); }


__device__ __forceinline__ void sort128(unsigned& k0, unsigned& k1, int lane_in) {
    int ln = lane_in; asm volatile("" : "+v"(ln));
#pragma unroll
    for (int lk = 1; lk <= 7; ++lk)
#pragma unroll
        for (int lj = lk - 1; lj >= 0; --lj) {
            if (lj == 6) { const unsigned mn = umin_(k0, k1), mx = umax_(k0, k1); k0 = mn; k1 = mx; }
            else { const unsigned bj = (unsigned)__builtin_amdgcn_sbfe(ln, lj, 1);
                const unsigned bk0 = (lk >= 7) ? 0u : (lk == 6 ? 0u : (unsigned)__builtin_amdgcn_sbfe(ln, lk, 1));
                const unsigned bk1 = (lk >= 7) ? 0u : (lk == 6 ? ~0u : (unsigned)__builtin_amdgcn_sbfe(ln, lk, 1));
                const unsigned f0 = bj ^ bk0, f1 = bj ^ bk1;
                const unsigned p0 = (unsigned)__shfl_xor((int)k0, 1 << lj), p1 = (unsigned)__shfl_xor((int)k1, 1 << lj);
                k0 = umin_(k0 ^ f0, p0 ^ f0) ^ f0; k1 = umin_(k1 ^ f1, p1 ^ f1) ^ f1; } }
}

__device__ __forceinline__ void peer_batch4(__amdgpu_buffer_rsrc_t U6, __amdgpu_buffer_rsrc_t V6, const float (&hf)[32], int ev, float suv, float cv, int lbase, float (&y)[32], int lane) {
    asm volatile("" ::: "memory");
    const int rh = lane >> 5, l5 = lane & 31, b4 = (lane >> 4) & 1;
    v4u ua4[2], va4[2]; v2u ua2[2], va2[2];
#pragma unroll
    for (int i = 0; i < 2; ++i) { const int e0 = __builtin_amdgcn_readlane(ev, lbase + 2 * i), e1 = __builtin_amdgcn_readlane(ev, lbase + 2 * i + 1);
        const int rb = (rh ? e1 : e0) * 768;
        ua4[i] = __builtin_amdgcn_raw_buffer_load_b128(U6, rb + 16 * l5, 0, 0); ua2[i] = __builtin_amdgcn_raw_buffer_load_b64(U6, rb + 512 + 8 * l5, 0, 0);
        va4[i] = __builtin_amdgcn_raw_buffer_load_b128(V6, rb + 16 * l5, 0, 0); va2[i] = __builtin_amdgcn_raw_buffer_load_b64(V6, rb + 512 + 8 * l5, 0, 0); }
    float p[2];
#pragma unroll
    for (int i = 0; i < 2; ++i) { v6u w; w[0] = ua4[i].x; w[1] = ua4[i].y; w[2] = ua4[i].z; w[3] = ua4[i].w; w[4] = ua2[i].x; w[5] = ua2[i].y;
        if (i > 0) asm volatile("" : "+v"(w) : "v"(p[i - 1]));
        const v32f f = __builtin_amdgcn_cvt_scalef32_pk32_f32_fp6(w, 1.0f);
        float s0 = 0.f;
#pragma unroll
        for (int k = 0; k < 32; ++k) s0 += f[k] * hf[k];
        p[i] = s0; }
    float sd;
    { const float snd = b4 ? p[0] : p[1]; const float rcv = __shfl_xor(snd, 16); sd = (b4 ? p[1] : p[0]) + rcv; }
    sd += __shfl_xor(sd, 8); sd += __shfl_xor(sd, 4); sd += __shfl_xor(sd, 2); sd += __shfl_xor(sd, 1);
    const int slot = lbase + 2 * b4 + rh;
    const float w = __shfl(cv, slot) * gelu_erf(sd * __shfl(suv, slot));
#pragma unroll
    for (int i = 0; i < 2; ++i) { const float wi = __shfl(w, (lane & 32) + 16 * i);
        v6u vw; vw[0] = va4[i].x; vw[1] = va4[i].y; vw[2] = va4[i].z; vw[3] = va4[i].w; vw[4] = va2[i].x; vw[5] = va2[i].y;
        asm volatile("" : "+v"(vw) : "v"(wi));
        const v32f f = __builtin_amdgcn_cvt_scalef32_pk32_f32_fp6(vw, 1.0f);
#pragma unroll
        for (int k = 0; k < 32; ++k) y[k] += wi * f[k]; }
}

template <int L> __device__ __forceinline__ void ph_peer(const Args& args, const XcdBarrier& bar) {
    const int lane = threadIdx.x & 63, wave = __builtin_amdgcn_readfirstlane(threadIdx.x >> 6);
    unsigned char* ws = args.ws;
    const __amdgpu_buffer_rsrc_t U6 = __builtin_amdgcn_make_buffer_rsrc(ws + WS_U + (size_t)L * NE * 768, 0, NE * 768, 0x00020000);
    const __amdgpu_buffer_rsrc_t V6 = __builtin_amdgcn_make_buffer_rsrc(ws + WS_V + (size_t)L * NE * 768, 0, NE * 768, 0x00020000);
    const float* SU = (const float*)(ws + WS_SU) + L * NE; const float* SV = (const float*)(ws + WS_SV) + L * NE;
    const bf16* Hb = (const bf16*)(ws + WS_H); const float* X1 = (const float*)(ws + WS_X1);
    const int* eidx = (const int*)(ws + WS_EIDX); const float* gate = (const float*)(ws + WS_GATE);
    const float* mod = (const float*)(ws + WS_MOD);
    float* outp = args.out;
    const int gw = MK_GW(wave), NGW = MK_NGW;
    const bool poison = __hip_atomic_load((unsigned*)(ws + WS_CTL) + CW_FP6, __ATOMIC_RELAXED, __HIP_MEMORY_SCOPE_AGENT) == 0u;
    const int ecol = 32 * (lane & 31) + 16 * (lane >> 5);
#pragma unroll 1
    for (int t = gw; t < T; t += NGW) {
        float hf[32];
#pragma unroll
        for (int q = 0; q < 4; ++q) { const v4u h = *(const GAS v4u*)(Hb + (size_t)t * D + 32 * (lane & 31) + 8 * q); const unsigned hw[4] = {h.x, h.y, h.z, h.w};
#pragma unroll
            for (int d = 0; d < 4; ++d) { hf[8 * q + 2 * d] = __builtin_bit_cast(float, hw[d] << 16); hf[8 * q + 2 * d + 1] = __builtin_bit_cast(float, hw[d] & 0xffff0000u); } }
        unsigned k0 = ((unsigned)eidx[(size_t)t * 128 + lane] << 7) | (unsigned)lane, k1 = ((unsigned)eidx[(size_t)t * 128 + 64 + lane] << 7) | (unsigned)(64 + lane);
        sort128(k0, k1, lane);
        const int e0 = (int)(k0 >> 7), e1 = (int)(k1 >> 7);
        const float su0 = SU[e0], su1 = SU[e1];
        const float c0 = gate[(size_t)t * 128 + (k0 & 127u)] * SV[e0], c1 = gate[(size_t)t * 128 + (k1 & 127u)] * SV[e1];
        float y[32];
#pragma unroll
        for (int i = 0; i < 32; ++i) y[i] = 0.f;
#pragma unroll 1
        for (int bt = 0; bt < 32; ++bt)
            peer_batch4(U6, V6, hf, (bt < 16) ? e0 : e1, (bt < 16) ? su0 : su1, (bt < 16) ? c0 : c1, (bt & 15) * 4, y, lane);
        asm volatile("" ::: "memory");
        float ys[16];
#pragma unroll
        for (int i = 0; i < 16; ++i) { const float mine = (lane >> 5) ? y[16 + i] : y[i], give = (lane >> 5) ? y[i] : y[16 + i]; ys[i] = mine + __shfl_xor(give, 32); }
        const float* g2 = mod + ((size_t)L * B + t / S) * 6 * D + 5 * D;
        float xo[16]; float ssq = 0.f;
        const float qnan = __builtin_nanf("");
#pragma unroll
        for (int hf4 = 0; hf4 < 4; ++hf4) { const int col = ecol + 4 * hf4;
            const f32x4 xv = *(const GAS f32x4*)(X1 + (size_t)t * D + col), gg = *(const f32x4*)(g2 + col);
            f32x4 o; o.x = xv.x + gg.x * ys[4 * hf4 + 0]; o.y = xv.y + gg.y * ys[4 * hf4 + 1]; o.z = xv.z + gg.z * ys[4 * hf4 + 2]; o.w = xv.w + gg.w * ys[4 * hf4 + 3];
            if (poison) o = (f32x4){qnan, qnan, qnan, qnan};
            *(GAS f32x4*)(outp + (size_t)t * D + col) = o;
            xo[4 * hf4 + 0] = o.x; xo[4 * hf4 + 1] = o.y; xo[4 * hf4 + 2] = o.z; xo[4 * hf4 + 3] = o.w;
            ssq += (o.x * o.x + o.y * o.y) + (o.z * o.z + o.w * o.w); }
        if (L + 1 < DEPTH) {
            const float rstd = 1.0f / sqrtf(wave_sum(ssq) * (1.f / D) + EPS);
            const float* g = args.in[3] + (L + 1) * D; const float* mb = mod + ((size_t)(L + 1) * B + t / S) * 6 * D;
            float hv[16];
#pragma unroll
            for (int hf4 = 0; hf4 < 4; ++hf4) { const int col = ecol + 4 * hf4;
                const f32x4 gg = *(const f32x4*)(g + col), sh = *(const f32x4*)(mb + col), sc = *(const f32x4*)(mb + D + col);
                hv[4 * hf4 + 0] = xo[4 * hf4 + 0] * rstd * gg.x * (1.0f + sc.x) + sh.x; hv[4 * hf4 + 1] = xo[4 * hf4 + 1] * rstd * gg.y * (1.0f + sc.y) + sh.y;
                hv[4 * hf4 + 2] = xo[4 * hf4 + 2] * rstd * gg.z * (1.0f + sc.z) + sh.z; hv[4 * hf4 + 3] = xo[4 * hf4 + 3] * rstd * gg.w * (1.0f + sc.w) + sh.w; }
#pragma unroll
            for (int pc = 0; pc < 2; ++pc) { v4u o; o.x = pk2(hv[8 * pc + 0], hv[8 * pc + 1]); o.y = pk2(hv[8 * pc + 2], hv[8 * pc + 3]); o.z = pk2(hv[8 * pc + 4], hv[8 * pc + 5]); o.w = pk2(hv[8 * pc + 6], hv[8 * pc + 7]);
                *(GAS v4u*)((bf16*)(ws + WS_H) + (size_t)t * D + ecol + 8 * pc) = o; }
        }
    }
}
}

namespace mk {
constexpr int LDS_XB_OFF = LDS_BYTES - 64;
template <int L> __device__ __forceinline__ void layer_phases(const Args& args, LAS unsigned char* lds, const XcdBarrier& bar) {
    const int lo = args.ph_lo, hi = args.ph_hi;
#define IN(k) (lo <= (k) && (k) < hi)
#define SEAM(k) do { if (IN(k) && IN((k) + 1)) xcd_barrier(bar); } while (0)
    constexpr int pb = PH_L0 + L * PH_PER_LAYER;
    if (IN(pb + PH_G1)) for (int rep = 0; rep < REP_GEMM; ++rep) ph_g1<L>(args, lds);
    SEAM(pb + PH_G1);
    if (IN(pb + PH_AT)) for (int rep = 0; rep < REP_AT; ++rep) ph_mixer<L>(args, lds);
    SEAM(pb + PH_AT);
    if (IN(pb + PH_G2)) for (int rep = 0; rep < REP_GEMM; ++rep) ph_g2<L>(args, lds);
    SEAM(pb + PH_G2);
    if (IN(pb + PH_N2)) for (int rep = 0; rep < REP_N2; ++rep) ph_hmod<L, 1>(args);
    SEAM(pb + PH_N2);
    if (IN(pb + PH_G3)) for (int rep = 0; rep < REP_GEMM; ++rep) ph_g3<L>(args, lds);
    SEAM(pb + PH_G3);
    if (IN(pb + PH_TK)) for (int rep = 0; rep < REP_TK; ++rep) ph_topk<L>(args, lds);
    SEAM(pb + PH_TK);
    if (IN(pb + PH_PE)) for (int rep = 0; rep < (L == 1 ? REP_PE1 : 1); ++rep) ph_peer<L>(args, bar);
    if (L + 1 < DEPTH) SEAM(pb + PH_PE);
#undef SEAM
#undef IN
}

__global__ void __launch_bounds__(NT, 2) mk_fwd(Args args) {
    extern __shared__ __attribute__((aligned(16))) unsigned char lds_raw[];
    LAS unsigned char* lds = (LAS unsigned char*)lds_raw;
    const int lo = args.ph_lo, hi = args.ph_hi;
    if (threadIdx.x < 16) ((LAS unsigned*)(lds + LDS_XB_OFF))[threadIdx.x] = 0u;
    __syncthreads();
    XcdBarrier bar; bar.bar = (unsigned*)(args.ws + WS_CTL) + CW_BAR; bar.x = 0; bar.st = nullptr;
    if (hi - lo > 1) bar = xcd_barrier_post((unsigned*)(args.ws + WS_CTL) + CW_BAR, (volatile LAS unsigned*)(lds + LDS_XB_OFF));
#define IN(k) (lo <= (k) && (k) < hi)
#define SEAM(k) do { if (IN(k) && IN((k) + 1)) xcd_barrier(bar); } while (0)
    if (IN(PH_PRO)) for (int rep = 0; rep < REP_PRO; ++rep) ph_prologue(args, lds);
    SEAM(PH_PRO);
    if (IN(PH_H0)) ph_hmod<0, 0>(args);
    SEAM(PH_H0);
    layer_phases<0>(args, lds, bar);
    layer_phases<1>(args, lds, bar);
#undef SEAM
#undef IN
}
}


extern "C" void kernel_launch(void* const* d_in, const int* in_sizes, int n_in, void* d_out, int out_size, void* d_ws, size_t ws_size, hipStream_t stream) {
    using namespace mk;
    static int grid = 0;
    if (grid == 0) {
        if (n_in != 19 || ws_size < WS_END || out_size != T * D) { fprintf(stderr, "kernel_launch: bad n_in %d / out_size %d / ws_size %zu\n", n_in, out_size, ws_size); grid = -1; return; }
        int dev = 0, cus = 0, per_cu = 0;
        if (hipGetDevice(&dev) != hipSuccess || hipDeviceGetAttribute(&cus, hipDeviceAttributeMultiprocessorCount, dev) != hipSuccess) { grid = -1; return; }
        if (hipFuncSetAttribute((const void*)mk_fwd, hipFuncAttributeMaxDynamicSharedMemorySize, LDS_BYTES) != hipSuccess) { fprintf(stderr, "hipFuncSetAttribute failed\n"); grid = -1; return; }
        if (hipOccupancyMaxActiveBlocksPerMultiprocessor(&per_cu, (const void*)mk_fwd, NT, LDS_BYTES) != hipSuccess) per_cu = 0;
        (void)hipGetLastError();
        grid = (per_cu >= 1) ? cus : -1;
        if (grid < 0) { fprintf(stderr, "kernel_launch: occupancy query says %d workgroups per CU; nothing launched\n", per_cu); return; }
    }
    if (grid < 0) return;
    unsigned char* ws = (unsigned char*)d_ws;
    (void)hipMemsetAsync(ws + WS_CTL, 0, CTL_ZERO_BYTES, stream);
    Args a{};
    for (int i = 0; i < 19; ++i) a.in[i] = (const float*)d_in[i];
    a.out = (float*)d_out; a.ws = ws;
#if MK_SPLIT
    for (int ph = 0; ph < PH_END; ++ph) { a.ph_lo = ph; a.ph_hi = ph + 1;
        const int pl = ph >= PH_L0 ? (ph - PH_L0) % PH_PER_LAYER : -1;
        const int reps = (pl == PH_G1 || pl == PH_G2 || pl == PH_G3) ? HREP_GEMM : (pl == PH_AT) ? HREP_AT : (pl == PH_TK) ? HREP_TK : (pl == PH_N2 || ph == PH_H0) ? HREP_N2 : (ph == PH_PRO) ? HREP_PRO : 1;
        for (int rep = 0; rep < reps; ++rep) hipLaunchKernelGGL(mk_fwd, dim3(grid), dim3(NT), LDS_BYTES, stream, a); }
#else
    a.ph_lo = 0; a.ph_hi = PH_END;
    hipLaunchKernelGGL(mk_fwd, dim3(grid), dim3(NT), LDS_BYTES, stream, a);
#endif
}
```

```cpp
#include <hip/hip_runtime.h>
#include <stdint.h>
#include <math.h>
#include <cstdio>

#ifndef BATCH
#define BATCH 8
#endif
#ifndef SEQ
#define SEQ 2048
#endif
#ifndef MK_SPLIT
#define MK_SPLIT 0
#endif
#define Z_F32 0
#ifndef HREP_GEMM
#define HREP_GEMM 1
#endif
#ifndef HREP_AT
#define HREP_AT 1
#endif
#ifndef HREP_TK
#define HREP_TK 1
#endif
#ifndef HREP_N2
#define HREP_N2 1
#endif
#ifndef HREP_PRO
#define HREP_PRO 1
#endif
#ifndef PE_SYNC
#define PE_SYNC 0
#endif
#ifndef PE_NP
#define PE_NP 4
#endif
#ifndef PE_NTOK
#define PE_NTOK 1
#endif
#ifndef REP_PRO
#define REP_PRO 1
#endif
#ifndef REP_GEMM
#define REP_GEMM 1
#endif
#ifndef REP_AT
#define REP_AT 1
#endif
#ifndef REP_TK
#define REP_TK 1
#endif
#ifndef REP_PE1
#define REP_PE1 1
#endif
#ifndef REP_N2
#define REP_N2 1
#endif
#define QP_F32 0
#define DO_UV 1

namespace cfg {
constexpr int B = BATCH, S = SEQ, T = B * S, D = 1024, DEPTH = 2;
constexpr int HDIM = 64, NQH = 8, NKVH = 2, GRP = 4, WIN = 128;
constexpr int INW = 1792, OQ = 0, OK_ = 512, OV = 640, OCX = 768, OCB = 1024, OCC = 1280, OPX = 1536;
constexpr int PH = 8, NK = 128, NE = 16384, QD = 256, TOPK = 16, PW = 2048;
constexpr float EPS = 1e-6f;
}
using namespace cfg;

namespace pg8 {
#define PG8_LAS __attribute__((address_space(3)))
typedef unsigned short bf16_t;
typedef short bf16x8 __attribute__((ext_vector_type(8)));
typedef float f32x4 __attribute__((ext_vector_type(4)));
typedef unsigned u32x4 __attribute__((ext_vector_type(4)));
constexpr int BM = 256, BK = 64, HALF = 128, HTB = HALF * BK * 2  , STAGE_BYTES = 8 * HTB, NXCD = 8, WGM = 8;

__host__ __device__ __forceinline__ int lds_byte(int r, int c) { const int st = (r >> 4) * 2 + (c >> 5), rr = r & 15, cc = c & 31, ob = rr * 64 + cc * 2; return st * 1024 + (ob ^ (((ob >> 9) & 1) << 5)); }
__host__ __device__ __forceinline__ void stage_rc(int b, int& R, int& C) { const int st = b / 1024, sb = b % 1024, swz = sb ^ (((sb >> 9) & 1) << 5); R = (st >> 1) * 16 + swz / 64; C = (st & 1) * 32 + (swz % 64) / 2; }
__host__ __device__ __forceinline__ int perm32(int rho) { const int n = rho >> 4, i = rho & 15; return 8 * (i >> 2) + 4 * n + (i & 3); }

struct Unit { int pm, pn; };
struct Gemm { const bf16_t* A; const bf16_t* Bt; int M, N, K; };

struct StaticOrder {
    int nM, nN, nwg, G, c;
    __host__ __device__ void init(int M, int N, int G_, int c_) { nM = M / BM; nN = N / BM; nwg = nM * nN; G = G_; c = c_; }
    __host__ __device__ bool next(int i, Unit& u) const {
        const long L = (long)i * G + c; if (L >= nwg) return false;
        int wgid = (int)L; { const int q = nwg / NXCD, r = nwg % NXCD, xcd = wgid % NXCD, off = wgid / NXCD; wgid = (xcd < r ? xcd * (q + 1) : r * (q + 1) + (xcd - r) * q) + off; }
        const int nig = WGM * nN, gid = wgid / nig, fm = gid * WGM, gsz = (nM - fm) < WGM ? (nM - fm) : WGM;
        u.pm = fm + ((wgid % nig) % gsz); u.pn = (wgid % nig) / gsz; return true;
    }
    __device__ __forceinline__ void a_ready(const Unit&) const {}
    __device__ __forceinline__ void done(const Unit&) const {}
};

__device__ __forceinline__ unsigned cvt_pk_bf16(float lo, float hi) { unsigned r; asm volatile("v_cvt_pk_bf16_f32 %0, %1, %2" : "=v"(r) : "v"(lo), "v"(hi)); return r; }
typedef float f32x2 __attribute__((ext_vector_type(2)));
__device__ __forceinline__ f32x2 gelu_pk(f32x2 v) {
    const f32x2 av = __builtin_elementwise_abs(v), d = av * 0.2316418882f + 1.0f;
    f32x2 t; t.x = __builtin_amdgcn_rcpf(d.x); t.y = __builtin_amdgcn_rcpf(d.y);
    f32x2 q = t * 0.5307027145f + (-0.7265760135f); q = q * t + 0.7107068705f; q = q * t + (-0.142248368f); q = q * t + 0.127414796f; q = q * t;
    const f32x2 s = (v * v) * (-0.72134752044f);
    f32x2 e; e.x = __builtin_amdgcn_exp2f(s.x); e.y = __builtin_amdgcn_exp2f(s.y);
    const f32x2 m = v * (q * e), r = v - m;
    f32x2 o; o.x = v.x < 0.f ? m.x : r.x; o.y = v.y < 0.f ? m.y : r.y; return o;
}

template <int ACT  > struct EpiBf16 {
    static constexpr bool PERM = true, AFTER_DRAIN = false; static_assert(ACT == 0 || ACT == 1, "EpiBf16: ACT is 0 (none) or 1 (gelu_pk)");
    bf16_t* O; int ldc; const float* bias; int split_cols; size_t split_stride; float scale0;
    __device__ __forceinline__ void operator()(const f32x4 (&acc)[2][2][4][2], const Unit& u, int wr, int wc, int fr, int fq) const {
        const int row0 = u.pm * BM + wr * 64 + fr; int colt = u.pn * BM; bf16_t* base = O;
        float sc = 1.f; if (split_cols) { const int t = colt / split_cols; base += (size_t)t * split_stride; colt -= t * split_cols; if (t == 0) sc = scale0; }
        const int col0 = colt + wc * 32 + 8 * fq, bcol0 = u.pn * BM + wc * 32 + 8 * fq;
        f32x4 bv[2][2];
#pragma unroll
        for (int bj = 0; bj < 2; ++bj)
#pragma unroll
            for (int n = 0; n < 2; ++n) bv[bj][n] = bias ? *(const f32x4*)(bias + bcol0 + bj * HALF + 4 * n) : (f32x4){0.f, 0.f, 0.f, 0.f};
#pragma unroll
        for (int ai = 0; ai < 2; ++ai)
#pragma unroll
            for (int m = 0; m < 4; ++m) { bf16_t* rowp = base + (size_t)(row0 + ai * HALF + m * 16) * ldc + col0;
#pragma unroll
                for (int bj = 0; bj < 2; ++bj) { f32x4 v0 = acc[ai][bj][m][0] + bv[bj][0], v1 = acc[ai][bj][m][1] + bv[bj][1];
                    if (ACT == 1) { f32x2 a = gelu_pk((f32x2){v0[0], v0[1]}), b = gelu_pk((f32x2){v0[2], v0[3]}), c = gelu_pk((f32x2){v1[0], v1[1]}), d = gelu_pk((f32x2){v1[2], v1[3]});
                        v0 = (f32x4){a.x, a.y, b.x, b.y}; v1 = (f32x4){c.x, c.y, d.x, d.y}; }
                    v0 = v0 * sc; v1 = v1 * sc; u32x4 w; w.x = cvt_pk_bf16(v0[0], v0[1]); w.y = cvt_pk_bf16(v0[2], v0[3]); w.z = cvt_pk_bf16(v1[0], v1[1]); w.w = cvt_pk_bf16(v1[2], v1[3]);
                    *(u32x4*)(rowp + bj * HALF) = w; } }
    }
};

template <class Epi, class Sched, bool ALIGN_EPI = false, bool SP2 = false>
__device__ __forceinline__ void gemm_phase(PG8_LAS unsigned char* lds, const Gemm g, const Sched& S, const Epi& E) {
    const int tid = threadIdx.x, wid = __builtin_amdgcn_readfirstlane(tid >> 6), lane = tid & 63, wr = wid >> 2, wc = wid & 3, fr = lane & 15, fq = lane >> 4;
    const int K = g.K, nt = K / BK;
    unsigned voffA[2], voffB[2];
#pragma unroll
    for (int i = 0; i < 2; ++i) { int R, C; stage_rc(tid * 16 + i * 8192, R, C); const int Rb = Epi::PERM ? ((R & ~31) + perm32(R & 31)) : R;
        voffA[i] = (unsigned)(R * K + C) * 2u; voffB[i] = (unsigned)(Rb * K + C) * 2u; }
    const size_t kstep = (size_t)(BK * 2);
    const size_t hstep = (size_t)HALF * K * 2;
    const size_t tstep = 2 * hstep;
    const unsigned ldsw = (unsigned)wid * 1024u;
    const int aoff = lds_byte(wr * 64 + fr, fq * 8), boff = lds_byte(wc * 32 + fr, fq * 8);
#define PG8_SA(b, h) (((b) * 2 + (h)) * HTB)
#define PG8_SB(b, h) ((4 + (b) * 2 + (h)) * HTB)
#define PG8_STAGE(bufoff, gbase, voff) do { _Pragma("unroll") for (int _i = 0; _i < 2; ++_i) \
        __builtin_amdgcn_global_load_lds((const unsigned*)((const char*)(gbase) + (voff)[_i]), (PG8_LAS unsigned*)(lds + (bufoff) + ldsw + _i * 8192), 16, 0, 0); } while (0)
#define PG8_LDA(dst, b, h) do { _Pragma("unroll") for (int m = 0; m < 4; ++m) _Pragma("unroll") for (int k = 0; k < 2; ++k) dst[m][k] = *(const PG8_LAS bf16x8*)(lds + PG8_SA(b, h) + aoff + m * 2048 + k * 1024); } while (0)
#define PG8_LDB(dst, b, h) do { _Pragma("unroll") for (int n = 0; n < 2; ++n) _Pragma("unroll") for (int k = 0; k < 2; ++k) dst[n][k] = *(const PG8_LAS bf16x8*)(lds + PG8_SB(b, h) + boff + n * 2048 + k * 1024); } while (0)
#define PG8_MMA(ai, bj, At, Bt) do { __builtin_amdgcn_s_setprio(1); _Pragma("unroll") for (int m = 0; m < 4; ++m) _Pragma("unroll") for (int n = 0; n < 2; ++n) _Pragma("unroll") for (int k = 0; k < 2; ++k) \
        acc[ai][bj][m][n] = __builtin_amdgcn_mfma_f32_16x16x32_bf16(Bt[n][k], At[m][k], acc[ai][bj][m][n], 0, 0, 0); __builtin_amdgcn_s_setprio(0); } while (0)
#define PG8_WAIT_V(n) asm volatile("s_waitcnt vmcnt(" #n ")" ::: "memory")
#define PG8_WAIT_L(n) asm volatile("s_waitcnt lgkmcnt(" #n ")" ::: "memory")
#define PG8_BAR __builtin_amdgcn_s_barrier()
#define PG8_SCHED __builtin_amdgcn_sched_barrier(0)
    Unit cur, nxt; int ui = 0;
    if (!S.next(0, cur)) return;
    f32x4 acc[2][2][4][2];
#pragma unroll
    for (int a = 0; a < 2; ++a)
#pragma unroll
        for (int b = 0; b < 2; ++b)
#pragma unroll
            for (int m = 0; m < 4; ++m)
#pragma unroll
                for (int n = 0; n < 2; ++n) acc[a][b][m][n] = (f32x4){0.f, 0.f, 0.f, 0.f};
    bf16x8 At[4][2], B0[2][2], B1[2][2];
    const char* cA = (const char*)g.A + (size_t)cur.pm * tstep; const char* cB = (const char*)g.Bt + (size_t)cur.pn * tstep;
    S.a_ready(cur);
    if constexpr (SP2) {
        PG8_STAGE(PG8_SB(0, 0), cB, voffB); PG8_STAGE(PG8_SB(0, 1), cB + hstep, voffB); PG8_STAGE(PG8_SA(0, 0), cA, voffA); PG8_STAGE(PG8_SA(0, 1), cA + hstep, voffA);
        if (wr == 1) PG8_BAR;
        PG8_WAIT_V(2); PG8_BAR;
        PG8_STAGE(PG8_SB(1, 0), cB + kstep, voffB); PG8_STAGE(PG8_SA(1, 0), cA + kstep, voffA); PG8_STAGE(PG8_SB(1, 1), cB + hstep + kstep, voffB);
        PG8_WAIT_V(6); PG8_BAR;
    } else {
        PG8_STAGE(PG8_SB(0, 0), cB, voffB); PG8_STAGE(PG8_SA(0, 0), cA, voffA); PG8_STAGE(PG8_SB(0, 1), cB + hstep, voffB); PG8_STAGE(PG8_SA(0, 1), cA + hstep, voffA);
        if (wr == 1) PG8_BAR;
        PG8_WAIT_V(4); PG8_BAR;
        PG8_STAGE(PG8_SB(1, 0), cB + kstep, voffB); PG8_STAGE(PG8_SA(1, 0), cA + kstep, voffA); PG8_STAGE(PG8_SB(1, 1), cB + hstep + kstep, voffB);
        PG8_WAIT_V(6); PG8_BAR;
    }
    for (;;) {
        const bool has_next = S.next(ui + 1, nxt);
        const char* nA = has_next ? (const char*)g.A + (size_t)nxt.pm * tstep : cA; const char* nB = has_next ? (const char*)g.Bt + (size_t)nxt.pn * tstep : cB;
        for (int t = 0; t < nt; t += 2) {
            const bool last = (t == nt - 2);
            const char* a1 = cA + (size_t)(t + 1) * kstep;
            const char* a2 = last ? nA : cA + (size_t)(t + 2) * kstep; const char* b2 = last ? nB : cB + (size_t)(t + 2) * kstep;
            const char* a3 = a2 + kstep; const char* b3 = b2 + kstep;
            if (last && has_next) S.a_ready(nxt);
            if constexpr (SP2) {
            PG8_LDB(B0, 0, 0); PG8_LDB(B1, 0, 1); PG8_SCHED; PG8_LDA(At, 0, 0); PG8_STAGE(PG8_SA(1, 1), a1 + hstep, voffA);
            PG8_WAIT_V(8); PG8_WAIT_L(0); PG8_BAR; PG8_MMA(0, 0, At, B0); PG8_MMA(0, 1, At, B1); PG8_BAR; PG8_SCHED;
            PG8_LDA(At, 0, 1); PG8_STAGE(PG8_SB(0, 0), b2, voffB); PG8_STAGE(PG8_SB(0, 1), b2 + hstep, voffB); PG8_STAGE(PG8_SA(0, 0), a2, voffA);
            PG8_WAIT_V(8); PG8_WAIT_L(0); PG8_BAR; PG8_MMA(1, 0, At, B0); PG8_MMA(1, 1, At, B1); PG8_BAR; PG8_SCHED;
            PG8_LDB(B0, 1, 0); PG8_LDB(B1, 1, 1); PG8_SCHED; PG8_LDA(At, 1, 0); PG8_STAGE(PG8_SA(0, 1), a2 + hstep, voffA);
            PG8_WAIT_V(8); PG8_WAIT_L(0); PG8_BAR; PG8_MMA(0, 0, At, B0); PG8_MMA(0, 1, At, B1); PG8_BAR; PG8_SCHED;
            PG8_LDA(At, 1, 1); PG8_STAGE(PG8_SB(1, 0), b3, voffB); PG8_STAGE(PG8_SB(1, 1), b3 + hstep, voffB); PG8_STAGE(PG8_SA(1, 0), a3, voffA);
            PG8_WAIT_V(8); PG8_WAIT_L(0); PG8_BAR; PG8_MMA(1, 0, At, B0); PG8_MMA(1, 1, At, B1); PG8_BAR; PG8_SCHED;
            } else {
            PG8_LDB(B0, 0, 0); PG8_SCHED; PG8_LDA(At, 0, 0); PG8_STAGE(PG8_SA(1, 1), a1 + hstep, voffA);
            PG8_WAIT_L(8); PG8_BAR; PG8_WAIT_L(0); PG8_MMA(0, 0, At, B0); PG8_BAR; PG8_SCHED;
            PG8_LDB(B1, 0, 1); PG8_STAGE(PG8_SB(0, 0), b2, voffB);
            PG8_BAR; PG8_WAIT_L(0); PG8_MMA(0, 1, At, B1); PG8_BAR;
            PG8_LDA(At, 0, 1); PG8_STAGE(PG8_SA(0, 0), a2, voffA);
            PG8_BAR; PG8_WAIT_L(0); PG8_MMA(1, 0, At, B0); PG8_BAR; PG8_SCHED;
            PG8_STAGE(PG8_SB(0, 1), b2 + hstep, voffB);
            PG8_WAIT_V(6); PG8_BAR; PG8_MMA(1, 1, At, B1); PG8_BAR;
            PG8_LDB(B0, 1, 0); PG8_SCHED; PG8_LDA(At, 1, 0); PG8_STAGE(PG8_SA(0, 1), a2 + hstep, voffA);
            PG8_WAIT_L(8); PG8_BAR; PG8_WAIT_L(0); PG8_MMA(0, 0, At, B0); PG8_BAR; PG8_SCHED;
            PG8_LDB(B1, 1, 1); PG8_STAGE(PG8_SB(1, 0), b3, voffB);
            PG8_BAR; PG8_WAIT_L(0); PG8_MMA(0, 1, At, B1); PG8_BAR;
            PG8_LDA(At, 1, 1); PG8_STAGE(PG8_SA(1, 0), a3, voffA);
            PG8_BAR; PG8_WAIT_L(0); PG8_MMA(1, 0, At, B0); PG8_BAR; PG8_SCHED;
            PG8_STAGE(PG8_SB(1, 1), b3 + hstep, voffB);
            PG8_WAIT_V(6); PG8_BAR; PG8_MMA(1, 1, At, B1); PG8_BAR;
            }
        }
        if constexpr (ALIGN_EPI) { if (wr == 0) PG8_BAR; }
        if constexpr (!Epi::AFTER_DRAIN) { E(acc, cur, wr, wc, fr, fq); S.done(cur); }
        if (!has_next) break;
#pragma unroll
        for (int a = 0; a < 2; ++a)
#pragma unroll
            for (int b = 0; b < 2; ++b)
#pragma unroll
                for (int m = 0; m < 4; ++m)
#pragma unroll
                    for (int n = 0; n < 2; ++n) acc[a][b][m][n] = (f32x4){0.f, 0.f, 0.f, 0.f};
        cur = nxt; cA = nA; cB = nB; ++ui;
        if constexpr (ALIGN_EPI) { if (wr == 1) PG8_BAR; }
    }
    PG8_WAIT_V(0);
    if constexpr (!ALIGN_EPI) { if (wr == 0) PG8_BAR; }
    PG8_BAR;
    if constexpr (Epi::AFTER_DRAIN) { E.fused(acc, cur, wr, wc, fr, fq, lds, wid, lane); S.done(cur); }
#undef PG8_SA
#undef PG8_SB
#undef PG8_STAGE
#undef PG8_LDA
#undef PG8_LDB
#undef PG8_MMA
#undef PG8_WAIT_V
#undef PG8_WAIT_L
#undef PG8_BAR
#undef PG8_SCHED
}
}

namespace pg8 {
struct EpiF32 {
    static constexpr bool PERM = false, AFTER_DRAIN = false;
    float* C; int ldc;
    __device__ __forceinline__ void operator()(const f32x4 (&acc)[2][2][4][2], const Unit& u, int wr, int wc, int fr, int fq) const {
        const int row0 = u.pm * BM + wr * 64 + fr, col0 = u.pn * BM + wc * 32 + 4 * fq;
#pragma unroll
        for (int ai = 0; ai < 2; ++ai)
#pragma unroll
            for (int m = 0; m < 4; ++m) { float* rowp = C + (size_t)(row0 + ai * HALF + m * 16) * ldc + col0;
#pragma unroll
                for (int bj = 0; bj < 2; ++bj)
#pragma unroll
                    for (int n = 0; n < 2; ++n) *(f32x4*)(rowp + bj * HALF + n * 16) = acc[ai][bj][m][n]; }
    }
};
struct EpiResid {
    static constexpr bool PERM = false, AFTER_DRAIN = false;
    const float* base; float* out; int ldc; const float* gate0; int rows_per_b; int gstride;
    __device__ __forceinline__ void operator()(const f32x4 (&acc)[2][2][4][2], const Unit& u, int wr, int wc, int fr, int fq) const {
        const int row0 = u.pm * BM + wr * 64 + fr, col0 = u.pn * BM + wc * 32 + 4 * fq;
        const float* gp = gate0 + (size_t)((u.pm * BM) / rows_per_b) * gstride + col0;
        f32x4 gv[2][2];
#pragma unroll
        for (int bj = 0; bj < 2; ++bj)
#pragma unroll
            for (int n = 0; n < 2; ++n) gv[bj][n] = *(const f32x4*)(gp + bj * HALF + n * 16);
#pragma unroll
        for (int ai = 0; ai < 2; ++ai)
#pragma unroll
            for (int m = 0; m < 4; ++m) { const size_t off = (size_t)(row0 + ai * HALF + m * 16) * ldc + col0;
#pragma unroll
                for (int bj = 0; bj < 2; ++bj)
#pragma unroll
                    for (int n = 0; n < 2; ++n) { const f32x4 bs = *(const f32x4*)(base + off + bj * HALF + n * 16);
                        *(f32x4*)(out + off + bj * HALF + n * 16) = bs + gv[bj][n] * acc[ai][bj][m][n]; }
                if (m & 1) asm volatile("" ::: "memory"); }
    }
};
}

namespace mk {
#define GAS __attribute__((address_space(1)))
#define LAS __attribute__((address_space(3)))
typedef unsigned short bf16;
typedef unsigned v4u __attribute__((ext_vector_type(4)));
typedef unsigned v2u __attribute__((ext_vector_type(2)));
typedef float f32x4 __attribute__((ext_vector_type(4)));
#define LDS_WAIT() asm volatile("s_waitcnt lgkmcnt(0)" ::: "memory")
#define VM_WAIT() asm volatile("s_waitcnt vmcnt(0)" ::: "memory")
__device__ __forceinline__ unsigned f2bf(float f) { unsigned u = __builtin_bit_cast(unsigned, f); return (u + 0x7fffu + ((u >> 16) & 1u)) >> 16; }
__device__ __forceinline__ unsigned pk2(float lo, float hi) { return f2bf(lo) | (f2bf(hi) << 16); }
__device__ __forceinline__ float bf2f(unsigned short h) { return __builtin_bit_cast(float, (unsigned)h << 16); }

constexpr int NWAVES = 8, NT = 512;
constexpr int RING_BYTES = 131072, LDSCTL_OFF = RING_BYTES, LDS_BYTES = 147456;
constexpr size_t MiB = 1u << 20;
constexpr size_t WS_CTL = 0, CTL_ZERO_BYTES = 1 * MiB;
constexpr size_t WS_MOD = 1 * MiB, WS_KEYS = 2 * MiB, WS_WIN = 4 * MiB, WS_WOUT = 12 * MiB, WS_WQ = 16 * MiB, WS_H = 24 * MiB, WS_X1 = 56 * MiB;
constexpr size_t WS_EIDX = 120 * MiB, WS_GATE = 128 * MiB, WS_A = 136 * MiB, WS_MIX = 200 * MiB, WS_U = 232 * MiB, WS_V = 264 * MiB, WS_END = 296 * MiB;
constexpr size_t WS_SU = 3 * MiB, WS_SV = 3 * MiB + 512 * 1024;
constexpr size_t WS_T1 = 232 * MiB, WS_T2 = 360 * MiB, WS_TEND = 488 * MiB;
constexpr int CW_BAR = 4096, CW_FP6 = 64;

enum { PH_PRO = 0, PH_H0 = 1, PH_L0 = 2, PH_PER_LAYER = 7, PH_G1 = 0, PH_AT = 1, PH_G2 = 2, PH_N2 = 3, PH_G3 = 4, PH_TK = 5, PH_PE = 6, PH_END = PH_L0 + 2 * PH_PER_LAYER, PH_H1 = 100 };

struct Args { const float* in[19]; float* out; unsigned char* ws; int ph_lo, ph_hi; };

__device__ __forceinline__ void p0_transpose_item(const float* W, int K, int N, bf16* WT, LAS float* scr, int item, int lane) {
    const int nblk = N / 32, kb = item / nblk, nb = item % nblk, k0 = 64 * kb, n0 = 32 * nb;
#pragma unroll 8
    for (int i = 0; i < 32; ++i) { const int kk = 2 * i + (lane >> 5); scr[kk * 33 + (lane & 31)] = W[(size_t)(k0 + kk) * N + n0 + (lane & 31)]; }
    LDS_WAIT(); asm volatile("" ::: "memory");
    const int c = lane & 7;
#pragma unroll
    for (int j = 0; j < 4; ++j) { const int n = (lane >> 3) + 8 * j; const LAS float* s = scr + (8 * c) * 33 + n;
        v4u o; o.x = pk2(s[0 * 33], s[1 * 33]); o.y = pk2(s[2 * 33], s[3 * 33]); o.z = pk2(s[4 * 33], s[5 * 33]); o.w = pk2(s[6 * 33], s[7 * 33]);
        *(GAS v4u*)(WT + (size_t)(n0 + n) * K + k0 + 8 * c) = o; }
    LDS_WAIT(); asm volatile("" ::: "memory");
}
__device__ __forceinline__ float wave_sum(float v) {
#pragma unroll
    for (int o = 1; o < 64; o <<= 1) v += __shfl_xor(v, o);
    return v;
}
__device__ __forceinline__ void hmod_row(const float* xrow, const float* g, const float* mod_b, int which, bf16* orow, int lane) {
    const GAS f32x4* xr = (const GAS f32x4*)xrow + lane;
    f32x4 v[4]; float s = 0.f;
#pragma unroll
    for (int j = 0; j < 4; ++j) { v[j] = xr[64 * j]; s += (v[j].x * v[j].x + v[j].y * v[j].y) + (v[j].z * v[j].z + v[j].w * v[j].w); }
    const float rstd = 1.0f / sqrtf(wave_sum(s) * (1.f / D) + EPS);
    const float* shp = mod_b + (which * 3 + 0) * D; const float* scp = mod_b + (which * 3 + 1) * D;
    GAS unsigned long long* o8 = (GAS unsigned long long*)orow + lane;
#pragma unroll
    for (int j = 0; j < 4; ++j) { const int k = 4 * lane + 256 * j;
        const f32x4 gg = *(const f32x4*)(g + k), sh = *(const f32x4*)(shp + k), sc = *(const f32x4*)(scp + k);
        const f32x4 hv = v[j] * rstd * gg * (sc + 1.0f) + sh;
        o8[64 * j] = (unsigned long long)pk2(hv.x, hv.y) | ((unsigned long long)pk2(hv.z, hv.w) << 32); }
}


#define MK_GW(wave) (((gridDim.x % 8 == 0) ? (blockIdx.x % 8) * (gridDim.x / 8) + blockIdx.x / 8 : blockIdx.x) * NWAVES + (wave))
#define MK_NGW (gridDim.x * NWAVES)


typedef float v16f __attribute__((ext_vector_type(16)));
typedef float v32f __attribute__((ext_vector_type(32)));
typedef unsigned v6u __attribute__((ext_vector_type(6)));
__device__ __forceinline__ float fp6_val(int k) { return k < 8 ? 0.125f * (float)k : 0.125f * (float)(8 + (k & 7)) * (float)(1 << ((k >> 3) - 1)); }
__device__ __forceinline__ int fp6_arrangement() {
    float zero = 0.f; asm volatile("" : "+v"(zero));
    v16f a, b;
#pragma unroll
    for (int i = 0; i < 16; ++i) { a[i] = fp6_val(i) + zero; b[i] = fp6_val(16 + i) + zero; }
    const v6u p = __builtin_amdgcn_cvt_scalef32_2xpk16_fp6_f32(a, b, 1.0f);
    const v32f f = __builtin_amdgcn_cvt_scalef32_pk32_f32_fp6(p, 1.0f);
    bool seq = true, il = true;
#pragma unroll
    for (int k = 0; k < 32; ++k) seq = seq && (f[k] == fp6_val(k));
#pragma unroll
    for (int i = 0; i < 16; ++i) il = il && (f[2 * i] == fp6_val(i)) && (f[2 * i + 1] == fp6_val(16 + i));
    return seq ? 1 : (il ? 2 : 0);
}

__device__ __forceinline__ void ph_prologue(const Args& args, LAS unsigned char* lds) {
    const int tid = threadIdx.x, lane = tid & 63, wave = __builtin_amdgcn_readfirstlane(tid >> 6);
    const int G = gridDim.x, bx = blockIdx.x;
    unsigned char* ws = args.ws;
    {
        const float* c = args.in[1]; const float* w_ada = args.in[5]; const float* b_ada = args.in[6]; float* mod = (float*)(ws + WS_MOD);
        LAS float* sact = (LAS float*)lds; LAS float* red = (LAS float*)(lds + 32768);
        for (int i = tid; i < B * D; i += NT) { const float cv = c[i]; sact[i] = cv / (1.0f + __expf(-cv)); }
        __syncthreads();
        for (int item = bx; item < DEPTH * (6 * D / 32); item += G) {
            const int l = item / (6 * D / 32), n0 = (item % (6 * D / 32)) * 32, cc = tid & 31, kg = tid >> 5;
            float acc[B];
#pragma unroll
            for (int b = 0; b < B; ++b) acc[b] = 0.f;
            const float* w = w_ada + (size_t)l * D * 6 * D + n0 + cc;
            for (int kk = 0; kk < 64; ++kk) { const int k = kg * 64 + kk; const float wv = w[(size_t)k * 6 * D];
#pragma unroll
                for (int b = 0; b < B; ++b) acc[b] += sact[b * D + k] * wv; }
#pragma unroll
            for (int b = 0; b < B; ++b) red[(kg * 32 + cc) * B + b] = acc[b];
            __syncthreads();
            if (tid < 32 * B) { const int c2 = tid & 31, b = tid >> 5; float s = 0.f;
                for (int k2 = 0; k2 < 16; ++k2) s += red[(k2 * 32 + c2) * B + b];
                mod[((size_t)l * B + b) * 6 * D + n0 + c2] = s + b_ada[(size_t)l * 6 * D + n0 + c2]; }
            __syncthreads();
        }
    }
    const int gw = MK_GW(wave), NGW = MK_NGW;
    {
        const float* w_in = args.in[7]; const float* w_out = args.in[14]; const float* peer_wq = args.in[15];
        bf16* WinT = (bf16*)(ws + WS_WIN); bf16* WoutT = (bf16*)(ws + WS_WOUT); bf16* WqT = (bf16*)(ws + WS_WQ);
        LAS float* scr = (LAS float*)(lds + wave * 16384);
        constexpr int I_IN = (D / 64) * (INW / 32), I_OUT = (D / 64) * (D / 32), I_Q = (D / 64) * (PW / 32), I_L = I_IN + I_OUT + I_Q;
        for (int it = gw; it < DEPTH * I_L; it += NGW) {
            const int l = it / I_L; int r = it % I_L;
            if (r < I_IN) { p0_transpose_item(w_in + (size_t)l * D * INW, D, INW, WinT + (size_t)l * INW * D, scr, r, lane); continue; } r -= I_IN;
            if (r < I_OUT) { p0_transpose_item(w_out + (size_t)l * D * D, D, D, WoutT + (size_t)l * D * D, scr, r, lane); continue; } r -= I_OUT;
            p0_transpose_item(peer_wq + (size_t)l * D * PW, D, PW, WqT + (size_t)l * PW * D, scr, r, lane);
        }
    }
    {
        const float* peer_keys = args.in[16]; bf16* keysb = (bf16*)(ws + WS_KEYS);
        for (int i = gw * 64 + lane; i < DEPTH * 2 * NK * 128 / 2; i += NGW * 64) ((GAS unsigned*)keysb)[i] = pk2(peer_keys[2 * i], peer_keys[2 * i + 1]);
    }
    {
        const float* peer_u = args.in[17]; const float* peer_v = args.in[18];
        unsigned char* U6 = ws + WS_U; unsigned char* V6 = ws + WS_V; float* SU = (float*)(ws + WS_SU); float* SV = (float*)(ws + WS_SV);
        const int arr = fp6_arrangement();
        if (threadIdx.x == 0) __hip_atomic_store((unsigned*)(ws + WS_CTL) + CW_FP6, (unsigned)arr, __ATOMIC_RELAXED, __HIP_MEMORY_SCOPE_AGENT);
        LAS unsigned char* scr = lds + wave * 16384;
        const int rh = lane >> 5, l5 = lane & 31;
        for (int rp = gw; rp < DEPTH * NE / 2; rp += NGW) {
            for (int tb = 0; tb < 2; ++tb) {
                const float* srcb = (tb ? peer_v : peer_u) + (size_t)(2 * rp) * D;
#pragma unroll
                for (int rr = 0; rr < 2; ++rr)
#pragma unroll
                    for (int j = 0; j < 4; ++j) { const f32x4 v = ((const GAS f32x4*)(srcb + (size_t)rr * D))[64 * j + lane];
                        *(LAS f32x4*)(scr + rr * 4608 + (8 * j + (lane >> 3)) * 144 + 16 * (lane & 7)) = v; }
                LDS_WAIT(); asm volatile("" ::: "memory");
                float x[32]; float am = 0.f;
#pragma unroll
                for (int q = 0; q < 8; ++q) { const f32x4 v = *(const LAS f32x4*)(scr + rh * 4608 + l5 * 144 + 16 * q); x[4 * q] = v.x; x[4 * q + 1] = v.y; x[4 * q + 2] = v.z; x[4 * q + 3] = v.w;
                    am = fmaxf(am, fmaxf(fmaxf(fabsf(v.x), fabsf(v.y)), fmaxf(fabsf(v.z), fabsf(v.w)))); }
                LDS_WAIT(); asm volatile("" ::: "memory");
#pragma unroll
                for (int o = 1; o < 32; o <<= 1) am = fmaxf(am, __shfl_xor(am, o));
                const float sc = am > 0.f ? am * (1.0f / 7.5f) : 1.0f, inv = 1.0f / sc;
                v16f a, b;
#pragma unroll
                for (int i = 0; i < 16; ++i) { a[i] = (arr == 2 ? x[2 * i] : x[i]) * inv; b[i] = (arr == 2 ? x[2 * i + 1] : x[16 + i]) * inv; }
                const v6u p = __builtin_amdgcn_cvt_scalef32_2xpk16_fp6_f32(a, b, 1.0f);
                unsigned char* drow = (tb ? V6 : U6) + (size_t)(2 * rp + rh) * 768;
                v4u p4; p4.x = p[0]; p4.y = p[1]; p4.z = p[2]; p4.w = p[3]; v2u p2; p2.x = p[4]; p2.y = p[5];
                *(GAS v4u*)(drow + 16 * l5) = p4; *(GAS v2u*)(drow + 512 + 8 * l5) = p2;
                if (l5 == 0) (tb ? SV : SU)[2 * rp + rh] = sc;
            }
        }
    }
}
template <int L, int WHICH> __device__ __forceinline__ void ph_hmod(const Args& args) {
    const int lane = threadIdx.x & 63, wave = __builtin_amdgcn_readfirstlane(threadIdx.x >> 6);
    unsigned char* ws = args.ws;
    const float* src = WHICH ? (const float*)(ws + WS_X1) : (L == 0 ? args.in[0] : args.out);
    const float* g = args.in[WHICH ? 4 : 3] + L * D; const float* mod_l = (const float*)(ws + WS_MOD) + (size_t)L * B * 6 * D; bf16* Hb = (bf16*)(ws + WS_H);
    const int gw = MK_GW(wave), NGW = MK_NGW;
    for (int m = gw; m < T; m += NGW) hmod_row(src + (size_t)m * D, g, mod_l + (size_t)(m / S) * 6 * D, WHICH, Hb + (size_t)m * D, lane);
}
template <int L> __device__ __forceinline__ void ph_g1(const Args& args, LAS unsigned char* lds) {
    unsigned char* ws = args.ws;
    pg8::Gemm g{(const bf16*)(ws + WS_H), (const bf16*)(ws + WS_WIN) + (size_t)L * INW * D, T, INW, D}; pg8::StaticOrder SO; SO.init(T, INW, gridDim.x, blockIdx.x);
#if Z_F32
    pg8::EpiF32 E{(float*)(ws + WS_T1), INW};
    pg8::gemm_phase<pg8::EpiF32, pg8::StaticOrder, true, true>(lds, g, SO, E);
#else
    pg8::EpiBf16<0> E{(bf16*)(ws + WS_A), INW, nullptr, 0, 0, 1.f};
    pg8::gemm_phase<pg8::EpiBf16<0>, pg8::StaticOrder, true, true>(lds, g, SO, E);
#endif
}
template <int L> __device__ __forceinline__ void ph_g2(const Args& args, LAS unsigned char* lds) {
    unsigned char* ws = args.ws;
    pg8::Gemm g{(const bf16*)(ws + WS_MIX), (const bf16*)(ws + WS_WOUT) + (size_t)L * D * D, T, D, D}; pg8::StaticOrder SO; SO.init(T, D, gridDim.x, blockIdx.x);
    pg8::EpiResid E{L == 0 ? args.in[0] : args.out, (float*)(ws + WS_X1), D, (const float*)(ws + WS_MOD) + (size_t)L * B * 6 * D + 2 * D, S, 6 * D};
    pg8::gemm_phase<pg8::EpiResid, pg8::StaticOrder, true, true>(lds, g, SO, E);
}
template <int L> __device__ __forceinline__ void ph_g3(const Args& args, LAS unsigned char* lds) {
    unsigned char* ws = args.ws;
    pg8::Gemm g{(const bf16*)(ws + WS_H), (const bf16*)(ws + WS_WQ) + (size_t)L * PW * D, T, PW, D}; pg8::StaticOrder SO; SO.init(T, PW, gridDim.x, blockIdx.x);
#if QP_F32
    pg8::EpiF32 E{(float*)(ws + WS_T1), PW};
    pg8::gemm_phase<pg8::EpiF32, pg8::StaticOrder, true, true>(lds, g, SO, E);
#else
    pg8::EpiBf16<0> E{(bf16*)(ws + WS_A), PW, nullptr, 0, 0, 1.f};
    pg8::gemm_phase<pg8::EpiBf16<0>, pg8::StaticOrder, true, true>(lds, g, SO, E);
#endif
}
}

namespace mk {
#define XB_TMO      128
#define XB_XCNT(j)  (256  + 64 * (j))
#define XB_XSUB(j)  (1280 + 64 * (j))
#define XB_XGEN(j)  (2304 + 64 * (j))
#define XB_TOP      3328
#define XB_TOPGEN   3392
#define XCD_BAR_WORDS 3456
#define XB_SPIN_CAP (1u << 18)

__device__ __forceinline__ unsigned xb_ld(unsigned* p)              { return __hip_atomic_load(p, __ATOMIC_RELAXED, __HIP_MEMORY_SCOPE_AGENT); }
__device__ __forceinline__ unsigned xb_add(unsigned* p, unsigned v) { return __hip_atomic_fetch_add(p, v, __ATOMIC_RELAXED, __HIP_MEMORY_SCOPE_AGENT); }
__device__ __forceinline__ unsigned xb_xcc_id() { return (unsigned)__builtin_amdgcn_s_getreg((3 << 11) | 20) & 0xFu; }
#define XB_SPIN(cond, bar) do { unsigned _sp = 0; while (cond) { __builtin_amdgcn_s_sleep(1); \
    if ((++_sp & 255u) == 0u) { if (xb_ld(&(bar)[XB_TMO])) break; if (_sp > XB_SPIN_CAP) { atomicAdd(&(bar)[XB_TMO], 1u); break; } } } } while (0)

struct XcdBarrier {
    unsigned* bar; unsigned x;
    volatile LAS unsigned* st;
};

__device__ __forceinline__ XcdBarrier xcd_barrier_post(unsigned* bar, volatile LAS unsigned* st) {
    XcdBarrier b; b.bar = bar; b.x = xb_xcc_id(); b.st = st;
    if (threadIdx.x == 0) (void)xb_add(&bar[XB_XCNT(b.x)], 1u);
    return b;
}
__device__ __forceinline__ void xcd_barrier_complete(unsigned* bar, unsigned x, unsigned& nloc, unsigned& nx) {
    const unsigned G = gridDim.x * gridDim.y * gridDim.z;
    unsigned sum, cnt, mine, sp = 0u;
    for (;;) {
        sum = 0u; cnt = 0u; mine = 0u;
#pragma unroll
        for (unsigned j = 0; j < 16; ++j) { const unsigned c = xb_ld(&bar[XB_XCNT(j)]); sum += c; cnt += (c > 0u) ? 1u : 0u; mine = (j == x) ? c : mine; }
        if (sum == G) break;
        __builtin_amdgcn_s_sleep(1);
        if ((++sp & 255u) == 0u) { if (xb_ld(&bar[XB_TMO])) break; if (sp > XB_SPIN_CAP) { atomicAdd(&bar[XB_TMO], 1u); break; } }
    }
    nloc = mine > 0u ? mine : 1u; nx = cnt > 0u ? cnt : 1u;
}

__device__ __forceinline__ void xcd_barrier(const XcdBarrier& b) {
    asm volatile("s_waitcnt vmcnt(0)" ::: "memory");
    __syncthreads();
    if (threadIdx.x == 0) {
        unsigned* bar = b.bar;
        __builtin_amdgcn_s_waitcnt(0);
        unsigned nloc = b.st[0], nx = b.st[1];
        if (nloc == 0u) { xcd_barrier_complete(bar, b.x, nloc, nx); b.st[0] = nloc; b.st[1] = nx; }
        const unsigned old = xb_add(&bar[XB_XSUB(b.x)], 1u);
        const unsigned gen = old / nloc;
        if (old + 1u == (gen + 1u) * nloc) {
            __builtin_amdgcn_fence(__ATOMIC_RELEASE, "agent");
            asm volatile("s_waitcnt vmcnt(0)" ::: "memory");
            const unsigned og = xb_add(&bar[XB_TOP], 1u);
            const unsigned tg = og / nx;
            if (og + 1u == (tg + 1u) * nx) xb_add(&bar[XB_TOPGEN], 1u);
            else XB_SPIN(xb_ld(&bar[XB_TOPGEN]) == tg, bar);
            __builtin_amdgcn_fence(__ATOMIC_ACQUIRE, "agent");
            xb_add(&bar[XB_XGEN(b.x)], 1u);
            asm volatile("s_waitcnt vmcnt(0)" ::: "memory");
        } else {
            XB_SPIN(xb_ld(&bar[XB_XGEN(b.x)]) == gen, bar);
            __builtin_amdgcn_fence(__ATOMIC_ACQUIRE, "agent");
            asm volatile("s_waitcnt vmcnt(0)" ::: "memory");
        }
    }
    __syncthreads();
}

}


namespace mk {
typedef short bf16x8 __attribute__((ext_vector_type(8)));
typedef float f32x16 __attribute__((ext_vector_type(16)));
__device__ __forceinline__ unsigned f2sort(float f) { const unsigned u = __builtin_bit_cast(unsigned, f); return u ^ ((unsigned)((int)u >> 31) | 0x80000000u); }
__device__ __forceinline__ float sort2f(unsigned s) { const unsigned m = (unsigned)((int)s >> 31); return __builtin_bit_cast(float, s ^ (~m | 0x80000000u)); }
__device__ __forceinline__ unsigned umax_(unsigned a, unsigned b) { return a > b ? a : b; }
__device__ __forceinline__ unsigned umin_(unsigned a, unsigned b) { return a < b ? a : b; }
__device__ __forceinline__ void sort16_desc(unsigned (&v)[16]) {
#pragma unroll
    for (int k = 2; k <= 16; k <<= 1)
#pragma unroll
        for (int j = k >> 1; j > 0; j >>= 1)
#pragma unroll
            for (int i = 0; i < 16; ++i) { const int l = i ^ j; if (l > i) { const unsigned a = v[i], b = v[l], mx = umax_(a, b), mn = umin_(a, b);
                if ((i & k) == 0) { v[i] = mx; v[l] = mn; } else { v[i] = mn; v[l] = mx; } } }
}
__device__ __forceinline__ void merge16_desc(unsigned (&a)[16], const unsigned (&b)[16]) {
#pragma unroll
    for (int i = 0; i < 16; ++i) a[i] = umax_(a[i], b[15 - i]);
#pragma unroll
    for (int j = 8; j > 0; j >>= 1)
#pragma unroll
        for (int i = 0; i < 16; ++i) { const int l = i ^ j; if (l > i) { const unsigned x = a[i], y = a[l]; a[i] = umax_(x, y); a[l] = umin_(x, y); } }
}
__device__ __forceinline__ void xmerge16_desc(unsigned (&a)[16]) {
    unsigned p[16];
#pragma unroll
    for (int i = 0; i < 16; ++i) p[i] = (unsigned)__shfl_xor((int)a[i], 32);
    merge16_desc(a, p);
}
#define TK_CANDS \
    TKC(0, 0, 0, 2, 1) \
    TKC(1, 0, 1, 2, 2) \
    TKC(2, 0, 2, 2, 3) \
    TKC(3, 0, 3, 2, 4) \
    TKC(4, 0, 4, 3, 0) \
    TKC(5, 0, 5, 3, 1) \
    TKC(6, 0, 6, 3, 2) \
    TKC(7, 0, 7, 3, 3) \
    TKC(8, 0, 8, 4, 0) \
    TKC(9, 0, 9, 4, 1) \
    TKC(10, 0, 10, 4, 2) \
    TKC(11, 0, 11, 5, 0) \
    TKC(12, 0, 12, 5, 1) \
    TKC(13, 0, 13, 6, 0) \
    TKC(14, 0, 14, 6, 1) \
    TKC(15, 0, 15, 7, 0) \
    TKC(16, 1, 0, 7, 1) \
    TKC(17, 1, 1, 8, 0) \
    TKC(18, 1, 2, 9, 0) \
    TKC(19, 1, 3, 10, 0) \
    TKC(20, 1, 4, 11, 0) \
    TKC(21, 1, 5, 12, 0) \
    TKC(22, 1, 6, 13, 0) \
    TKC(23, 1, 7, 14, 0) \
    TKC(24, 2, 0, 15, 0)

template <int L> __device__ __forceinline__ void ph_topk(const Args& args, LAS unsigned char* lds) {
    const int tid = threadIdx.x, lane = tid & 63, wave = __builtin_amdgcn_readfirstlane(tid >> 6);
    const int c = lane & 31, hi = lane >> 5;
    unsigned char* ws = args.ws;
    const bf16* keysb = (const bf16*)(ws + WS_KEYS) + (size_t)L * 2 * NK * 128;
    const bf16* qp = (const bf16*)(ws + WS_A);
    int* eidx = (int*)(ws + WS_EIDX); float* gate = (float*)(ws + WS_GATE);
    constexpr int KROW = 272;
    for (int ch = tid; ch < 256 * 16; ch += NT) { const int r = ch >> 4, cc = ch & 15; *(LAS v4u*)(lds + r * KROW + cc * 16) = *(const GAS v4u*)(keysb + r * 128 + cc * 8); }
    __syncthreads();
    LAS unsigned* wl = (LAS unsigned*)(lds + 256 * KROW + wave * 4096) + c * 32;
    const int gw = MK_GW(wave), NGW = MK_NGW;
    const unsigned h4 = 4u * (unsigned)hi;
    for (int pass = gw; pass < T * PH / 32; pass += NGW) {
        const int row = pass * 32 + c;
        const bf16* qrow = qp + (size_t)row * 256 + hi * 8;
        unsigned top[2][16];
#pragma unroll
        for (int half = 0; half < 2; ++half) {
            bf16x8 bq[8];
#pragma unroll
            for (int ks = 0; ks < 8; ++ks) bq[ks] = *(const GAS bf16x8*)(qrow + half * 128 + ks * 16);
            f32x16 acc[4];
#pragma unroll
            for (int mt = 0; mt < 4; ++mt)
#pragma unroll
                for (int r = 0; r < 16; ++r) acc[mt][r] = 0.f;
#pragma unroll
            for (int ks = 0; ks < 8; ++ks)
#pragma unroll
                for (int mt = 0; mt < 4; ++mt) { const bf16x8 a = *(const LAS bf16x8*)(lds + (half * 128 + mt * 32 + c) * KROW + (ks * 16 + hi * 8) * 2);
                    acc[mt] = __builtin_amdgcn_mfma_f32_32x32x16_bf16(a, bq[ks], acc[mt], 0, 0, 0); }
            unsigned g[4][16];
#pragma unroll
            for (int mt = 0; mt < 4; ++mt)
#pragma unroll
                for (int r = 0; r < 16; ++r) { const unsigned code = (unsigned)(127 - mt * 32 - (r & 3) - 8 * (r >> 2)) - h4;
                    g[mt][r] = (f2sort(acc[mt][r]) & ~127u) | code; }
#pragma unroll
            for (int mt = 0; mt < 4; ++mt) sort16_desc(g[mt]);
            merge16_desc(g[0], g[1]); merge16_desc(g[2], g[3]); merge16_desc(g[0], g[2]);
            xmerge16_desc(g[0]);
#pragma unroll
            for (int i = 0; i < 16; ++i) top[half][i] = g[0][i];
        }
#pragma unroll
        for (int q = 0; q < 4; ++q) { v4u w;
            w.x = hi ? top[1][4 * q + 0] : top[0][4 * q + 0]; w.y = hi ? top[1][4 * q + 1] : top[0][4 * q + 1];
            w.z = hi ? top[1][4 * q + 2] : top[0][4 * q + 2]; w.w = hi ? top[1][4 * q + 3] : top[0][4 * q + 3];
            *(LAS v4u*)(wl + hi * 16 + 4 * q) = w; }
        float v1[16], v2[16];
#pragma unroll
        for (int i = 0; i < 16; ++i) { v1[i] = sort2f(top[0][i] & ~127u); v2[i] = sort2f(top[1][i] & ~127u); }
        unsigned cd[2][16];
#pragma unroll
        for (int i = 0; i < 16; ++i) { cd[0][i] = 0u; cd[1][i] = 0u; }
#define TKC(q, i0, j0, i1, j1) { const float sm = hi ? (v1[i1] + v2[j1]) : (v1[i0] + v2[j0]); const unsigned code = hi ? (unsigned)(255 - ((i1) * 16 + (j1))) : (unsigned)(255 - ((i0) * 16 + (j0))); \
            cd[(q) >> 4][(q) & 15] = (f2sort(sm) & ~255u) | code; }
        TK_CANDS
#undef TKC
        sort16_desc(cd[0]); sort16_desc(cd[1]); merge16_desc(cd[0], cd[1]); xmerge16_desc(cd[0]);
        float ev[16]; int ex[16]; float den = 0.f;
        const float vmax = sort2f(cd[0][0] & ~255u);
#pragma unroll
        for (int r = 0; r < 16; ++r) { const unsigned key = cd[0][r], pos = 255u - (key & 255u);
            const unsigned k1 = wl[pos >> 4], k2 = wl[16 + (pos & 15u)];
            ex[r] = (int)((127u - (k1 & 127u)) * 128u + (127u - (k2 & 127u)));
            ev[r] = __expf(sort2f(key & ~255u) - vmax); den += ev[r]; }
        const float inv = 1.0f / den;
        if (hi == 0) {
#pragma unroll
            for (int q = 0; q < 4; ++q) { v4u w; w.x = (unsigned)ex[4 * q]; w.y = (unsigned)ex[4 * q + 1]; w.z = (unsigned)ex[4 * q + 2]; w.w = (unsigned)ex[4 * q + 3]; *(GAS v4u*)(eidx + (size_t)row * 16 + 4 * q) = w; }
        } else {
#pragma unroll
            for (int q = 0; q < 4; ++q) { f32x4 w; w.x = ev[4 * q] * inv; w.y = ev[4 * q + 1] * inv; w.z = ev[4 * q + 2] * inv; w.w = ev[4 * q + 3] * inv; *(GAS f32x4*)(gate + (size_t)row * 16 + 4 * q) = w; }
        }
    }
}
}


namespace mk {
typedef short bf16x4v __attribute__((ext_vector_type(4)));
__device__ __forceinline__ unsigned cvt_pk_bf16(float lo, float hi) { unsigned r; asm volatile("v_cvt_pk_bf16_f32 %0, %1, %2" : "=v"(r) : "v"(lo), "v"(hi)); return r; }
__device__ __forceinline__ void head_prep(const bf16* src  , const float* g, int h, int pos, float scl, v4u (&outp)[4]) {
    float v[4][8]; float ss = 0.f;
#pragma unroll
    for (int ks = 0; ks < 4; ++ks) { const v4u w = *(const GAS v4u*)(src + ks * 16);
        const unsigned ww[4] = {w.x, w.y, w.z, w.w};
#pragma unroll
        for (int q = 0; q < 4; ++q) { v[ks][2 * q] = __builtin_bit_cast(float, ww[q] << 16); v[ks][2 * q + 1] = __builtin_bit_cast(float, ww[q] & 0xffff0000u); }
#pragma unroll
        for (int j = 0; j < 8; ++j) ss += v[ks][j] * v[ks][j]; }
    ss += __shfl_xor(ss, 32);
    const float r = scl / sqrtf(ss * (1.0f / 64.0f) + EPS);
#pragma unroll
    for (int ks = 0; ks < 4; ++ks) { const f32x4 g0 = *(const f32x4*)(g + ks * 16 + 8 * h), g1 = *(const f32x4*)(g + ks * 16 + 8 * h + 4);
        v[ks][0] *= r * g0.x; v[ks][1] *= r * g0.y; v[ks][2] *= r * g0.z; v[ks][3] *= r * g0.w; v[ks][4] *= r * g1.x; v[ks][5] *= r * g1.y; v[ks][6] *= r * g1.z; v[ks][7] *= r * g1.w; }
#pragma unroll
    for (int i = 0; i < 8; ++i) { const float other = __shfl_xor(v[0][i], 32);
        constexpr float INVF[8] = {1.0f, 0.1939227432012558f, 0.03760603070259094f, 0.007292664609849453f, 0.0014142135623842478f, 0.00027424818836152554f, 5.318296098266728e-05f, 1.0313386155758053e-05f};
        float rev = ((float)pos * INVF[i]) * 0.15915494309189535f; rev -= floorf(rev);
        const float sn = __builtin_amdgcn_sinf(rev), cs = __builtin_amdgcn_cosf(rev);
        v[0][i] = h ? (v[0][i] * cs + other * sn) : (v[0][i] * cs - other * sn); }
#pragma unroll
    for (int ks = 0; ks < 4; ++ks) { outp[ks].x = pk2(v[ks][0], v[ks][1]); outp[ks].y = pk2(v[ks][2], v[ks][3]); outp[ks].z = pk2(v[ks][4], v[ks][5]); outp[ks].w = pk2(v[ks][6], v[ks][7]); }
}

template <int L> __device__ __forceinline__ void ph_mixer(const Args& args, LAS unsigned char* lds) {
    const int tid = threadIdx.x, lane = tid & 63, wave = __builtin_amdgcn_readfirstlane(tid >> 6);
    const int c = lane & 31, hi = lane >> 5;
    unsigned char* ws = args.ws;
    const bf16* z = (const bf16*)(ws + WS_A); bf16* mix = (bf16*)(ws + WS_MIX);
    const int* positions = (const int*)args.in[2];
    const float* qg = args.in[8] + L * 64; const float* kg = args.in[9] + L * 64; const float* sink = args.in[10] + L * NQH;
    const float* conv_w = args.in[11] + L * 3 * 256; const float* pool_w = args.in[12] + (size_t)L * 4 * 64 * 64; const float* pool_scale = args.in[13] + L * 256;
    constexpr int KROW = 144, VROW = 776, K_OFF = 0, V_OFF = 384 * KROW, P_OFF = V_OFF + 64 * VROW, PROW = 68;
    constexpr int NQB = S / 128;
    for (int unit = blockIdx.x; unit < B * NKVH * NQB; unit += gridDim.x) {
        const int qb = unit % NQB, kvh = (unit / NQB) % NKVH, b = unit / (NQB * NKVH);
        const int tok0 = b * S, kbase = qb * 128 - 128;
        __syncthreads();
        for (int pass = wave; pass < 12; pass += NWAVES) { const int kr = pass * 32 + c, kp = kbase + kr;
            if (kp >= 0 && kp < S) {
                v4u o[4]; head_prep(z + (size_t)(tok0 + kp) * INW + OK_ + kvh * 64 + 8 * hi, kg, hi, positions[tok0 + kp], 1.0f, o);
#pragma unroll
                for (int ks = 0; ks < 4; ++ks) *(LAS v4u*)(lds + K_OFF + kr * KROW + (ks * 16 + 8 * hi) * 2) = o[ks]; } }
        for (int ch = tid; ch < 384 * 8; ch += NT) { const int kr = ch >> 3, dc = ch & 7, kp = kbase + kr;
            if (kp >= 0 && kp < S) { const v4u w = *(const GAS v4u*)(z + (size_t)(tok0 + kp) * INW + OV + kvh * 64 + dc * 8);
                const unsigned ww[4] = {w.x, w.y, w.z, w.w};
#pragma unroll
                for (int q = 0; q < 4; ++q) { *(LAS unsigned short*)(lds + V_OFF + (dc * 8 + 2 * q) * VROW + kr * 2) = (unsigned short)(ww[q] & 0xffffu);
                                              *(LAS unsigned short*)(lds + V_OFF + (dc * 8 + 2 * q + 1) * VROW + kr * 2) = (unsigned short)(ww[q] >> 16); } } }
        __syncthreads();
        {
            const int g = wave >> 1, qh = wave & 1, hq = kvh * GRP + g;
            const float sk = sink[hq] * 1.4426950408889634f;
#pragma unroll 1
            for (int qt = 0; qt < 2; ++qt) {
                const int a = qb * 128 + qh * 64 + qt * 32;
                const int tq = tok0 + a + c;
                v4u qf[4]; head_prep(z + (size_t)tq * INW + OQ + hq * 64 + 8 * hi, qg, hi, positions[tq], 0.125f * 1.4426950408889634f, qf);
                bf16x8 bq[4];
#pragma unroll
                for (int ks = 0; ks < 4; ++ks) bq[ks] = __builtin_bit_cast(bf16x8, qf[ks]);
                float m = sk, lsum = hi ? 0.f : 1.f;
                f32x16 O0, O1;
#pragma unroll
                for (int r = 0; r < 16; ++r) { O0[r] = 0.f; O1[r] = 0.f; }
#pragma unroll 1
                for (int kt = 0; kt < 9; ++kt) {
                    const int kp0 = a - 128 + 32 * kt;
                    if (kp0 < 0 || kp0 >= S) continue;
                    const int kr0 = kp0 - kbase;
                    f32x16 sa;
#pragma unroll
                    for (int r = 0; r < 16; ++r) sa[r] = 0.f;
#pragma unroll
                    for (int ks = 0; ks < 4; ++ks) { const bf16x8 ka = *(const LAS bf16x8*)(lds + K_OFF + (kr0 + c) * KROW + (ks * 16 + 8 * hi) * 2);
                        sa = __builtin_amdgcn_mfma_f32_32x32x16_bf16(ka, bq[ks], sa, 0, 0, 0); }
                    if (kt == 0) {
#pragma unroll
                        for (int r = 0; r < 16; ++r) { const int i = (r & 3) + 8 * (r >> 2) + 4 * hi; if (i < c) sa[r] = -1e30f; }
                    } else if (kt == 8) {
#pragma unroll
                        for (int r = 0; r < 16; ++r) { const int i = (r & 3) + 8 * (r >> 2) + 4 * hi; if (i > c) sa[r] = -1e30f; }
                    }
                    float mx = sa[0];
#pragma unroll
                    for (int r = 1; r < 16; ++r) mx = fmaxf(mx, sa[r]);
                    mx = fmaxf(mx, __shfl_xor(mx, 32));
                    if (__any(mx > m + 11.0f)) {
                        const float mn = fmaxf(m, mx), al = __builtin_amdgcn_exp2f(m - mn);
                        m = mn; lsum *= al;
#pragma unroll
                        for (int r = 0; r < 16; ++r) { O0[r] *= al; O1[r] *= al; }
                    }
                    float p[16]; float rs = 0.f;
#pragma unroll
                    for (int r = 0; r < 16; ++r) { p[r] = __builtin_amdgcn_exp2f(sa[r] - m); rs += p[r]; }
                    lsum += rs;
#pragma unroll
                    for (int s2 = 0; s2 < 2; ++s2) {
                        v4u pw; pw.x = cvt_pk_bf16(p[8 * s2 + 0], p[8 * s2 + 1]); pw.y = cvt_pk_bf16(p[8 * s2 + 2], p[8 * s2 + 3]); pw.z = cvt_pk_bf16(p[8 * s2 + 4], p[8 * s2 + 5]); pw.w = cvt_pk_bf16(p[8 * s2 + 6], p[8 * s2 + 7]);
                        const bf16x8 pb = __builtin_bit_cast(bf16x8, pw);
#pragma unroll
                        for (int mt = 0; mt < 2; ++mt) { const LAS unsigned char* vp = lds + V_OFF + (mt * 32 + c) * VROW + (kr0 + 16 * s2 + 4 * hi) * 2;
                            const v2u lo2 = *(const LAS v2u*)vp, hi2 = *(const LAS v2u*)(vp + 16);
                            v4u va; va.x = lo2.x; va.y = lo2.y; va.z = hi2.x; va.w = hi2.y;
                            if (mt == 0) O0 = __builtin_amdgcn_mfma_f32_32x32x16_bf16(__builtin_bit_cast(bf16x8, va), pb, O0, 0, 0, 0);
                            else         O1 = __builtin_amdgcn_mfma_f32_32x32x16_bf16(__builtin_bit_cast(bf16x8, va), pb, O1, 0, 0, 0); }
                    }
                }
                const float inv = 1.0f / (lsum + __shfl_xor(lsum, 32));
                bf16* orow = mix + (size_t)tq * D + hq * 64 + 4 * hi;
#pragma unroll
                for (int q = 0; q < 4; ++q) { v2u w0, w1;
                    w0.x = pk2(O0[4 * q] * inv, O0[4 * q + 1] * inv); w0.y = pk2(O0[4 * q + 2] * inv, O0[4 * q + 3] * inv);
                    w1.x = pk2(O1[4 * q] * inv, O1[4 * q + 1] * inv); w1.y = pk2(O1[4 * q + 2] * inv, O1[4 * q + 3] * inv);
                    *(GAS v2u*)(orow + 8 * q) = w0; *(GAS v2u*)(orow + 32 + 8 * q) = w1; }
            }
        }
        if (kvh == 0) {
            const int chunk = tid & 31, tg = tid >> 5, c8 = chunk * 8;
            float w0[8], w1[8], w2[8];
#pragma unroll
            for (int j = 0; j < 8; ++j) { w0[j] = conv_w[c8 + j]; w1[j] = conv_w[256 + c8 + j]; w2[j] = conv_w[512 + c8 + j]; }
#pragma unroll 2
            for (int r = 0; r < 8; ++r) { const int sq = qb * 128 + r * 16 + tg; const bf16* zr = z + (size_t)(tok0 + sq) * INW + c8;
                const bool hp = sq > 0, hn = sq + 1 < S;
                const bf16* zp = hp ? zr - INW : zr; const bf16* zn = hn ? zr + INW : zr;
                const v4u xp = *(const GAS v4u*)(zp + OCX), cp = *(const GAS v4u*)(zp + OCC), xc = *(const GAS v4u*)(zr + OCX), cc = *(const GAS v4u*)(zr + OCC),
                          xn = *(const GAS v4u*)(zn + OCX), cn = *(const GAS v4u*)(zn + OCC), cb = *(const GAS v4u*)(zr + OCB);
                const unsigned axp[4] = {xp.x, xp.y, xp.z, xp.w}, acp[4] = {cp.x, cp.y, cp.z, cp.w}, axc[4] = {xc.x, xc.y, xc.z, xc.w}, acc_[4] = {cc.x, cc.y, cc.z, cc.w},
                               axn[4] = {xn.x, xn.y, xn.z, xn.w}, acn[4] = {cn.x, cn.y, cn.z, cn.w}, acb[4] = {cb.x, cb.y, cb.z, cb.w};
                const float fp = hp ? 1.f : 0.f, fn = hn ? 1.f : 0.f;
                unsigned ow[4];
#pragma unroll
                for (int q = 0; q < 4; ++q) {
                    const float upa = fp * __builtin_bit_cast(float, axp[q] << 16) * __builtin_bit_cast(float, acp[q] << 16), upb = fp * __builtin_bit_cast(float, axp[q] & 0xffff0000u) * __builtin_bit_cast(float, acp[q] & 0xffff0000u);
                    const float uca = __builtin_bit_cast(float, axc[q] << 16) * __builtin_bit_cast(float, acc_[q] << 16), ucb = __builtin_bit_cast(float, axc[q] & 0xffff0000u) * __builtin_bit_cast(float, acc_[q] & 0xffff0000u);
                    const float una = fn * __builtin_bit_cast(float, axn[q] << 16) * __builtin_bit_cast(float, acn[q] << 16), unb = fn * __builtin_bit_cast(float, axn[q] & 0xffff0000u) * __builtin_bit_cast(float, acn[q] & 0xffff0000u);
                    const float oa = __builtin_bit_cast(float, acb[q] << 16) * (w0[2 * q] * upa + w1[2 * q] * uca + w2[2 * q] * una);
                    const float ob = __builtin_bit_cast(float, acb[q] & 0xffff0000u) * (w0[2 * q + 1] * upb + w1[2 * q + 1] * ucb + w2[2 * q + 1] * unb);
                    ow[q] = pk2(oa, ob); }
                v4u o; o.x = ow[0]; o.y = ow[1]; o.z = ow[2]; o.w = ow[3];
                *(GAS v4u*)(mix + (size_t)(tok0 + sq) * D + 512 + c8) = o; }
        }
#pragma unroll 1
        for (int gi = 0; gi < 2; ++gi) {
            const int gq = kvh * 2 + gi, half = 1 << gq;
            __syncthreads();
            { const int tt = tid >> 2, cq = tid & 3, sq = qb * 128 + tt;
              const int lo = sq - half < 0 ? 0 : sq - half, hi2 = sq + half > S ? S : sq + half;
              float acc[16];
#pragma unroll
              for (int j = 0; j < 16; ++j) acc[j] = 0.f;
              const bf16* zb = z + (size_t)tok0 * INW + OPX + gq * 64 + cq * 16;
#pragma unroll 1
              for (int i0 = 0; i0 < 2 * half; i0 += 4) {
                  v4u wa[4], wb[4]; float vf[4];
#pragma unroll
                  for (int i = 0; i < 4; ++i) { const int ss = sq - half + i0 + i; const bool ok = (i0 + i < 2 * half) && ss >= lo && ss < hi2; const int sc_ = ok ? ss : sq;
                      wa[i] = *(const GAS v4u*)(zb + (size_t)sc_ * INW); wb[i] = *(const GAS v4u*)(zb + (size_t)sc_ * INW + 8); vf[i] = ok ? 1.f : 0.f; }
#pragma unroll
                  for (int i = 0; i < 4; ++i) { const unsigned ww[8] = {wa[i].x, wa[i].y, wa[i].z, wa[i].w, wb[i].x, wb[i].y, wb[i].z, wb[i].w};
#pragma unroll
                      for (int q = 0; q < 8; ++q) { acc[2 * q] += vf[i] * __builtin_bit_cast(float, ww[q] << 16); acc[2 * q + 1] += vf[i] * __builtin_bit_cast(float, ww[q] & 0xffff0000u); } } }
              const float icnt = 1.0f / (float)(hi2 - lo);
              const bf16* zc = zb + (size_t)sq * INW;
              const v4u w0 = *(const GAS v4u*)zc, w1 = *(const GAS v4u*)(zc + 8); const unsigned ww[8] = {w0.x, w0.y, w0.z, w0.w, w1.x, w1.y, w1.z, w1.w};
              LAS float* pr = (LAS float*)(lds + P_OFF) + tt * PROW + cq * 16;
#pragma unroll
              for (int q = 0; q < 8; ++q) { pr[2 * q] = acc[2 * q] * icnt - __builtin_bit_cast(float, ww[q] << 16); pr[2 * q + 1] = acc[2 * q + 1] * icnt - __builtin_bit_cast(float, ww[q] & 0xffff0000u); } }
            __syncthreads();
            { const int e = tid & 63, tq8 = tid >> 6;
              float acc[16];
#pragma unroll
              for (int j = 0; j < 16; ++j) acc[j] = 0.f;
              const float* pw = pool_w + (size_t)gq * 64 * 64 + e;
#pragma unroll 4
              for (int c4 = 0; c4 < 16; ++c4) { const float wa = pw[(4 * c4) * 64], wb = pw[(4 * c4 + 1) * 64], wc = pw[(4 * c4 + 2) * 64], wd = pw[(4 * c4 + 3) * 64];
#pragma unroll
                  for (int tt = 0; tt < 16; ++tt) { const f32x4 pv = *(const LAS f32x4*)((LAS float*)(lds + P_OFF) + (tq8 * 16 + tt) * PROW + 4 * c4);
                      acc[tt] += pv.x * wa + pv.y * wb + pv.z * wc + pv.w * wd; } }
              const float sc = pool_scale[gq * 64 + e];
#pragma unroll
              for (int tt = 0; tt < 16; ++tt) mix[(size_t)(tok0 + qb * 128 + tq8 * 16 + tt) * D + 768 + gq * 64 + e] = (bf16)f2bf(acc[tt] * sc); }
        }
    }
}
}


namespace mk {
typedef float f32x2v __attribute__((ext_vector_type(2)));
__device__ __forceinline__ float gelu_erf(float x) { return 0.5f * x * (1.0f + erff(x * 0.70710678118654752f)); }


__device__ __forceinline__ void sort128(unsigned& k0, unsigned& k1, int lane_in) {
    int ln = lane_in; asm volatile("" : "+v"(ln));
#pragma unroll
    for (int lk = 1; lk <= 7; ++lk)
#pragma unroll
        for (int lj = lk - 1; lj >= 0; --lj) {
            if (lj == 6) { const unsigned mn = umin_(k0, k1), mx = umax_(k0, k1); k0 = mn; k1 = mx; }
            else { const unsigned bj = (unsigned)__builtin_amdgcn_sbfe(ln, lj, 1);
                const unsigned bk0 = (lk >= 7) ? 0u : (lk == 6 ? 0u : (unsigned)__builtin_amdgcn_sbfe(ln, lk, 1));
                const unsigned bk1 = (lk >= 7) ? 0u : (lk == 6 ? ~0u : (unsigned)__builtin_amdgcn_sbfe(ln, lk, 1));
                const unsigned f0 = bj ^ bk0, f1 = bj ^ bk1;
                const unsigned p0 = (unsigned)__shfl_xor((int)k0, 1 << lj), p1 = (unsigned)__shfl_xor((int)k1, 1 << lj);
                k0 = umin_(k0 ^ f0, p0 ^ f0) ^ f0; k1 = umin_(k1 ^ f1, p1 ^ f1) ^ f1; } }
}

typedef __bf16 v32bf __attribute__((ext_vector_type(32)));
typedef unsigned v16u __attribute__((ext_vector_type(16)));
typedef __bf16 bf16x2_t __attribute__((ext_vector_type(2)));
__device__ __forceinline__ float dot2bf(unsigned a, unsigned b, float c) { return __builtin_amdgcn_fdot2_f32_bf16(__builtin_bit_cast(bf16x2_t, a), __builtin_bit_cast(bf16x2_t, b), c, false); }
template <int NP> __device__ __forceinline__ void peer_batch(__amdgpu_buffer_rsrc_t U6, __amdgpu_buffer_rsrc_t V6, const unsigned (&hp)[16], int ev, float suv, float cv, int lbase, float (&y)[32], int lane) {
    static_assert(NP == 2 || NP == 4, "pairs per batch");
    asm volatile("" ::: "memory");
    const int rh = lane >> 5, l5 = lane & 31, b4 = (lane >> 4) & 1, b3 = (lane >> 3) & 1;
    v4u ua4[NP], va4[NP]; v2u ua2[NP], va2[NP];
#pragma unroll
    for (int i = 0; i < NP; ++i) { const int e0 = __builtin_amdgcn_readlane(ev, lbase + 2 * i), e1 = __builtin_amdgcn_readlane(ev, lbase + 2 * i + 1);
        const int rb = (rh ? e1 : e0) * 768;
        ua4[i] = __builtin_amdgcn_raw_buffer_load_b128(U6, rb + 16 * l5, 0, 0); ua2[i] = __builtin_amdgcn_raw_buffer_load_b64(U6, rb + 512 + 8 * l5, 0, 0);
        va4[i] = __builtin_amdgcn_raw_buffer_load_b128(V6, rb + 16 * l5, 0, 0); va2[i] = __builtin_amdgcn_raw_buffer_load_b64(V6, rb + 512 + 8 * l5, 0, 0); }
    float p[NP];
#pragma unroll
    for (int i = 0; i < NP; ++i) { v6u w; w[0] = ua4[i].x; w[1] = ua4[i].y; w[2] = ua4[i].z; w[3] = ua4[i].w; w[4] = ua2[i].x; w[5] = ua2[i].y;
        if (i > 0) asm volatile("" : "+v"(w) : "v"(p[i - 1]));
        const v16u f = __builtin_bit_cast(v16u, __builtin_amdgcn_cvt_scalef32_pk32_bf16_fp6(w, 1.0f));
        float s0 = 0.f, s1 = 0.f;
#pragma unroll
        for (int k = 0; k < 8; ++k) { s0 = dot2bf(f[2 * k], hp[2 * k], s0); s1 = dot2bf(f[2 * k + 1], hp[2 * k + 1], s1); }
        p[i] = s0 + s1; }
    float sd; int pi;
    if (NP == 4) { float q2[2];
#pragma unroll
        for (int i = 0; i < 2; ++i) { const float snd = b4 ? p[i] : p[i + 2]; const float rcv = __shfl_xor(snd, 16); q2[i] = (b4 ? p[i + 2] : p[i]) + rcv; }
        { const float snd = b3 ? q2[0] : q2[1]; const float rcv = __shfl_xor(snd, 8); sd = (b3 ? q2[1] : q2[0]) + rcv; }
        pi = 2 * b4 + b3;
    } else { const float snd = b4 ? p[0] : p[1]; const float rcv = __shfl_xor(snd, 16); sd = (b4 ? p[1] : p[0]) + rcv; sd += __shfl_xor(sd, 8); pi = b4; }
    sd += __shfl_xor(sd, 4); sd += __shfl_xor(sd, 2); sd += __shfl_xor(sd, 1);
    const int slot = lbase + 2 * pi + rh;
    const float w = __shfl(cv, slot) * gelu_erf(sd * __shfl(suv, slot));
#pragma unroll
    for (int i = 0; i < NP; ++i) { const float wi = __shfl(w, (lane & 32) + (NP == 4 ? 16 * (i >> 1) + 8 * (i & 1) : 16 * i));
        v6u vw; vw[0] = va4[i].x; vw[1] = va4[i].y; vw[2] = va4[i].z; vw[3] = va4[i].w; vw[4] = va2[i].x; vw[5] = va2[i].y;
        asm volatile("" : "+v"(vw) : "v"(wi));
        const v32f f = __builtin_amdgcn_cvt_scalef32_pk32_f32_fp6(vw, 1.0f);
#pragma unroll
        for (int k = 0; k < 32; ++k) y[k] += wi * f[k]; }
}

template <int L> __device__ __forceinline__ void ph_peer(const Args& args, const XcdBarrier& bar) {
    const int lane = threadIdx.x & 63, wave = __builtin_amdgcn_readfirstlane(threadIdx.x >> 6);
    unsigned char* ws = args.ws;
    const __amdgpu_buffer_rsrc_t U6 = __builtin_amdgcn_make_buffer_rsrc(ws + WS_U + (size_t)L * NE * 768, 0, NE * 768, 0x00020000);
    const __amdgpu_buffer_rsrc_t V6 = __builtin_amdgcn_make_buffer_rsrc(ws + WS_V + (size_t)L * NE * 768, 0, NE * 768, 0x00020000);
    const float* SU = (const float*)(ws + WS_SU) + L * NE; const float* SV = (const float*)(ws + WS_SV) + L * NE;
    const bf16* Hb = (const bf16*)(ws + WS_H); const float* X1 = (const float*)(ws + WS_X1);
    const int* eidx = (const int*)(ws + WS_EIDX); const float* gate = (const float*)(ws + WS_GATE);
    const float* mod = (const float*)(ws + WS_MOD);
    float* outp = args.out;
    const int gw = MK_GW(wave), NGW = MK_NGW;
    const bool poison = __hip_atomic_load((unsigned*)(ws + WS_CTL) + CW_FP6, __ATOMIC_RELAXED, __HIP_MEMORY_SCOPE_AGENT) == 0u;
    const int ecol = 32 * (lane & 31) + 16 * (lane >> 5);
#pragma unroll 1
    for (int t = gw; t < T; t += NGW) {
        unsigned hp[16];
#pragma unroll
        for (int q = 0; q < 4; ++q) { const v4u h = *(const GAS v4u*)(Hb + (size_t)t * D + 32 * (lane & 31) + 8 * q); hp[4 * q] = h.x; hp[4 * q + 1] = h.y; hp[4 * q + 2] = h.z; hp[4 * q + 3] = h.w; }
        unsigned k0 = ((unsigned)eidx[(size_t)t * 128 + lane] << 7) | (unsigned)lane, k1 = ((unsigned)eidx[(size_t)t * 128 + 64 + lane] << 7) | (unsigned)(64 + lane);
        sort128(k0, k1, lane);
        const int e0 = (int)(k0 >> 7), e1 = (int)(k1 >> 7);
        const float su0 = SU[e0], su1 = SU[e1];
        const float c0 = gate[(size_t)t * 128 + (k0 & 127u)] * SV[e0], c1 = gate[(size_t)t * 128 + (k1 & 127u)] * SV[e1];
        float y[32];
#pragma unroll
        for (int i = 0; i < 32; ++i) y[i] = 0.f;
#pragma unroll 1
        for (int bt = 0; bt < 128 / (2 * PE_NP); ++bt) { constexpr int HB = 64 / (2 * PE_NP);
            peer_batch<PE_NP>(U6, V6, hp, (bt < HB) ? e0 : e1, (bt < HB) ? su0 : su1, (bt < HB) ? c0 : c1, (bt % HB) * 2 * PE_NP, y, lane); }
        asm volatile("" ::: "memory");
        float ys[16];
#pragma unroll
        for (int i = 0; i < 16; ++i) { const float mine = (lane >> 5) ? y[16 + i] : y[i], give = (lane >> 5) ? y[i] : y[16 + i]; ys[i] = mine + __shfl_xor(give, 32); }
        const float* g2 = mod + ((size_t)L * B + t / S) * 6 * D + 5 * D;
        float xo[16]; float ssq = 0.f;
        const float qnan = __builtin_nanf("");
#pragma unroll
        for (int hf4 = 0; hf4 < 4; ++hf4) { const int col = ecol + 4 * hf4;
            const f32x4 xv = *(const GAS f32x4*)(X1 + (size_t)t * D + col), gg = *(const f32x4*)(g2 + col);
            f32x4 o; o.x = xv.x + gg.x * ys[4 * hf4 + 0]; o.y = xv.y + gg.y * ys[4 * hf4 + 1]; o.z = xv.z + gg.z * ys[4 * hf4 + 2]; o.w = xv.w + gg.w * ys[4 * hf4 + 3];
            if (poison) o = (f32x4){qnan, qnan, qnan, qnan};
            *(GAS f32x4*)(outp + (size_t)t * D + col) = o;
            xo[4 * hf4 + 0] = o.x; xo[4 * hf4 + 1] = o.y; xo[4 * hf4 + 2] = o.z; xo[4 * hf4 + 3] = o.w;
            ssq += (o.x * o.x + o.y * o.y) + (o.z * o.z + o.w * o.w); }
        if (L + 1 < DEPTH) {
            const float rstd = 1.0f / sqrtf(wave_sum(ssq) * (1.f / D) + EPS);
            const float* g = args.in[3] + (L + 1) * D; const float* mb = mod + ((size_t)(L + 1) * B + t / S) * 6 * D;
            float hv[16];
#pragma unroll
            for (int hf4 = 0; hf4 < 4; ++hf4) { const int col = ecol + 4 * hf4;
                const f32x4 gg = *(const f32x4*)(g + col), sh = *(const f32x4*)(mb + col), sc = *(const f32x4*)(mb + D + col);
                hv[4 * hf4 + 0] = xo[4 * hf4 + 0] * rstd * gg.x * (1.0f + sc.x) + sh.x; hv[4 * hf4 + 1] = xo[4 * hf4 + 1] * rstd * gg.y * (1.0f + sc.y) + sh.y;
                hv[4 * hf4 + 2] = xo[4 * hf4 + 2] * rstd * gg.z * (1.0f + sc.z) + sh.z; hv[4 * hf4 + 3] = xo[4 * hf4 + 3] * rstd * gg.w * (1.0f + sc.w) + sh.w; }
#pragma unroll
            for (int pc = 0; pc < 2; ++pc) { v4u o; o.x = pk2(hv[8 * pc + 0], hv[8 * pc + 1]); o.y = pk2(hv[8 * pc + 2], hv[8 * pc + 3]); o.z = pk2(hv[8 * pc + 4], hv[8 * pc + 5]); o.w = pk2(hv[8 * pc + 6], hv[8 * pc + 7]);
                *(GAS v4u*)((bf16*)(ws + WS_H) + (size_t)t * D + ecol + 8 * pc) = o; }
        }
    }
}
}

namespace mk {
constexpr int LDS_XB_OFF = LDS_BYTES - 64;
template <int L> __device__ __forceinline__ void layer_phases(const Args& args, LAS unsigned char* lds, const XcdBarrier& bar) {
    const int lo = args.ph_lo, hi = args.ph_hi;
#define IN(k) (lo <= (k) && (k) < hi)
#define SEAM(k) do { if (IN(k) && IN((k) + 1)) xcd_barrier(bar); } while (0)
    constexpr int pb = PH_L0 + L * PH_PER_LAYER;
    if (IN(pb + PH_G1)) for (int rep = 0; rep < REP_GEMM; ++rep) ph_g1<L>(args, lds);
    SEAM(pb + PH_G1);
    if (IN(pb + PH_AT)) for (int rep = 0; rep < REP_AT; ++rep) ph_mixer<L>(args, lds);
    SEAM(pb + PH_AT);
    if (IN(pb + PH_G2)) for (int rep = 0; rep < REP_GEMM; ++rep) ph_g2<L>(args, lds);
    SEAM(pb + PH_G2);
    if (IN(pb + PH_N2)) for (int rep = 0; rep < REP_N2; ++rep) ph_hmod<L, 1>(args);
    SEAM(pb + PH_N2);
    if (IN(pb + PH_G3)) for (int rep = 0; rep < REP_GEMM; ++rep) ph_g3<L>(args, lds);
    SEAM(pb + PH_G3);
    if (IN(pb + PH_TK)) for (int rep = 0; rep < REP_TK; ++rep) ph_topk<L>(args, lds);
    SEAM(pb + PH_TK);
    if (IN(pb + PH_PE)) for (int rep = 0; rep < (L == 1 ? REP_PE1 : 1); ++rep) ph_peer<L>(args, bar);
    if (L + 1 < DEPTH) SEAM(pb + PH_PE);
#undef SEAM
#undef IN
}

__global__ void __launch_bounds__(NT, 2) mk_fwd(Args args) {
    extern __shared__ __attribute__((aligned(16))) unsigned char lds_raw[];
    LAS unsigned char* lds = (LAS unsigned char*)lds_raw;
    const int lo = args.ph_lo, hi = args.ph_hi;
    if (threadIdx.x < 16) ((LAS unsigned*)(lds + LDS_XB_OFF))[threadIdx.x] = 0u;
    __syncthreads();
    XcdBarrier bar; bar.bar = (unsigned*)(args.ws + WS_CTL) + CW_BAR; bar.x = 0; bar.st = nullptr;
    if (hi - lo > 1) bar = xcd_barrier_post((unsigned*)(args.ws + WS_CTL) + CW_BAR, (volatile LAS unsigned*)(lds + LDS_XB_OFF));
#define IN(k) (lo <= (k) && (k) < hi)
#define SEAM(k) do { if (IN(k) && IN((k) + 1)) xcd_barrier(bar); } while (0)
    if (IN(PH_PRO)) for (int rep = 0; rep < REP_PRO; ++rep) ph_prologue(args, lds);
    SEAM(PH_PRO);
    if (IN(PH_H0)) ph_hmod<0, 0>(args);
    SEAM(PH_H0);
    layer_phases<0>(args, lds, bar);
    layer_phases<1>(args, lds, bar);
#undef SEAM
#undef IN
}
}


extern "C" void kernel_launch(void* const* d_in, const int* in_sizes, int n_in, void* d_out, int out_size, void* d_ws, size_t ws_size, hipStream_t stream) {
    using namespace mk;
    static int grid = 0;
    if (grid == 0) {
        if (n_in != 19 || ws_size < WS_END || out_size != T * D) { fprintf(stderr, "kernel_launch: bad n_in %d / out_size %d / ws_size %zu\n", n_in, out_size, ws_size); grid = -1; return; }
        int dev = 0, cus = 0, per_cu = 0;
        if (hipGetDevice(&dev) != hipSuccess || hipDeviceGetAttribute(&cus, hipDeviceAttributeMultiprocessorCount, dev) != hipSuccess) { grid = -1; return; }
        if (hipFuncSetAttribute((const void*)mk_fwd, hipFuncAttributeMaxDynamicSharedMemorySize, LDS_BYTES) != hipSuccess) { fprintf(stderr, "hipFuncSetAttribute failed\n"); grid = -1; return; }
        if (hipOccupancyMaxActiveBlocksPerMultiprocessor(&per_cu, (const void*)mk_fwd, NT, LDS_BYTES) != hipSuccess) per_cu = 0;
        (void)hipGetLastError();
        grid = (per_cu >= 1) ? cus : -1;
        if (grid < 0) { fprintf(stderr, "kernel_launch: occupancy query says %d workgroups per CU; nothing launched\n", per_cu); return; }
    }
    if (grid < 0) return;
    unsigned char* ws = (unsigned char*)d_ws;
    (void)hipMemsetAsync(ws + WS_CTL, 0, CTL_ZERO_BYTES, stream);
    Args a{};
    for (int i = 0; i < 19; ++i) a.in[i] = (const float*)d_in[i];
    a.out = (float*)d_out; a.ws = ws;
#if MK_SPLIT
    for (int ph = 0; ph < PH_END; ++ph) { a.ph_lo = ph; a.ph_hi = ph + 1;
        const int pl = ph >= PH_L0 ? (ph - PH_L0) % PH_PER_LAYER : -1;
        const int reps = (pl == PH_G1 || pl == PH_G2 || pl == PH_G3) ? HREP_GEMM : (pl == PH_AT) ? HREP_AT : (pl == PH_TK) ? HREP_TK : (pl == PH_N2 || ph == PH_H0) ? HREP_N2 : (ph == PH_PRO) ? HREP_PRO : 1;
        for (int rep = 0; rep < reps; ++rep) hipLaunchKernelGGL(mk_fwd, dim3(grid), dim3(NT), LDS_BYTES, stream, a); }
#else
    a.ph_lo = 0; a.ph_hi = PH_END;
    hipLaunchKernelGGL(mk_fwd, dim3(grid), dim3(NT), LDS_BYTES, stream, a);
#endif
}
```
